# Optimizing an MI355X kernel written in HIP

```python
import math
import jax
import jax.numpy as jnp
from jax import lax
import numpy as np

D_MODEL = 1024
BATCH = 2
SEQ = 8192
DEPTH = 2

SSM_WIDTH = D_MODEL // 2
SSM_GROUP = 16
SSM_GROUPS = SSM_WIDTH // SSM_GROUP
SSM_STATE = 64
GDN_HEADS = 4
GDN_DK = 128
GDN_DV = 128
GDN_CONV = 4
GDN_CHUNK = 64
NSA_HEADS = 8
NSA_KV_GROUPS = 2
NSA_HPG = NSA_HEADS // NSA_KV_GROUPS
NSA_DH = 64
NSA_CMP_LEN = 32
NSA_CMP_STRIDE = 16
NSA_CMP_HIDDEN = 128
NSA_SEL_LEN = 64
NSA_SEL_TOPK = 16
NSA_WINDOW = 512
NSA_QBLOCK = 128
SGU_WIDTH = D_MODEL // 2
SGU_GROUPS = 4
SGU_CHUNK = 128
REL_BUCKETS = 32
REL_MAX_DIST = 128
FFN_DENSE = 2816
N_EXPERTS = 8
TOP_K = 2
FFN_EXPERT = 3584
N_BRANCH = 4
N_DENSE_LAYERS = (DEPTH + 1) // 2
N_MOE_LAYERS = DEPTH // 2
RMS_EPS = 1e-6
GDN_QKV = GDN_HEADS * (2 * GDN_DK + GDN_DV)
NSA_Q = NSA_HEADS * NSA_DH
NSA_KV = NSA_KV_GROUPS * NSA_DH
IN_COLS = (SSM_WIDTH + GDN_QKV + 2 * GDN_HEADS + GDN_HEADS * GDN_DV + NSA_Q + 6 * NSA_KV
           + 3 * NSA_HEADS + 2 * SGU_WIDTH + N_BRANCH * D_MODEL)

kernel_name = 'hybrid_parallel_mixers_moe'


def rms_norm(x, g):
    xf = x.astype(jnp.float32)
    y = xf * lax.rsqrt(jnp.mean(xf * xf, axis=-1, keepdims=True) + RMS_EPS)
    return (y * g.astype(jnp.float32)).astype(x.dtype)


def l2_norm(t):
    return t * lax.rsqrt(jnp.sum(t * t, axis=-1, keepdims=True) + 1e-6)


def masked_softmax(logits, valid):
    logits = jnp.where(valid, logits.astype(jnp.float32), -1e30)
    return jax.nn.softmax(logits, axis=-1) * valid


def rel_bucket(dist):
    n = jnp.maximum(dist, 0)
    max_exact = REL_BUCKETS // 2
    nf = jnp.maximum(n, 1).astype(jnp.float32)
    large = max_exact + (jnp.log(nf / max_exact) / math.log(REL_MAX_DIST / max_exact)
                         * (REL_BUCKETS - max_exact)).astype(jnp.int32)
    large = jnp.minimum(large, REL_BUCKETS - 1)
    return jnp.where(n < max_exact, n, large)


def split_columns(proj):
    sizes = ([SSM_WIDTH, GDN_QKV, GDN_HEADS, GDN_HEADS, GDN_HEADS * GDN_DV, NSA_Q]
             + [NSA_KV] * 6 + [3 * NSA_HEADS, 2 * SGU_WIDTH, N_BRANCH * D_MODEL])
    cuts = [int(c) for c in np.cumsum(sizes)[:-1]]
    return jnp.split(proj, cuts, axis=-1)


def swiglu(h, w_gate, w_up, w_down):
    return (jax.nn.silu(h @ w_gate) * (h @ w_up)) @ w_down


def ssm_mixer(u, a_re, a_im, log_dt, b_re, b_im, c_re, c_im, d_skip, glu_w):
    f32 = jnp.float32
    bs, s, _ = u.shape
    uf = u.astype(f32).reshape(bs, s, SSM_GROUPS, SSM_GROUP)
    a_re, a_im = a_re.astype(f32), a_im.astype(f32)
    dt = jnp.exp(log_dt.astype(f32))[:, None]
    mag = jnp.exp(a_re * dt)
    abar_r, abar_i = mag * jnp.cos(a_im * dt), mag * jnp.sin(a_im * dt)
    nr, ni = abar_r - 1.0, abar_i
    den = a_re * a_re + a_im * a_im
    sr, si = (nr * a_re + ni * a_im) / den, (ni * a_re - nr * a_im) / den
    b_re, b_im = b_re.astype(f32), b_im.astype(f32)
    bbar_r = sr[..., None] * b_re - si[..., None] * b_im
    bbar_i = sr[..., None] * b_im + si[..., None] * b_re
    bu_r = jnp.einsum('bsgp,gnp->bsgn', uf, bbar_r)
    bu_i = jnp.einsum('bsgp,gnp->bsgn', uf, bbar_i)
    ar = jnp.broadcast_to(abar_r, bu_r.shape)
    ai = jnp.broadcast_to(abar_i, bu_r.shape)

    def combine(e1, e2):
        a1r, a1i, b1r, b1i = e1
        a2r, a2i, b2r, b2i = e2
        return (a2r * a1r - a2i * a1i, a2r * a1i + a2i * a1r,
                a2r * b1r - a2i * b1i + b2r, a2r * b1i + a2i * b1r + b2i)

    _, _, st_r, st_i = lax.associative_scan(combine, (ar, ai, bu_r, bu_i), axis=1)
    y = (jnp.einsum('gpn,bsgn->bsgp', c_re.astype(f32), st_r)
         - jnp.einsum('gpn,bsgn->bsgp', c_im.astype(f32), st_i)
         + d_skip.astype(f32).reshape(SSM_GROUPS, SSM_GROUP) * uf)
    y = jax.nn.gelu(y.reshape(bs, s, SSM_WIDTH))
    return (y * jax.nn.sigmoid(y @ glu_w.astype(f32))).astype(u.dtype)


def gdn_mixer(qkv, a, b, z, conv_w, a_log, dt_bias, norm_g):
    f32 = jnp.float32
    out_dtype = z.dtype
    bs, s, c = qkv.shape
    H, DK, DV, CH = GDN_HEADS, GDN_DK, GDN_DV, GDN_CHUNK
    qkv = lax.conv_general_dilated(qkv, conv_w.astype(qkv.dtype)[:, None, :], window_strides=(1,),
                                   padding=[(GDN_CONV - 1, 0)],
                                   dimension_numbers=('NWC', 'WIO', 'NWC'), feature_group_count=c)
    qkv = jax.nn.silu(qkv.astype(f32))
    q, k, v = jnp.split(qkv, [H * DK, 2 * H * DK], axis=-1)
    q = l2_norm(q.reshape(bs, s, H, DK)) * (DK ** -0.5)
    k = l2_norm(k.reshape(bs, s, H, DK))
    v = v.reshape(bs, s, H, DV)
    beta = jax.nn.sigmoid(b.astype(f32))
    log_alpha = -jnp.exp(a_log.astype(f32)) * jax.nn.softplus(a.astype(f32) + dt_bias.astype(f32))
    nc = s // CH

    def chunks(t):
        return t.reshape(bs, nc, CH, H, -1).transpose(0, 3, 1, 2, 4)

    q, k, v = chunks(q), chunks(k), chunks(v)
    beta = chunks(beta[..., None])
    g = jnp.cumsum(chunks(log_alpha[..., None]), axis=3)
    gv = g[..., 0]
    causal = jnp.tril(jnp.ones((CH, CH), bool))
    strict = jnp.tril(jnp.ones((CH, CH), bool), -1)
    decay = jnp.exp(jnp.where(causal, gv[..., :, None] - gv[..., None, :], -jnp.inf))
    kb = k * beta
    a_mat = (jnp.where(strict, jnp.einsum('bhncd,bhnkd->bhnck', kb, k) * decay, 0.0)
             + jnp.eye(CH, dtype=f32))
    rhs = jnp.concatenate([v * beta, kb * jnp.exp(g)], axis=-1)
    sol = lax.linalg.triangular_solve(a_mat, rhs, left_side=True, lower=True, unit_diagonal=True)
    u_val, w = sol[..., :DV], sol[..., DV:]
    attn = jnp.einsum('bhncd,bhnkd->bhnck', q, k) * decay
    g_last = g[..., -1:, :]
    k_st = k * jnp.exp(g_last - g)
    q_st = q * jnp.exp(g)

    def step(state, xs):
        q_c, k_c, u_c, w_c, a_c, gl_c = xs
        v_new = u_c - jnp.einsum('bhcd,bhde->bhce', w_c, state)
        o = jnp.einsum('bhcd,bhde->bhce', q_c, state) + jnp.einsum('bhck,bhke->bhce', a_c, v_new)
        state = state * jnp.exp(gl_c) + jnp.einsum('bhcd,bhce->bhde', k_c, v_new)
        return state, o

    xs = tuple(jnp.moveaxis(t, 2, 0) for t in (q_st, k_st, u_val, w, attn, g_last))
    _, o = lax.scan(step, jnp.zeros((bs, H, DK, DV), f32), xs)
    o = o.transpose(1, 0, 3, 2, 4).reshape(bs, s, H, DV)
    o = o * lax.rsqrt(jnp.mean(o * o, axis=-1, keepdims=True) + RMS_EPS) * norm_g.astype(f32)
    o = o * jax.nn.silu(z.astype(f32).reshape(bs, s, H, DV))
    return o.reshape(bs, s, H * DV).astype(out_dtype)


def nsa_mixer(q, k_c, v_c, k_s, v_s, k_w, v_w, gate_logits, positions,
              ck_pe, ck_w1, ck_w2, cv_pe, cv_w1, cv_w2, rel_bias):
    f32 = jnp.float32
    out_dtype = q.dtype
    bs, s, _ = q.shape
    G, HG, DH, QB, W = NSA_KV_GROUPS, NSA_HPG, NSA_DH, NSA_QBLOCK, NSA_WINDOW
    q = q.astype(f32).reshape(bs, s, G, HG, DH) * (DH ** -0.5)

    def kv(t):
        return t.astype(f32).reshape(bs, s, G, DH)

    k_c, v_c, k_s, v_s, k_w, v_w = (kv(t) for t in (k_c, v_c, k_s, v_s, k_w, v_w))
    gates = jax.nn.sigmoid(gate_logits.astype(f32)).reshape(bs, s, G, HG, 3)
    n_cmp = (s - NSA_CMP_LEN) // NSA_CMP_STRIDE + 1
    cmp_start = jnp.arange(n_cmp) * NSA_CMP_STRIDE
    cmp_end = cmp_start + NSA_CMP_LEN - 1
    cmp_tok = cmp_start[:, None] + jnp.arange(NSA_CMP_LEN)[None, :]

    def compress(t, pe, w1, w2):
        blk = t[:, cmp_tok] + pe.astype(f32)[None, None, :, None, :]
        blk = blk.transpose(0, 1, 3, 2, 4).reshape(bs, n_cmp, G, NSA_CMP_LEN * DH)
        return jax.nn.gelu(blk @ w1.astype(f32)) @ w2.astype(f32)

    kc = compress(k_c, ck_pe, ck_w1, ck_w2)
    vc = compress(v_c, cv_pe, cv_w1, cv_w2)
    cmp_pos = positions[cmp_end]
    n_sel = s // NSA_SEL_LEN
    sel_k = min(NSA_SEL_TOPK, n_sel)
    sel_start = jnp.arange(n_sel) * NSA_SEL_LEN
    agg = ((cmp_start[:, None] <= sel_start[None, :] + NSA_SEL_LEN - 1)
           & (cmp_end[:, None] >= sel_start[None, :])).astype(f32)
    ks_blk = k_s.reshape(bs, n_sel, NSA_SEL_LEN, G, DH).transpose(0, 3, 1, 2, 4)
    vs_blk = v_s.reshape(bs, n_sel, NSA_SEL_LEN, G, DH).transpose(0, 3, 1, 2, 4)
    pos_blk = positions.reshape(n_sel, NSA_SEL_LEN)
    kw_pad = jnp.pad(k_w, ((0, 0), (W, 0), (0, 0), (0, 0)))
    vw_pad = jnp.pad(v_w, ((0, 0), (W, 0), (0, 0), (0, 0)))
    pos_pad = jnp.pad(positions, (W, 0))
    tbl = rel_bias.astype(f32).reshape(REL_BUCKETS, G, HG)
    b_ix = jnp.arange(bs)[:, None, None, None]
    g_ix = jnp.arange(G)[None, :, None, None]
    sel_offs = jnp.arange(NSA_SEL_LEN)
    win_offs = jnp.arange(QB + W)
    blk_j = jnp.arange(n_sel)

    def one_block(qi):
        s0 = qi * QB
        qb = lax.dynamic_slice_in_dim(q, s0, QB, axis=1)
        t = s0 + jnp.arange(QB)
        tp = lax.dynamic_slice_in_dim(positions, s0, QB)
        bias_c = tbl[rel_bucket(tp[:, None] - cmp_pos[None, :])].transpose(2, 3, 0, 1)
        lg_c = jnp.einsum('bqghd,bcgd->bghqc', qb, kc) + bias_c
        p_c = masked_softmax(lg_c, cmp_end[None, :] <= t[:, None])
        o_c = jnp.einsum('bghqc,bcgd->bqghd', p_c, vc)
        imp = jnp.einsum('bghqc,cj->bgqj', p_c, agg)
        tb = t // NSA_SEL_LEN
        forced = ((blk_j[None, :] == 0) | (blk_j[None, :] == tb[:, None])
                  | (blk_j[None, :] == tb[:, None] - 1))
        eligible = sel_start[None, :] <= t[:, None]
        score = jnp.where(forced, 1e9, jnp.where(eligible, imp, -1e9))
        _, sel = lax.top_k(score, sel_k)
        k_sel = ks_blk[b_ix, g_ix, sel]
        v_sel = vs_blk[b_ix, g_ix, sel]
        tok_s = sel[..., None] * NSA_SEL_LEN + sel_offs
        bias_s = tbl[rel_bucket(tp[:, None, None] - pos_blk[sel]), g_ix[..., None]]
        lg_s = jnp.einsum('bqghd,bgqnkd->bghqnk', qb, k_sel) + bias_s.transpose(0, 1, 5, 2, 3, 4)
        valid_s = (tok_s <= t[:, None, None])[:, :, None].reshape(bs, G, 1, QB, -1)
        p_s = masked_softmax(lg_s.reshape(bs, G, HG, QB, -1), valid_s)
        p_s = p_s.reshape(bs, G, HG, QB, sel_k, NSA_SEL_LEN)
        o_s = jnp.einsum('bghqnk,bgqnkd->bqghd', p_s, v_sel)
        kwb = lax.dynamic_slice_in_dim(kw_pad, s0, QB + W, axis=1)
        vwb = lax.dynamic_slice_in_dim(vw_pad, s0, QB + W, axis=1)
        tok_w = s0 - W + win_offs
        pos_w = lax.dynamic_slice_in_dim(pos_pad, s0, QB + W)
        d_tok = t[:, None] - tok_w[None, :]
        valid_w = (d_tok >= 0) & (d_tok < W) & (tok_w[None, :] >= 0)
        bias_w = tbl[rel_bucket(tp[:, None] - pos_w[None, :])].transpose(2, 3, 0, 1)
        lg_w = jnp.einsum('bqghd,bkgd->bghqk', qb, kwb) + bias_w
        p_w = masked_softmax(lg_w, valid_w)
        o_w = jnp.einsum('bghqk,bkgd->bqghd', p_w, vwb)
        gb = lax.dynamic_slice_in_dim(gates, s0, QB, axis=1)
        return gb[..., 0:1] * o_c + gb[..., 1:2] * o_s + gb[..., 2:3] * o_w

    out = lax.map(one_block, jnp.arange(s // QB))
    return out.transpose(1, 0, 2, 3, 4, 5).reshape(bs, s, G * HG * DH).astype(out_dtype)


def sgu_mixer(uv, ln_g, ln_b, w_s, b_s):
    f32 = jnp.float32
    bs, s, _ = uv.shape
    uv = jax.nn.gelu(uv.astype(f32))
    u, v = uv[..., :SGU_WIDTH], uv[..., SGU_WIDTH:]
    mu = jnp.mean(v, axis=-1, keepdims=True)
    var = jnp.mean(jnp.square(v - mu), axis=-1, keepdims=True)
    v = (v - mu) * lax.rsqrt(var + RMS_EPS) * ln_g.astype(f32) + ln_b.astype(f32)
    nc = s // SGU_CHUNK
    v = v.reshape(bs, nc, SGU_CHUNK, SGU_GROUPS, SGU_WIDTH // SGU_GROUPS)
    mix = (jnp.einsum('gij,bcjgd->bcigd', jnp.tril(w_s.astype(f32)), v)
           + b_s.astype(f32).T[None, None, :, :, None])
    return (u * mix.reshape(bs, s, SGU_WIDTH)).astype(uv.dtype)


def moe_ffn(h, router, w_gate, w_up, w_down):
    logits = (h @ router).astype(jnp.float32)
    top_val, top_idx = lax.top_k(logits, TOP_K)
    weights = jax.nn.softmax(top_val, axis=-1)
    gate = jnp.sum(jax.nn.one_hot(top_idx, N_EXPERTS, dtype=jnp.float32) * weights[..., None], axis=-2)
    out = jnp.zeros_like(h)
    for e in range(N_EXPERTS):
        out = out + gate[..., e:e + 1].astype(h.dtype) * swiglu(h, w_gate[e], w_up[e], w_down[e])
    return out


def setup_inputs(seed: int = 0) -> dict:
    key = jax.random.key(seed)
    keys = iter(jax.random.split(key, 64))
    f32 = jnp.float32

    def nrm(shape, scale):
        return jax.random.normal(next(keys), shape, f32) * scale

    def gain(shape):
        return 1.0 + nrm(shape, 0.02)

    L = DEPTH
    x = nrm((BATCH, SEQ, D_MODEL), 1.0)
    positions = jnp.arange(SEQ, dtype=jnp.int32) + jax.random.randint(next(keys), (), 0, 1024, dtype=jnp.int32)
    ssm_a_re = -0.5 + nrm((L, SSM_GROUPS, SSM_STATE), 1e-3)
    ssm_a_im = math.pi * jnp.arange(SSM_STATE, dtype=f32) + nrm((L, SSM_GROUPS, SSM_STATE), 1e-3)
    ssm_log_dt = jax.random.uniform(next(keys), (L, SSM_GROUPS), f32, math.log(1e-3), math.log(1e-1))
    dt = jnp.exp(jax.random.uniform(next(keys), (L, GDN_HEADS), f32, math.log(1e-3), math.log(1e-1)))
    return {
        'x': x,
        'positions': positions,
        'norm_mix': gain((L, D_MODEL)),
        'norm_ffn': gain((L, D_MODEL)),
        'norm_final': gain((D_MODEL,)),
        'w_in': nrm((L, D_MODEL, IN_COLS), D_MODEL ** -0.5),
        'ssm_a_re': ssm_a_re,
        'ssm_a_im': ssm_a_im,
        'ssm_log_dt': ssm_log_dt,
        'ssm_b_re': nrm((L, SSM_GROUPS, SSM_STATE, SSM_GROUP), (2 * SSM_GROUP) ** -0.5),
        'ssm_b_im': nrm((L, SSM_GROUPS, SSM_STATE, SSM_GROUP), (2 * SSM_GROUP) ** -0.5),
        'ssm_c_re': nrm((L, SSM_GROUPS, SSM_GROUP, SSM_STATE), (2 * SSM_STATE) ** -0.5),
        'ssm_c_im': nrm((L, SSM_GROUPS, SSM_GROUP, SSM_STATE), (2 * SSM_STATE) ** -0.5),
        'ssm_d': nrm((L, SSM_WIDTH), 1.0),
        'ssm_glu_w': nrm((L, SSM_WIDTH, SSM_WIDTH), SSM_WIDTH ** -0.5),
        'gdn_conv_w': nrm((L, GDN_CONV, GDN_QKV), GDN_CONV ** -0.5),
        'gdn_a_log': jnp.log(jax.random.uniform(next(keys), (L, GDN_HEADS), f32, 1.0, 16.0)),
        'gdn_dt_bias': dt + jnp.log(-jnp.expm1(-dt)),
        'gdn_norm': gain((L, GDN_DV)),
        'nsa_cmp_k_pe': nrm((L, NSA_CMP_LEN, NSA_DH), 0.02),
        'nsa_cmp_k_w1': nrm((L, NSA_CMP_LEN * NSA_DH, NSA_CMP_HIDDEN), (NSA_CMP_LEN * NSA_DH) ** -0.5),
        'nsa_cmp_k_w2': nrm((L, NSA_CMP_HIDDEN, NSA_DH), NSA_CMP_HIDDEN ** -0.5),
        'nsa_cmp_v_pe': nrm((L, NSA_CMP_LEN, NSA_DH), 0.02),
        'nsa_cmp_v_w1': nrm((L, NSA_CMP_LEN * NSA_DH, NSA_CMP_HIDDEN), (NSA_CMP_LEN * NSA_DH) ** -0.5),
        'nsa_cmp_v_w2': nrm((L, NSA_CMP_HIDDEN, NSA_DH), NSA_CMP_HIDDEN ** -0.5),
        'rel_bias': nrm((REL_BUCKETS, NSA_HEADS), 0.5),
        'sgu_ln_g': gain((L, SGU_WIDTH)),
        'sgu_ln_b': nrm((L, SGU_WIDTH), 0.02),
        'sgu_w': nrm((L, SGU_GROUPS, SGU_CHUNK, SGU_CHUNK), SGU_CHUNK ** -0.5),
        'sgu_b': 1.0 + nrm((L, SGU_GROUPS, SGU_CHUNK), 0.02),
        'w_br_ssm': nrm((L, SSM_WIDTH, D_MODEL), SSM_WIDTH ** -0.5),
        'w_br_gdn': nrm((L, GDN_HEADS * GDN_DV, D_MODEL), (GDN_HEADS * GDN_DV) ** -0.5),
        'w_br_nsa': nrm((L, NSA_Q, D_MODEL), NSA_Q ** -0.5),
        'w_br_sgu': nrm((L, SGU_WIDTH, D_MODEL), SGU_WIDTH ** -0.5),
        'w_out': nrm((L, D_MODEL, D_MODEL), D_MODEL ** -0.5),
        'ffn_w_gate': nrm((N_DENSE_LAYERS, D_MODEL, FFN_DENSE), D_MODEL ** -0.5),
        'ffn_w_up': nrm((N_DENSE_LAYERS, D_MODEL, FFN_DENSE), D_MODEL ** -0.5),
        'ffn_w_down': nrm((N_DENSE_LAYERS, FFN_DENSE, D_MODEL), FFN_DENSE ** -0.5),
        'moe_router': nrm((N_MOE_LAYERS, D_MODEL, N_EXPERTS), D_MODEL ** -0.5),
        'moe_w_gate': nrm((N_MOE_LAYERS, N_EXPERTS, D_MODEL, FFN_EXPERT), D_MODEL ** -0.5),
        'moe_w_up': nrm((N_MOE_LAYERS, N_EXPERTS, D_MODEL, FFN_EXPERT), D_MODEL ** -0.5),
        'moe_w_down': nrm((N_MOE_LAYERS, N_EXPERTS, FFN_EXPERT, D_MODEL), FFN_EXPERT ** -0.5),
    }


def reference(x, positions, norm_mix, norm_ffn, norm_final, w_in,
              ssm_a_re, ssm_a_im, ssm_log_dt, ssm_b_re, ssm_b_im, ssm_c_re, ssm_c_im, ssm_d, ssm_glu_w,
              gdn_conv_w, gdn_a_log, gdn_dt_bias, gdn_norm,
              nsa_cmp_k_pe, nsa_cmp_k_w1, nsa_cmp_k_w2, nsa_cmp_v_pe, nsa_cmp_v_w1, nsa_cmp_v_w2, rel_bias,
              sgu_ln_g, sgu_ln_b, sgu_w, sgu_b,
              w_br_ssm, w_br_gdn, w_br_nsa, w_br_sgu, w_out,
              ffn_w_gate, ffn_w_up, ffn_w_down,
              moe_router, moe_w_gate, moe_w_up, moe_w_down):
    bs, s, _ = x.shape
    for layer in range(DEPTH):
        h = rms_norm(x, norm_mix[layer])
        (p_ssm, p_qkv, p_a, p_b, p_z, p_nq, p_kc, p_vc, p_ks, p_vs, p_kw, p_vw,
         p_ng, p_sgu, p_gate) = split_columns(h @ w_in[layer])
        y_ssm = ssm_mixer(p_ssm, ssm_a_re[layer], ssm_a_im[layer], ssm_log_dt[layer], ssm_b_re[layer],
                          ssm_b_im[layer], ssm_c_re[layer], ssm_c_im[layer], ssm_d[layer], ssm_glu_w[layer])
        y_gdn = gdn_mixer(p_qkv, p_a, p_b, p_z, gdn_conv_w[layer], gdn_a_log[layer], gdn_dt_bias[layer],
                          gdn_norm[layer])
        y_nsa = nsa_mixer(p_nq, p_kc, p_vc, p_ks, p_vs, p_kw, p_vw, p_ng, positions,
                          nsa_cmp_k_pe[layer], nsa_cmp_k_w1[layer], nsa_cmp_k_w2[layer],
                          nsa_cmp_v_pe[layer], nsa_cmp_v_w1[layer], nsa_cmp_v_w2[layer], rel_bias)
        y_sgu = sgu_mixer(p_sgu, sgu_ln_g[layer], sgu_ln_b[layer], sgu_w[layer], sgu_b[layer])
        gates = jax.nn.sigmoid(p_gate).reshape(bs, s, N_BRANCH, D_MODEL)
        merged = (gates[:, :, 0] * (y_ssm @ w_br_ssm[layer])
                  + gates[:, :, 1] * (y_gdn @ w_br_gdn[layer])
                  + gates[:, :, 2] * (y_nsa @ w_br_nsa[layer])
                  + gates[:, :, 3] * (y_sgu @ w_br_sgu[layer]))
        x = x + merged @ w_out[layer]
        h = rms_norm(x, norm_ffn[layer])
        if layer % 2 == 0:
            i = layer // 2
            x = x + swiglu(h, ffn_w_gate[i], ffn_w_up[i], ffn_w_down[i])
        else:
            i = layer // 2
            x = x + moe_ffn(h, moe_router[i], moe_w_gate[i], moe_w_up[i], moe_w_down[i])
    return rms_norm(x, norm_final)
```

```cpp
#include <hip/hip_runtime.h>
#include <cstdio>
#include <cstdint>
namespace pg8 {
#define PG8_LAS __attribute__((address_space(3)))
typedef unsigned short bf16_t;
typedef short bf16x8 __attribute__((ext_vector_type(8)));
typedef float f32x4 __attribute__((ext_vector_type(4)));
typedef unsigned u32x4 __attribute__((ext_vector_type(4)));
constexpr int BM = 256, BK = 64, HALF = 128, HTB = HALF * BK * 2  , STAGE_BYTES = 8 * HTB, NXCD = 8, WGM = 8;

__host__ __device__ __forceinline__ int lds_byte(int r, int c) { const int st = (r >> 4) * 2 + (c >> 5), rr = r & 15, cc = c & 31, ob = rr * 64 + cc * 2; return st * 1024 + (ob ^ (((ob >> 9) & 1) << 5)); }
__host__ __device__ __forceinline__ void stage_rc(int b, int& R, int& C) { const int st = b / 1024, sb = b % 1024, swz = sb ^ (((sb >> 9) & 1) << 5); R = (st >> 1) * 16 + swz / 64; C = (st & 1) * 32 + (swz % 64) / 2; }
__host__ __device__ __forceinline__ int perm32(int rho) { const int n = rho >> 4, i = rho & 15; return 8 * (i >> 2) + 4 * n + (i & 3); }

struct Unit { int pm, pn; };
struct Gemm { const bf16_t* A; const bf16_t* Bt; int M, N, K; };

struct StaticOrder {
    int nM, nN, nwg, G, c;
    __host__ __device__ void init(int M, int N, int G_, int c_) { nM = M / BM; nN = N / BM; nwg = nM * nN; G = G_; c = c_; }
    __host__ __device__ bool next(int i, Unit& u) const {
        const long L = (long)i * G + c; if (L >= nwg) return false;
        int wgid = (int)L; { const int q = nwg / NXCD, r = nwg % NXCD, xcd = wgid % NXCD, off = wgid / NXCD; wgid = (xcd < r ? xcd * (q + 1) : r * (q + 1) + (xcd - r) * q) + off; }
        const int nig = WGM * nN, gid = wgid / nig, fm = gid * WGM, gsz = (nM - fm) < WGM ? (nM - fm) : WGM;
        u.pm = fm + ((wgid % nig) % gsz); u.pn = (wgid % nig) / gsz; return true;
    }
    __device__ __forceinline__ void a_ready(const Unit&) const {}
    __device__ __forceinline__ void done(const Unit&) const {}
};

typedef __bf16 bf16x2_cv __attribute__((ext_vector_type(2)));
typedef float f32x2_cv __attribute__((ext_vector_type(2)));
__device__ __forceinline__ unsigned cvt_pk_bf16(float lo, float hi) { const f32x2_cv v = {lo, hi}; const bf16x2_cv b = __builtin_convertvector(v, bf16x2_cv); return __builtin_bit_cast(unsigned, b); }
typedef float f32x2 __attribute__((ext_vector_type(2)));
__device__ __forceinline__ f32x2 gelu_pk(f32x2 v) {
    const f32x2 av = __builtin_elementwise_abs(v), d = av * 0.2316418882f + 1.0f;
    f32x2 t; t.x = __builtin_amdgcn_rcpf(d.x); t.y = __builtin_amdgcn_rcpf(d.y);
    f32x2 q = t * 0.5307027145f + (-0.7265760135f); q = q * t + 0.7107068705f; q = q * t + (-0.142248368f); q = q * t + 0.127414796f; q = q * t;
    const f32x2 s = (v * v) * (-0.72134752044f);
    f32x2 e; e.x = __builtin_amdgcn_exp2f(s.x); e.y = __builtin_amdgcn_exp2f(s.y);
    const f32x2 m = v * (q * e), r = v - m;
    f32x2 o; o.x = v.x < 0.f ? m.x : r.x; o.y = v.y < 0.f ? m.y : r.y; return o;
}

template <int ACT  > struct EpiBf16 {
    static constexpr bool PERM = true, AFTER_DRAIN = false; static_assert(ACT == 0 || ACT == 1, "EpiBf16: ACT is 0 (none) or 1 (gelu_pk)");
    bf16_t* O; int ldc; const float* bias; int split_cols; size_t split_stride; float scale0;
    __device__ __forceinline__ void operator()(const f32x4 (&acc)[2][2][4][2], const Unit& u, int wr, int wc, int fr, int fq) const {
        const int row0 = u.pm * BM + wr * 64 + fr; int colt = u.pn * BM; bf16_t* base = O;
        float sc = 1.f; if (split_cols) { const int t = colt / split_cols; base += (size_t)t * split_stride; colt -= t * split_cols; if (t == 0) sc = scale0; }
        const int col0 = colt + wc * 32 + 8 * fq, bcol0 = u.pn * BM + wc * 32 + 8 * fq;
        f32x4 bv[2][2];
#pragma unroll
        for (int bj = 0; bj < 2; ++bj)
#pragma unroll
            for (int n = 0; n < 2; ++n) bv[bj][n] = bias ? *(const f32x4*)(bias + bcol0 + bj * HALF + 4 * n) : (f32x4){0.f, 0.f, 0.f, 0.f};
#pragma unroll
        for (int ai = 0; ai < 2; ++ai)
#pragma unroll
            for (int m = 0; m < 4; ++m) { bf16_t* rowp = base + (size_t)(row0 + ai * HALF + m * 16) * ldc + col0;
#pragma unroll
                for (int bj = 0; bj < 2; ++bj) { f32x4 v0 = acc[ai][bj][m][0] + bv[bj][0], v1 = acc[ai][bj][m][1] + bv[bj][1];
                    if (ACT == 1) { f32x2 a = gelu_pk((f32x2){v0[0], v0[1]}), b = gelu_pk((f32x2){v0[2], v0[3]}), c = gelu_pk((f32x2){v1[0], v1[1]}), d = gelu_pk((f32x2){v1[2], v1[3]});
                        v0 = (f32x4){a.x, a.y, b.x, b.y}; v1 = (f32x4){c.x, c.y, d.x, d.y}; }
                    v0 = v0 * sc; v1 = v1 * sc; u32x4 w; w.x = cvt_pk_bf16(v0[0], v0[1]); w.y = cvt_pk_bf16(v0[2], v0[3]); w.z = cvt_pk_bf16(v1[0], v1[1]); w.w = cvt_pk_bf16(v1[2], v1[3]);
                    *(u32x4*)(rowp + bj * HALF) = w; } }
    }
};
template <class Epi, class Sched, bool ALIGN_EPI = false, bool SP2 = false>
__device__ __forceinline__ void gemm_phase(PG8_LAS unsigned char* lds, const Gemm g, const Sched& S, const Epi& E) {
    int tid_l = threadIdx.x; asm volatile("" : "+v"(tid_l));
    const int tid = tid_l, wid = __builtin_amdgcn_readfirstlane(tid >> 6), lane = tid & 63, wr = wid >> 2, wc = wid & 3, fr = lane & 15, fq = lane >> 4;
    const int K = g.K, nt = K / BK;
    unsigned voffA[2], voffB[2];
#pragma unroll
    for (int i = 0; i < 2; ++i) { int R, C; stage_rc(tid * 16 + i * 8192, R, C); const int Rb = Epi::PERM ? ((R & ~31) + perm32(R & 31)) : R;
        voffA[i] = (unsigned)(R * K + C) * 2u; voffB[i] = (unsigned)(Rb * K + C) * 2u; }
    const size_t kstep = (size_t)(BK * 2);
    const size_t hstep = (size_t)HALF * K * 2;
    const size_t tstep = 2 * hstep;
    const unsigned ldsw = (unsigned)wid * 1024u;
    const int aoff = lds_byte(wr * 64 + fr, fq * 8), boff = lds_byte(wc * 32 + fr, fq * 8);
#define PG8_SA(b, h) (((b) * 2 + (h)) * HTB)
#define PG8_SB(b, h) ((4 + (b) * 2 + (h)) * HTB)
#define PG8_STAGE(bufoff, gbase, voff) do { _Pragma("unroll") for (int _i = 0; _i < 2; ++_i) \
        __builtin_amdgcn_global_load_lds((const unsigned*)((const char*)(gbase) + (voff)[_i]), (PG8_LAS unsigned*)(lds + (bufoff) + ldsw + _i * 8192), 16, 0, 0); } while (0)
#define PG8_LDA(dst, b, h) do { _Pragma("unroll") for (int m = 0; m < 4; ++m) _Pragma("unroll") for (int k = 0; k < 2; ++k) dst[m][k] = *(const PG8_LAS bf16x8*)(lds + PG8_SA(b, h) + aoff + m * 2048 + k * 1024); } while (0)
#define PG8_LDB(dst, b, h) do { _Pragma("unroll") for (int n = 0; n < 2; ++n) _Pragma("unroll") for (int k = 0; k < 2; ++k) dst[n][k] = *(const PG8_LAS bf16x8*)(lds + PG8_SB(b, h) + boff + n * 2048 + k * 1024); } while (0)
#define PG8_MMA(ai, bj, At, Bt) do { __builtin_amdgcn_s_setprio(1); _Pragma("unroll") for (int m = 0; m < 4; ++m) _Pragma("unroll") for (int n = 0; n < 2; ++n) _Pragma("unroll") for (int k = 0; k < 2; ++k) \
        acc[ai][bj][m][n] = __builtin_amdgcn_mfma_f32_16x16x32_bf16(Bt[n][k], At[m][k], acc[ai][bj][m][n], 0, 0, 0); __builtin_amdgcn_s_setprio(0); } while (0)
#define PG8_WAIT_V(n) asm volatile("s_waitcnt vmcnt(" #n ")" ::: "memory")
#define PG8_WAIT_L(n) asm volatile("s_waitcnt lgkmcnt(" #n ")" ::: "memory")
#define PG8_BAR __builtin_amdgcn_s_barrier()
#define PG8_SCHED __builtin_amdgcn_sched_barrier(0)
    Unit cur, nxt; int ui = 0;
    if (!S.next(0, cur)) return;
    f32x4 acc[2][2][4][2];
#pragma unroll
    for (int a = 0; a < 2; ++a)
#pragma unroll
        for (int b = 0; b < 2; ++b)
#pragma unroll
            for (int m = 0; m < 4; ++m)
#pragma unroll
                for (int n = 0; n < 2; ++n) acc[a][b][m][n] = (f32x4){0.f, 0.f, 0.f, 0.f};
    bf16x8 At[4][2], B0[2][2], B1[2][2];
    const char* cA = (const char*)g.A + (size_t)cur.pm * tstep; const char* cB = (const char*)g.Bt + (size_t)cur.pn * tstep;
    S.a_ready(cur);
    if constexpr (SP2) {
        PG8_STAGE(PG8_SB(0, 0), cB, voffB); PG8_STAGE(PG8_SB(0, 1), cB + hstep, voffB); PG8_STAGE(PG8_SA(0, 0), cA, voffA); PG8_STAGE(PG8_SA(0, 1), cA + hstep, voffA);
        if (wr == 1) PG8_BAR;
        PG8_WAIT_V(2); PG8_BAR;
        PG8_STAGE(PG8_SB(1, 0), cB + kstep, voffB); PG8_STAGE(PG8_SA(1, 0), cA + kstep, voffA); PG8_STAGE(PG8_SB(1, 1), cB + hstep + kstep, voffB);
        PG8_WAIT_V(6); PG8_BAR;
    } else {
        PG8_STAGE(PG8_SB(0, 0), cB, voffB); PG8_STAGE(PG8_SA(0, 0), cA, voffA); PG8_STAGE(PG8_SB(0, 1), cB + hstep, voffB); PG8_STAGE(PG8_SA(0, 1), cA + hstep, voffA);
        if (wr == 1) PG8_BAR;
        PG8_WAIT_V(4); PG8_BAR;
        PG8_STAGE(PG8_SB(1, 0), cB + kstep, voffB); PG8_STAGE(PG8_SA(1, 0), cA + kstep, voffA); PG8_STAGE(PG8_SB(1, 1), cB + hstep + kstep, voffB);
        PG8_WAIT_V(6); PG8_BAR;
    }
    for (;;) {
        const bool has_next = S.next(ui + 1, nxt);
        const char* nA = has_next ? (const char*)g.A + (size_t)nxt.pm * tstep : cA; const char* nB = has_next ? (const char*)g.Bt + (size_t)nxt.pn * tstep : cB;
        for (int t = 0; t < nt; t += 2) {
            const bool last = (t == nt - 2);
            const char* a1 = cA + (size_t)(t + 1) * kstep;
            const char* a2 = last ? nA : cA + (size_t)(t + 2) * kstep; const char* b2 = last ? nB : cB + (size_t)(t + 2) * kstep;
            const char* a3 = a2 + kstep; const char* b3 = b2 + kstep;
            if (last && has_next) S.a_ready(nxt);
            if constexpr (SP2) {
            PG8_LDB(B0, 0, 0); PG8_LDB(B1, 0, 1); PG8_SCHED; PG8_LDA(At, 0, 0); PG8_STAGE(PG8_SA(1, 1), a1 + hstep, voffA);
            PG8_WAIT_V(8); PG8_WAIT_L(0); PG8_BAR; PG8_MMA(0, 0, At, B0); PG8_MMA(0, 1, At, B1); PG8_BAR; PG8_SCHED;
            PG8_LDA(At, 0, 1); PG8_STAGE(PG8_SB(0, 0), b2, voffB); PG8_STAGE(PG8_SB(0, 1), b2 + hstep, voffB); PG8_STAGE(PG8_SA(0, 0), a2, voffA);
            PG8_WAIT_V(8); PG8_WAIT_L(0); PG8_BAR; PG8_MMA(1, 0, At, B0); PG8_MMA(1, 1, At, B1); PG8_BAR; PG8_SCHED;
            PG8_LDB(B0, 1, 0); PG8_LDB(B1, 1, 1); PG8_SCHED; PG8_LDA(At, 1, 0); PG8_STAGE(PG8_SA(0, 1), a2 + hstep, voffA);
            PG8_WAIT_V(8); PG8_WAIT_L(0); PG8_BAR; PG8_MMA(0, 0, At, B0); PG8_MMA(0, 1, At, B1); PG8_BAR; PG8_SCHED;
            PG8_LDA(At, 1, 1); PG8_STAGE(PG8_SB(1, 0), b3, voffB); PG8_STAGE(PG8_SB(1, 1), b3 + hstep, voffB); PG8_STAGE(PG8_SA(1, 0), a3, voffA);
            PG8_WAIT_V(8); PG8_WAIT_L(0); PG8_BAR; PG8_MMA(1, 0, At, B0); PG8_MMA(1, 1, At, B1); PG8_BAR; PG8_SCHED;
            } else {
            PG8_LDB(B0, 0, 0); PG8_SCHED; PG8_LDA(At, 0, 0); PG8_STAGE(PG8_SA(1, 1), a1 + hstep, voffA);
            PG8_WAIT_L(8); PG8_BAR; PG8_WAIT_L(0); PG8_MMA(0, 0, At, B0); PG8_BAR; PG8_SCHED;
            PG8_LDB(B1, 0, 1); PG8_STAGE(PG8_SB(0, 0), b2, voffB);
            PG8_BAR; PG8_WAIT_L(0); PG8_MMA(0, 1, At, B1); PG8_BAR;
            PG8_LDA(At, 0, 1); PG8_STAGE(PG8_SA(0, 0), a2, voffA);
            PG8_BAR; PG8_WAIT_L(0); PG8_MMA(1, 0, At, B0); PG8_BAR; PG8_SCHED;
            PG8_STAGE(PG8_SB(0, 1), b2 + hstep, voffB);
            PG8_WAIT_V(6); PG8_BAR; PG8_MMA(1, 1, At, B1); PG8_BAR;
            PG8_LDB(B0, 1, 0); PG8_SCHED; PG8_LDA(At, 1, 0); PG8_STAGE(PG8_SA(0, 1), a2 + hstep, voffA);
            PG8_WAIT_L(8); PG8_BAR; PG8_WAIT_L(0); PG8_MMA(0, 0, At, B0); PG8_BAR; PG8_SCHED;
            PG8_LDB(B1, 1, 1); PG8_STAGE(PG8_SB(1, 0), b3, voffB);
            PG8_BAR; PG8_WAIT_L(0); PG8_MMA(0, 1, At, B1); PG8_BAR;
            PG8_LDA(At, 1, 1); PG8_STAGE(PG8_SA(1, 0), a3, voffA);
            PG8_BAR; PG8_WAIT_L(0); PG8_MMA(1, 0, At, B0); PG8_BAR; PG8_SCHED;
            PG8_STAGE(PG8_SB(1, 1), b3 + hstep, voffB);
            PG8_WAIT_V(6); PG8_BAR; PG8_MMA(1, 1, At, B1); PG8_BAR;
            }
        }
        if constexpr (ALIGN_EPI) { if (wr == 0) PG8_BAR; }
        if constexpr (!Epi::AFTER_DRAIN) { E(acc, cur, wr, wc, fr, fq); S.done(cur); }
        if (!has_next) break;
#pragma unroll
        for (int a = 0; a < 2; ++a)
#pragma unroll
            for (int b = 0; b < 2; ++b)
#pragma unroll
                for (int m = 0; m < 4; ++m)
#pragma unroll
                    for (int n = 0; n < 2; ++n) acc[a][b][m][n] = (f32x4){0.f, 0.f, 0.f, 0.f};
        cur = nxt; cA = nA; cB = nB; ++ui;
        if constexpr (ALIGN_EPI) { if (wr == 1) PG8_BAR; }
    }
    PG8_WAIT_V(0);
    if constexpr (!ALIGN_EPI) { if (wr == 0) PG8_BAR; }
    PG8_BAR;
    if constexpr (Epi::AFTER_DRAIN) { E.fused(acc, cur, wr, wc, fr, fq, lds, wid, lane); S.done(cur); }
#undef PG8_SA
#undef PG8_SB
#undef PG8_STAGE
#undef PG8_LDA
#undef PG8_LDB
#undef PG8_MMA
#undef PG8_WAIT_V
#undef PG8_WAIT_L
#undef PG8_BAR
#undef PG8_SCHED
}
}

#define GAS __attribute__((address_space(1)))
#define LAS __attribute__((address_space(3)))
typedef unsigned short bf16;
typedef unsigned v4u __attribute__((ext_vector_type(4)));
typedef float f32x4 __attribute__((ext_vector_type(4)));
typedef short bf16x8 __attribute__((ext_vector_type(8)));
typedef GAS unsigned gu32;
typedef GAS unsigned long long gu64;
#define RLX_AGENT __ATOMIC_RELAXED, __HIP_MEMORY_SCOPE_AGENT
#define LDS_WAIT() asm volatile("s_waitcnt lgkmcnt(0)" ::: "memory")
#define VM_WAIT() asm volatile("s_waitcnt vmcnt(0)" ::: "memory")
__device__ __forceinline__ unsigned long long rt() { return __builtin_amdgcn_s_memrealtime(); }
__device__ __forceinline__ unsigned f2bf(float f) { unsigned u = __builtin_bit_cast(unsigned, f); return (u + 0x7fffu + ((u >> 16) & 1u)) >> 16; }
__device__ __forceinline__ unsigned pk2(float lo, float hi) { return f2bf(lo) | (f2bf(hi) << 16); }

#define XB_TMO      128
#define XB_XCNT(j)  (256  + 64 * (j))
#define XB_XSUB(j)  (1280 + 64 * (j))
#define XB_XGEN(j)  (2304 + 64 * (j))
#define XB_TOP      3328
#define XB_TOPGEN   3392
#define XCD_BAR_WORDS 3456
#define XB_SPIN_CAP (1u << 18)

__device__ __forceinline__ unsigned xb_ld(unsigned* p)              { return __hip_atomic_load(p, __ATOMIC_RELAXED, __HIP_MEMORY_SCOPE_AGENT); }
__device__ __forceinline__ unsigned xb_add(unsigned* p, unsigned v) { return __hip_atomic_fetch_add(p, v, __ATOMIC_RELAXED, __HIP_MEMORY_SCOPE_AGENT); }
__device__ __forceinline__ unsigned xb_xcc_id() { return (unsigned)__builtin_amdgcn_s_getreg((3 << 11) | 20) & 0xFu; }
#define XB_SPIN(cond, bar) do { unsigned _sp = 0; while (cond) { __builtin_amdgcn_s_sleep(1); \
    if ((++_sp & 255u) == 0u) { if (xb_ld(&(bar)[XB_TMO])) break; if (_sp > XB_SPIN_CAP) { atomicAdd(&(bar)[XB_TMO], 1u); break; } } } } while (0)

struct XcdBarrier {
    unsigned* bar; unsigned x;
    volatile LAS unsigned* st;
};

__device__ __forceinline__ XcdBarrier xcd_barrier_post(unsigned* bar, volatile LAS unsigned* st) {
    XcdBarrier b; b.bar = bar; b.x = xb_xcc_id(); b.st = st;
    if (threadIdx.x == 0) (void)xb_add(&bar[XB_XCNT(b.x)], 1u);
    return b;
}
__device__ __forceinline__ void xcd_barrier_complete(unsigned* bar, unsigned x, unsigned& nloc, unsigned& nx) {
    const unsigned G = gridDim.x * gridDim.y * gridDim.z;
    unsigned sum, cnt, mine, sp = 0u;
    for (;;) {
        sum = 0u; cnt = 0u; mine = 0u;
#pragma unroll
        for (unsigned j = 0; j < 16; ++j) { const unsigned c = xb_ld(&bar[XB_XCNT(j)]); sum += c; cnt += (c > 0u) ? 1u : 0u; mine = (j == x) ? c : mine; }
        if (sum == G) break;
        __builtin_amdgcn_s_sleep(1);
        if ((++sp & 255u) == 0u) { if (xb_ld(&bar[XB_TMO])) break; if (sp > XB_SPIN_CAP) { atomicAdd(&bar[XB_TMO], 1u); break; } }
    }
    nloc = mine > 0u ? mine : 1u; nx = cnt > 0u ? cnt : 1u;
}

__device__ __forceinline__ void xcd_barrier(const XcdBarrier& b) {
    asm volatile("s_waitcnt vmcnt(0)" ::: "memory");
    __syncthreads();
    if (threadIdx.x == 0) {
        unsigned* bar = b.bar;
        __builtin_amdgcn_s_waitcnt(0);
        unsigned nloc = b.st[0], nx = b.st[1];
        if (nloc == 0u) { xcd_barrier_complete(bar, b.x, nloc, nx); b.st[0] = nloc; b.st[1] = nx; }
        const unsigned old = xb_add(&bar[XB_XSUB(b.x)], 1u);
        const unsigned gen = old / nloc;
        if (old + 1u == (gen + 1u) * nloc) {
            __builtin_amdgcn_fence(__ATOMIC_RELEASE, "agent");
            asm volatile("s_waitcnt vmcnt(0)" ::: "memory");
            const unsigned og = xb_add(&bar[XB_TOP], 1u);
            const unsigned tg = og / nx;
            if (og + 1u == (tg + 1u) * nx) xb_add(&bar[XB_TOPGEN], 1u);
            else XB_SPIN(xb_ld(&bar[XB_TOPGEN]) == tg, bar);
            __builtin_amdgcn_fence(__ATOMIC_ACQUIRE, "agent");
            xb_add(&bar[XB_XGEN(b.x)], 1u);
            asm volatile("s_waitcnt vmcnt(0)" ::: "memory");
        } else {
            XB_SPIN(xb_ld(&bar[XB_XGEN(b.x)]) == gen, bar);
            __builtin_amdgcn_fence(__ATOMIC_ACQUIRE, "agent");
            asm volatile("s_waitcnt vmcnt(0)" ::: "memory");
        }
    }
    __syncthreads();
}

constexpr int NWAVES = 8, NTHR = 512;
constexpr int BATCH = 2, SEQ = 8192, T = BATCH * SEQ, DM = 1024;
constexpr int IN_COLS = 8992, PMW = 5120, NMIX = 4896, NGATE = 4096;
constexpr int C_U = 0, C_QKV = 512, C_A = 2048, C_B = 2052, C_Z = 2056, C_NQ = 2568, C_KC = 3080, C_VC = 3208, C_KS = 3336, C_VS = 3464, C_KW = 3592, C_VW = 3720, C_NG = 3848, C_SGU = 3872;
constexpr int FFD = 2816, FFE = 3584, NEXP = 8;
constexpr int NCMP = 511;
constexpr int PASS_TILES = 68;
constexpr float RMS_EPS = 1e-6f;
#ifndef MK_MULTI
#define MK_MULTI 1
#endif
constexpr int NPH = 28;
#ifndef ABL
#define ABL 0
#endif
#ifndef NANFILL
#define NANFILL 0
#endif
#ifndef SELFCHK
#define SELFCHK 0
#endif
#ifndef ABL_LAYERS
#define ABL_LAYERS 3
#endif
#ifndef MASK_T0
#define MASK_T0 0
#endif
#ifndef MASK_T1
#define MASK_T1 0
#endif

constexpr size_t MiB = 1u << 20;
constexpr size_t WS_CTL = 0, CTL_ZERO_BYTES = 1 * MiB;
constexpr int CW_BAR = 4096;
constexpr int CW_CNT = 16384;
constexpr size_t WS_ROWTOK = 1 * MiB;
constexpr size_t WS_TOKINFO = WS_ROWTOK + 512 * 1024;
constexpr size_t WS_TOKW = WS_TOKINFO + 128 * 1024;
constexpr size_t WS_GBETA = WS_TOKW + 128 * 1024;
constexpr size_t WS_GLA = WS_GBETA + 256 * 1024;
constexpr size_t WS_KCC = 3 * MiB;
constexpr size_t WS_W = 8 * MiB;
constexpr size_t W_IN1 = 0, W_IN2 = W_IN1 + (size_t)PMW * DM * 2, W_GLU = W_IN2 + (size_t)NGATE * DM * 2, W_BR = W_GLU + 512 * 512 * 2, W_OUT = W_BR + (size_t)4 * 1024 * 512 * 2, W_LAYER = W_OUT + (size_t)DM * DM * 2;
constexpr size_t WS_WL = WS_W;
constexpr size_t WS_FUP = WS_WL + 2 * W_LAYER;
constexpr size_t WS_FDN = WS_FUP + (size_t)2 * FFD * DM * 2;
constexpr size_t WS_MUP = WS_FDN + (size_t)FFD * DM * 2;
constexpr size_t WS_MDN = WS_MUP + (size_t)NEXP * 2 * FFE * DM * 2;
constexpr size_t WS_WEND = WS_MDN + (size_t)NEXP * FFE * DM * 2;
static_assert(WS_WEND <= 244 * MiB, "weights region");
constexpr size_t WS_GQ = WS_MDN, WS_GK = WS_GQ + (size_t)T * 512 * 2, WS_GV = WS_GK + (size_t)T * 512 * 2;
static_assert(WS_GV + (size_t)T * 512 * 2 <= WS_WEND, "scratch E");
constexpr size_t WS_A = 244 * MiB;
constexpr size_t WS_YM = WS_A + 119 * MiB;
constexpr size_t WS_B = 404 * MiB;
constexpr size_t WS_D = 468 * MiB;
constexpr size_t WS_C = 500 * MiB;
constexpr size_t WS_END = 532 * MiB;

constexpr int RING_BYTES = 131072;
constexpr int LDSCTL_OFF = RING_BYTES, MISC_OFF = LDSCTL_OFF + 320;
constexpr int LDS_BYTES = 147456;

__device__ __forceinline__ float bf2f(unsigned short b) { return __uint_as_float(((unsigned)b) << 16); }
__device__ __forceinline__ float bflo(unsigned w) { return __uint_as_float(w << 16); }
__device__ __forceinline__ float bfhi(unsigned w) { return __uint_as_float(w & 0xffff0000u); }
__device__ __forceinline__ float sigm(float x) { return __builtin_amdgcn_rcpf(1.f + __expf(-x)); }
__device__ __forceinline__ float gelu_t(float x) { const float u = 1.5957691216f * (x + 0.044715f * x * x * x); return x * sigm(u); }
__device__ __forceinline__ float silu_f(float x) { return x * sigm(x); }
__device__ __forceinline__ float wave_sum(float v) {
#pragma unroll
    for (int o = 1; o < 64; o <<= 1) v += __shfl_xor(v, o);
    return v;
}
__device__ __forceinline__ float wave_max(float v) {
#pragma unroll
    for (int o = 1; o < 64; o <<= 1) v = fmaxf(v, __shfl_xor(v, o));
    return v;
}

namespace pg8 {
struct EpiStore {
    static constexpr bool PERM = true, AFTER_DRAIN = false;
    bf16_t* O; int ldc; int pnmod; int act;
    __device__ __forceinline__ void operator()(const f32x4 (&acc)[2][2][4][2], const Unit& u, int wr, int wc, int fr, int fq) const {
        const int row0 = u.pm * BM + wr * 64 + fr, col0 = (u.pn % pnmod) * BM + wc * 32 + 8 * fq;
#pragma unroll
        for (int ai = 0; ai < 2; ++ai)
#pragma unroll
            for (int m = 0; m < 4; ++m) { bf16_t* rowp = O + (size_t)(row0 + ai * HALF + m * 16) * ldc + col0;
#pragma unroll
                for (int bj = 0; bj < 2; ++bj) { f32x4 v0 = acc[ai][bj][m][0], v1 = acc[ai][bj][m][1];
                    if (act == 1) {
#pragma unroll
                        for (int j = 0; j < 4; ++j) { v0[j] = sigm(v0[j]); v1[j] = sigm(v1[j]); } }
                    u32x4 w; w.x = cvt_pk_bf16(v0[0], v0[1]); w.y = cvt_pk_bf16(v0[2], v0[3]); w.z = cvt_pk_bf16(v1[0], v1[1]); w.w = cvt_pk_bf16(v1[2], v1[3]);
                    *(u32x4*)(rowp + bj * HALF) = w; } }
    }
};
struct EpiSwiGLU {
    static constexpr bool PERM = true, AFTER_DRAIN = false;
    bf16_t* O; int ldc; int npn;
    __device__ __forceinline__ void operator()(const f32x4 (&acc)[2][2][4][2], const Unit& u, int wr, int wc, int fr, int fq) const {
        const int row0 = u.pm * BM + wr * 64 + fr, col0 = (u.pn % npn) * HALF + wc * 32 + 8 * fq;
#pragma unroll
        for (int ai = 0; ai < 2; ++ai)
#pragma unroll
            for (int m = 0; m < 4; ++m) { bf16_t* rowp = O + (size_t)(row0 + ai * HALF + m * 16) * ldc + col0;
                f32x4 v0, v1;
#pragma unroll
                for (int j = 0; j < 4; ++j) { v0[j] = silu_f(acc[ai][0][m][0][j]) * acc[ai][1][m][0][j]; v1[j] = silu_f(acc[ai][0][m][1][j]) * acc[ai][1][m][1][j]; }
                u32x4 w; w.x = cvt_pk_bf16(v0[0], v0[1]); w.y = cvt_pk_bf16(v0[2], v0[3]); w.z = cvt_pk_bf16(v1[0], v1[1]); w.w = cvt_pk_bf16(v1[2], v1[3]);
                *(u32x4*)rowp = w; }
    }
};
struct EpiResid {
    static constexpr bool PERM = false, AFTER_DRAIN = false;
    const float* base; float* out; int ldc;
    __device__ __forceinline__ void operator()(const f32x4 (&acc)[2][2][4][2], const Unit& u, int wr, int wc, int fr, int fq) const {
        const int row0 = u.pm * BM + wr * 64 + fr, col0 = u.pn * BM + wc * 32 + 4 * fq;
#pragma unroll
        for (int ai = 0; ai < 2; ++ai)
#pragma unroll
            for (int m = 0; m < 4; ++m) { const size_t off = (size_t)(row0 + ai * HALF + m * 16) * ldc + col0;
#pragma unroll
                for (int bj = 0; bj < 2; ++bj)
#pragma unroll
                    for (int n = 0; n < 2; ++n) { const size_t o = off + bj * HALF + n * 16; *(f32x4*)(out + o) = *(const f32x4*)(base + o) + acc[ai][bj][m][n]; } }
    }
};
struct EpiGLU {
    static constexpr bool PERM = true, AFTER_DRAIN = false;
    const bf16_t* ypre; bf16_t* O;
    __device__ __forceinline__ void operator()(const f32x4 (&acc)[2][2][4][2], const Unit& u, int wr, int wc, int fr, int fq) const {
        const int row0 = u.pm * BM + wr * 64 + fr, col0 = u.pn * BM + wc * 32 + 8 * fq;
#pragma unroll
        for (int ai = 0; ai < 2; ++ai)
#pragma unroll
            for (int m = 0; m < 4; ++m) { const size_t off = (size_t)(row0 + ai * HALF + m * 16) * 512 + col0;
#pragma unroll
                for (int bj = 0; bj < 2; ++bj) { const u32x4 y = *(const u32x4*)(ypre + off + bj * HALF); const f32x4 a0 = acc[ai][bj][m][0], a1 = acc[ai][bj][m][1];
                    u32x4 w; w.x = cvt_pk_bf16(bflo(y.x) * sigm(a0[0]), bfhi(y.x) * sigm(a0[1])); w.y = cvt_pk_bf16(bflo(y.y) * sigm(a0[2]), bfhi(y.y) * sigm(a0[3]));
                    w.z = cvt_pk_bf16(bflo(y.z) * sigm(a1[0]), bfhi(y.z) * sigm(a1[1])); w.w = cvt_pk_bf16(bflo(y.w) * sigm(a1[2]), bfhi(y.w) * sigm(a1[3]));
                    *(u32x4*)(O + off + bj * HALF) = w; } }
    }
};
struct EpiMerge {
    static constexpr bool PERM = true, AFTER_DRAIN = false;
    const bf16_t* gate; bf16_t* O; int abl;
    __device__ __forceinline__ void operator()(const f32x4 (&acc)[2][2][4][2], const Unit& u, int wr, int wc, int fr, int fq) const {
        const int b = u.pm >> 6, pm = u.pm & 63, pn = u.pn & 3;
        const int row0 = pm * BM + wr * 64 + fr, col0 = pn * BM + wc * 32 + 8 * fq;
        if (b > 0) { __builtin_amdgcn_fence(__ATOMIC_ACQUIRE, "agent"); asm volatile("s_waitcnt vmcnt(0)" ::: "memory"); }
#pragma unroll
        for (int ai = 0; ai < 2; ++ai)
#pragma unroll
            for (int m = 0; m < 4; ++m) { const int row = row0 + ai * HALF + m * 16;
#pragma unroll
                for (int bj = 0; bj < 2; ++bj) { const int c = col0 + bj * HALF;
                    const u32x4 g = *(const u32x4*)(gate + (size_t)row * NGATE + b * 1024 + c); f32x4 a0 = acc[ai][bj][m][0], a1 = acc[ai][bj][m][1];
                    if ((abl >> b) & 1) { a0 = (f32x4){0.f, 0.f, 0.f, 0.f}; a1 = a0; }
                    float v[8] = {bflo(g.x) * a0[0], bfhi(g.x) * a0[1], bflo(g.y) * a0[2], bfhi(g.y) * a0[3], bflo(g.z) * a1[0], bfhi(g.z) * a1[1], bflo(g.w) * a1[2], bfhi(g.w) * a1[3]};
                    bf16_t* op = O + (size_t)row * 1024 + c;
                    if (b > 0) { const u32x4 p = *(const u32x4*)op; v[0] += bflo(p.x); v[1] += bfhi(p.x); v[2] += bflo(p.y); v[3] += bfhi(p.y); v[4] += bflo(p.z); v[5] += bfhi(p.z); v[6] += bflo(p.w); v[7] += bfhi(p.w); }
                    u32x4 w; w.x = cvt_pk_bf16(v[0], v[1]); w.y = cvt_pk_bf16(v[2], v[3]); w.z = cvt_pk_bf16(v[4], v[5]); w.w = cvt_pk_bf16(v[6], v[7]);
                    *(u32x4*)op = w; } }
    }
};
struct MergeOrder {
    StaticOrder so;
    __device__ void init(int G_, int c_) { so.init(T, 1024, G_, c_); }
    __device__ bool next(int i, Unit& u) const { Unit t; if (!so.next(i >> 2, t)) return false; const int b = i & 3; u.pm = b * 64 + t.pm; u.pn = b * 4 + t.pn; return true; }
    __device__ __forceinline__ void a_ready(const Unit&) const {}
    __device__ __forceinline__ void done(const Unit&) const {}
};
struct MoeOrder {
    int ntp, tile0, ncol, G, c; int tb1, tb2, tb3, tb4, tb5, tb6, tb7;
    __device__ bool next(int i, Unit& u) const {
        const int L = i * G + c; if (L >= ntp * ncol) return false;
        const int pn = L / ntp, tl = L - pn * ntp, ti = tile0 + tl;
        const int e = (ti >= tb1) + (ti >= tb2) + (ti >= tb3) + (ti >= tb4) + (ti >= tb5) + (ti >= tb6) + (ti >= tb7);
        u.pm = tl; u.pn = e * ncol + pn; return true;
    }
    __device__ __forceinline__ void a_ready(const Unit&) const {}
    __device__ __forceinline__ void done(const Unit&) const {}
};
}

struct Args { const void* in[42]; float* out; unsigned char* ws; int ph_lo, ph_hi; };
__device__ __forceinline__ const void* inptr(const Args& a, int i) { asm volatile("" : "+s"(i)); return a.in[i]; }
__device__ __forceinline__ bool in_rng(int lo, int hi, int k) { asm volatile("" : "+s"(lo), "+s"(hi)); return lo <= k && k < hi; }
struct Frame {
    LAS unsigned char* lds;
    volatile LAS unsigned* MISC;
    gu32* ctl;
    int tid, lane, wave, vcu, G, gw, NGW;
};

__device__ __forceinline__ Frame relaunder_unused(const Frame& F) { Frame R = F; asm volatile("" : "+v"(R.tid), "+v"(R.lane), "+s"(R.wave), "+s"(R.vcu), "+s"(R.gw)); return R; }
__device__ __forceinline__ void tr_item(const float* W, int ldw, int K, bf16* WT, int k0, int n0, int drow0, LAS float* scr, int lane) {
#pragma unroll 8
    for (int i = 0; i < 32; ++i) { const int kk = 2 * i + (lane >> 5); scr[kk * 33 + (lane & 31)] = W[(size_t)(k0 + kk) * ldw + n0 + (lane & 31)]; }
    LDS_WAIT(); asm volatile("" ::: "memory");
    const int c = lane & 7;
#pragma unroll
    for (int j = 0; j < 4; ++j) { const int n = (lane >> 3) + 8 * j; const LAS float* s = scr + (8 * c) * 33 + n;
        v4u o; o.x = pk2(s[0 * 33], s[1 * 33]); o.y = pk2(s[2 * 33], s[3 * 33]); o.z = pk2(s[4 * 33], s[5 * 33]); o.w = pk2(s[6 * 33], s[7 * 33]);
        *(GAS v4u*)(WT + (size_t)(drow0 + n) * K + k0 + 8 * c) = o; }
    LDS_WAIT(); asm volatile("" ::: "memory");
}
__device__ __forceinline__ void tr_job(Frame& F, const float* W, int ldw, int K, int ncols, bf16* WT, int mode, int& base, LAS float* scr) {
    const int nblk = ncols / 32, nit = (K / 64) * nblk;
    int first = (F.gw - base) % F.NGW; if (first < 0) first += F.NGW;
    for (int it = first; it < nit; it += F.NGW) { const int kb = it / nblk, nb = it - kb * nblk, n0 = 32 * nb;
        const int drow = mode == 0 ? n0 : (256 * (n0 >> 7) + (n0 & 127) + (mode == 2 ? 128 : 0));
        tr_item(W, ldw, K, WT, 64 * kb, n0, drow, scr, F.lane); }
    base = (base + nit) % F.NGW;
}

__device__ __forceinline__ void p_prologue(Frame& F, const Args& a) {
    LAS float* scr = (LAS float*)(F.lds + F.wave * 16384);
    unsigned char* ws = a.ws; int base = 0;
#if NANFILL
    { const v4u qn = (v4u){0x7FC07FC0u, 0x7FC07FC0u, 0x7FC07FC0u, 0x7FC07FC0u};
      const size_t lo_[6] = {WS_A, WS_B, WS_C, WS_D, WS_MDN, WS_ROWTOK}, hi_[6] = {WS_B, WS_D, WS_END, WS_C, WS_WEND, 4 * MiB};
#pragma unroll
      for (int r = 0; r < 6; ++r) if ((NANFILL >> r) & 1) { v4u* p = (v4u*)(ws + lo_[r]); const size_t n = (hi_[r] - lo_[r]) / 16;
          for (size_t i = (size_t)F.gw * 64 + F.lane; i < n; i += (size_t)F.NGW * 64) p[i] = qn; } }
#endif
    for (int l = 0; l < 2; ++l) {
        unsigned char* wl = ws + WS_WL + (size_t)l * W_LAYER;
        const float* w_in = (const float*)inptr(a, 5) + (size_t)l * DM * IN_COLS;
        tr_job(F, w_in, IN_COLS, DM, NMIX, (bf16*)(wl + W_IN1), 0, base, scr);
        tr_job(F, w_in + NMIX, IN_COLS, DM, NGATE, (bf16*)(wl + W_IN2), 0, base, scr);
        tr_job(F, (const float*)inptr(a, 14) + (size_t)l * 512 * 512, 512, 512, 512, (bf16*)(wl + W_GLU), 0, base, scr);
        for (int b = 0; b < 4; ++b) tr_job(F, (const float*)inptr(a, 30 + b) + (size_t)l * 512 * 1024, 1024, 512, 1024, (bf16*)(wl + W_BR) + (size_t)b * 1024 * 512, 0, base, scr);
        tr_job(F, (const float*)inptr(a, 34) + (size_t)l * DM * DM, DM, DM, DM, (bf16*)(wl + W_OUT), 0, base, scr);
        { v4u* z = (v4u*)((bf16*)(wl + W_IN1) + (size_t)NMIX * DM); const int n16 = (PMW - NMIX) * DM * 2 / 16;
          for (int i = F.gw * 64 + F.lane; i < n16; i += F.NGW * 64) z[i] = (v4u){0u, 0u, 0u, 0u}; }
    }
    tr_job(F, (const float*)inptr(a, 35), FFD, DM, FFD, (bf16*)(ws + WS_FUP), 1, base, scr);
    tr_job(F, (const float*)inptr(a, 36), FFD, DM, FFD, (bf16*)(ws + WS_FUP), 2, base, scr);
    tr_job(F, (const float*)inptr(a, 37), DM, FFD, DM, (bf16*)(ws + WS_FDN), 0, base, scr);
    for (int e = 0; e < NEXP; ++e) {
        tr_job(F, (const float*)inptr(a, 39) + (size_t)e * DM * FFE, FFE, DM, FFE, (bf16*)(ws + WS_MUP) + (size_t)e * 2 * FFE * DM, 1, base, scr);
        tr_job(F, (const float*)inptr(a, 40) + (size_t)e * DM * FFE, FFE, DM, FFE, (bf16*)(ws + WS_MUP) + (size_t)e * 2 * FFE * DM, 2, base, scr);
    }
}
__device__ __forceinline__ void p_conv_moe_down(Frame& F, const Args& a) {
    LAS float* scr = (LAS float*)(F.lds + F.wave * 16384); int base = 0;
    for (int e = 0; e < NEXP; ++e) tr_job(F, (const float*)inptr(a, 41) + (size_t)e * FFE * DM, DM, FFE, DM, (bf16*)(a.ws + WS_MDN) + (size_t)e * DM * FFE, 0, base, scr);
}

template <bool ROUTER, bool INPLACE_F32>
__device__ __forceinline__ void p_norm(Frame& F, const float* xin, const float* gain, bf16* hout, float* fout, const float* router, const Args& a) {
    const f32x4 g0 = ((const f32x4*)gain)[F.lane], g1 = ((const f32x4*)gain)[F.lane + 64], g2 = ((const f32x4*)gain)[F.lane + 128], g3 = ((const f32x4*)gain)[F.lane + 192];
    for (int m = F.gw; m < T; m += F.NGW) {
        const f32x4* xr = (const f32x4*)(xin + (size_t)m * DM) + F.lane;
        f32x4 v[4]; float s = 0.f;
#pragma unroll
        for (int j = 0; j < 4; ++j) { v[j] = xr[64 * j]; s += (v[j].x * v[j].x + v[j].y * v[j].y) + (v[j].z * v[j].z + v[j].w * v[j].w); }
        const float rstd = 1.0f / sqrtf(wave_sum(s) * (1.f / DM) + RMS_EPS);
        v[0] = v[0] * rstd * g0; v[1] = v[1] * rstd * g1; v[2] = v[2] * rstd * g2; v[3] = v[3] * rstd * g3;
        if (INPLACE_F32) {
            if ((m & (SEQ - 1)) >= MASK_T0 && (m & (SEQ - 1)) < MASK_T1) { v[0] = (f32x4){0.f, 0.f, 0.f, 0.f}; v[1] = v[0]; v[2] = v[0]; v[3] = v[0]; }
            f32x4* o = (f32x4*)(fout + (size_t)m * DM) + F.lane;
#pragma unroll
            for (int j = 0; j < 4; ++j) o[64 * j] = v[j];
        } else {
            unsigned long long* o8 = (unsigned long long*)(hout + (size_t)m * DM) + F.lane;
#pragma unroll
            for (int j = 0; j < 4; ++j) o8[64 * j] = (unsigned long long)pk2(v[j].x, v[j].y) | ((unsigned long long)pk2(v[j].z, v[j].w) << 32);
        }
        if (ROUTER) {
            float lg[8];
#pragma unroll
            for (int e = 0; e < 8; ++e) lg[e] = 0.f;
#pragma unroll
            for (int j = 0; j < 4; ++j)
#pragma unroll
                for (int i = 0; i < 4; ++i) { const int c = 4 * (F.lane + 64 * j) + i; const f32x4 r0 = *(const f32x4*)(router + (size_t)c * 8), r1 = *(const f32x4*)(router + (size_t)c * 8 + 4); const float hv = v[j][i];
                    lg[0] += hv * r0.x; lg[1] += hv * r0.y; lg[2] += hv * r0.z; lg[3] += hv * r0.w; lg[4] += hv * r1.x; lg[5] += hv * r1.y; lg[6] += hv * r1.z; lg[7] += hv * r1.w; }
#pragma unroll
            for (int e = 0; e < 8; ++e) lg[e] = wave_sum(lg[e]);
            if (F.lane == 0) {
                int i1 = 0; float v1 = lg[0];
#pragma unroll
                for (int e = 1; e < 8; ++e) if (lg[e] > v1) { v1 = lg[e]; i1 = e; }
                int i2 = -1; float v2 = -3.0e38f;
#pragma unroll
                for (int e = 0; e < 8; ++e) if (e != i1 && lg[e] > v2) { v2 = lg[e]; i2 = e; }
                const float e2 = __expf(v2 - v1), w1 = 1.f / (1.f + e2), w2 = e2 / (1.f + e2);
                int* rowtok = (int*)(a.ws + WS_ROWTOK); int* tokinfo = (int*)(a.ws + WS_TOKINFO); float* tokw = (float*)(a.ws + WS_TOKW);
                const unsigned p1 = __hip_atomic_fetch_add((unsigned*)(F.ctl + CW_CNT + 64 * i1), 1u, RLX_AGENT);
                const unsigned p2 = __hip_atomic_fetch_add((unsigned*)(F.ctl + CW_CNT + 64 * i2), 1u, RLX_AGENT);
                rowtok[i1 * T + p1] = m; rowtok[i2 * T + p2] = m;
                tokinfo[2 * m] = (i1 << 16) | (int)p1; tokinfo[2 * m + 1] = (i2 << 16) | (int)p2; tokw[2 * m] = w1; tokw[2 * m + 1] = w2;
            }
        }
    }
}

struct MoeTiles { int cnt[8]; int tb[9]; };
__device__ __forceinline__ void moe_tiles(Frame& F, MoeTiles& mt) {
    int run = 0;
#pragma unroll
    for (int e = 0; e < 8; ++e) { const int c = (int)__hip_atomic_load((unsigned*)(F.ctl + CW_CNT + 64 * e), RLX_AGENT); mt.cnt[e] = c; mt.tb[e] = run; run += (c + 255) >> 8; }
    mt.tb[8] = run;
}
__device__ __forceinline__ int moe_expert_of(const MoeTiles& mt, int ti) {
    int e = 0;
#pragma unroll
    for (int k = 1; k < 8; ++k) e += (ti >= mt.tb[k]);
    return e;
}
__device__ __forceinline__ void p_moe_gather(Frame& F, const Args& a, const MoeTiles& mt, int pass) {
    const int tile0 = pass * PASS_TILES; int ntp = mt.tb[8] - tile0; ntp = ntp < 0 ? 0 : (ntp > PASS_TILES ? PASS_TILES : ntp);
    const bf16* H = (const bf16*)(a.ws + WS_C); bf16* HG = (bf16*)(a.ws + WS_B); const int* rowtok = (const int*)(a.ws + WS_ROWTOK);
    for (int r = F.gw; r < ntp * 256; r += F.NGW) {
        const int ti = tile0 + (r >> 8); const int e = moe_expert_of(mt, ti);
        int tbe = 0, ce = 0;
#pragma unroll
        for (int k = 0; k < 8; ++k) { tbe = (k == e) ? mt.tb[k] : tbe; ce = (k == e) ? mt.cnt[k] : ce; }
        const int rin = (ti - tbe) * 256 + (r & 255);
        v4u x0 = (v4u){0u, 0u, 0u, 0u}, x1 = x0;
        if (rin < ce) { const int tok = rowtok[e * T + rin]; const v4u* src = (const v4u*)(H + (size_t)tok * DM); x0 = src[F.lane]; x1 = src[F.lane + 64]; }
        v4u* dst = (v4u*)(HG + (size_t)r * DM); dst[F.lane] = x0; dst[F.lane + 64] = x1;
    }
}
__device__ __forceinline__ void p_moe_combine(Frame& F, const Args& a, const MoeTiles& mt, int pass) {
    const int tile0 = pass * PASS_TILES;
    const int* tokinfo = (const int*)(a.ws + WS_TOKINFO); const float* tokw = (const float*)(a.ws + WS_TOKW); const bf16* YM = (const bf16*)(a.ws + WS_YM);
    for (int m = F.gw; m < T; m += F.NGW) {
        f32x4* xr = (f32x4*)(a.out + (size_t)m * DM) + F.lane;
        bool any = false; f32x4 v[4];
#pragma unroll
        for (int k = 0; k < 2; ++k) {
            if ((ABL & 64) && k == 1) continue;
            if ((ABL & 128) && k == 0) continue;
            const int info = tokinfo[2 * m + k]; const int e = info >> 16, pos = info & 0xffff;
            int tbe = 0;
#pragma unroll
            for (int q = 0; q < 8; ++q) tbe = (q == e) ? mt.tb[q] : tbe;
            const int ti = tbe + (pos >> 8);
            if (ti >= tile0 && ti < tile0 + PASS_TILES) {
                if (!any) {
#pragma unroll
                    for (int j = 0; j < 4; ++j) v[j] = xr[64 * j];
                    any = true; }
                const float w = tokw[2 * m + k]; const int row = (ti - tile0) * 256 + (pos & 255);
                const unsigned long long* y8 = (const unsigned long long*)(YM + (size_t)row * DM) + F.lane;
#pragma unroll
                for (int j = 0; j < 4; ++j) { const unsigned long long y = y8[64 * j]; const unsigned lo = (unsigned)y, hi = (unsigned)(y >> 32);
                    v[j].x += w * bflo(lo); v[j].y += w * bfhi(lo); v[j].z += w * bflo(hi); v[j].w += w * bfhi(hi); }
            }
        }
        if (any) {
#pragma unroll
            for (int j = 0; j < 4; ++j) xr[64 * j] = v[j]; }
    }
}

struct LayerP {
    const float *a_re, *a_im, *log_dt, *b_re, *b_im, *c_re, *c_im, *ssm_d, *conv_w, *a_log, *dt_bias, *gdn_norm;
    const float *kpe, *kw1, *kw2, *vpe, *vw1, *vw2, *rel_bias, *ln_g, *ln_b, *sgu_w, *sgu_b; const int* pos;
};

__device__ __forceinline__ void mix_sgu(Frame& F, const LayerP& L, const bf16* P, bf16* Y3) {
    LAS float* stat = (LAS float*)(F.lds);
    LAS float* vn = (LAS float*)(F.lds + 1024);
    for (int unit = F.vcu; unit < 512; unit += F.G) {
        const int ck = unit >> 2, gg = unit & 3, t0 = ck * 128;
        for (int i = 0; i < 16; ++i) { const int tk = F.wave * 16 + i;
            const v4u raw = *(const v4u*)(P + (size_t)(t0 + tk) * PMW + C_SGU + 512 + F.lane * 8);
            float x[8] = {gelu_t(bflo(raw.x)), gelu_t(bfhi(raw.x)), gelu_t(bflo(raw.y)), gelu_t(bfhi(raw.y)), gelu_t(bflo(raw.z)), gelu_t(bfhi(raw.z)), gelu_t(bflo(raw.w)), gelu_t(bfhi(raw.w))};
            float s = 0.f;
#pragma unroll
            for (int j = 0; j < 8; ++j) s += x[j];
            const float mu = wave_sum(s) * (1.f / 512.f); float q = 0.f;
#pragma unroll
            for (int j = 0; j < 8; ++j) { const float d = x[j] - mu; q += d * d; }
            const float rstd = 1.0f / sqrtf(wave_sum(q) * (1.f / 512.f) + RMS_EPS);
            if (F.lane == 0) { stat[2 * tk] = mu; stat[2 * tk + 1] = rstd; } }
        __syncthreads();
        { const int j = F.tid >> 2, d0 = (F.tid & 3) * 32; const float mu = stat[2 * j], rstd = stat[2 * j + 1];
#pragma unroll
          for (int q = 0; q < 4; ++q) { const v4u raw = *(const v4u*)(P + (size_t)(t0 + j) * PMW + C_SGU + 512 + gg * 128 + d0 + q * 8);
              const unsigned wv[4] = {raw.x, raw.y, raw.z, raw.w};
#pragma unroll
              for (int k = 0; k < 4; ++k) { const int d = d0 + q * 8 + 2 * k; const int ch = gg * 128 + d;
                  vn[j * 128 + d] = (gelu_t(bflo(wv[k])) - mu) * rstd * L.ln_g[ch] + L.ln_b[ch];
                  vn[j * 128 + d + 1] = (gelu_t(bfhi(wv[k])) - mu) * rstd * L.ln_g[ch + 1] + L.ln_b[ch + 1]; } } }
        __syncthreads();
        { const int d = F.tid & 127, iq = F.tid >> 7;
          for (int ii = 0; ii < 32; ++ii) { const int i = iq + 4 * ii; const float* wrow = L.sgu_w + ((size_t)gg * 128 + i) * 128; float acc = 0.f;
              for (int j = 0; j <= i; ++j) acc += wrow[j] * vn[j * 128 + d];
              const float mixv = acc + L.sgu_b[gg * 128 + i];
              const float uu = gelu_t(bf2f(P[(size_t)(t0 + i) * PMW + C_SGU + gg * 128 + d]));
              Y3[(size_t)(t0 + i) * 512 + gg * 128 + d] = (bf16)f2bf(uu * mixv); } }
        __syncthreads();
    }
}

__device__ __forceinline__ void mix_ssm_naive(Frame& F, const LayerP& L, const bf16* P, bf16* Ypre, int b, int g) {
    LAS float* sre = (LAS float*)(F.lds);
    LAS float* sim = (LAS float*)(F.lds + 8448);
    LAS float* cre = (LAS float*)(F.lds + 16896);
    LAS float* cim = (LAS float*)(F.lds + 16896 + 4096);
    const int n = F.lane;
    const float are = L.a_re[g * 64 + n], aim = L.a_im[g * 64 + n], dt = expf(L.log_dt[g]);
    const float mag = expf(are * dt), abr = mag * cosf(aim * dt), abi = mag * sinf(aim * dt);
    const float nr = abr - 1.0f, ni = abi, den = are * are + aim * aim;
    const float sr = (nr * are + ni * aim) / den, si = (ni * are - nr * aim) / den;
    float bbr[16], bbi[16];
#pragma unroll
    for (int p = 0; p < 16; ++p) { const float br = L.b_re[(g * 64 + n) * 16 + p], bi = L.b_im[(g * 64 + n) * 16 + p]; bbr[p] = sr * br - si * bi; bbi[p] = sr * bi + si * br; }
#pragma unroll
    for (int p = 0; p < 16; ++p) { cre[p * 64 + n] = L.c_re[(g * 16 + p) * 64 + n]; cim[p * 64 + n] = L.c_im[(g * 16 + p) * 64 + n]; }
    float dsk[8];
    { const int ph = F.lane >> 5;
#pragma unroll
      for (int pp = 0; pp < 8; ++pp) dsk[pp] = L.ssm_d[g * 16 + ph * 8 + pp]; }
    float s_r = 0.f, s_i = 0.f;
    for (int ch = 0; ch < SEQ / 32; ++ch) {
        const bf16* ub = P + (size_t)(b * SEQ + ch * 32) * PMW + C_U + g * 16;
        for (int tt = 0; tt < 32; ++tt) {
            const v4u r0 = *(const v4u*)(ub + (size_t)tt * PMW), r1 = *(const v4u*)(ub + (size_t)tt * PMW + 8);
            const float u[16] = {bflo(r0.x), bfhi(r0.x), bflo(r0.y), bfhi(r0.y), bflo(r0.z), bfhi(r0.z), bflo(r0.w), bfhi(r0.w), bflo(r1.x), bfhi(r1.x), bflo(r1.y), bfhi(r1.y), bflo(r1.z), bfhi(r1.z), bflo(r1.w), bfhi(r1.w)};
            float bur = 0.f, bui = 0.f;
#pragma unroll
            for (int p = 0; p < 16; ++p) { bur += u[p] * bbr[p]; bui += u[p] * bbi[p]; }
            const float nsr = abr * s_r - abi * s_i + bur, nsi = abr * s_i + abi * s_r + bui; s_r = nsr; s_i = nsi;
            sre[n * 33 + tt] = s_r; sim[n * 33 + tt] = s_i;
        }
        LDS_WAIT(); asm volatile("" ::: "memory");
        { const int tt = F.lane & 31, ph = F.lane >> 5; float y[8];
#pragma unroll
          for (int pp = 0; pp < 8; ++pp) y[pp] = 0.f;
          for (int k = 0; k < 64; ++k) { const float xr = sre[k * 33 + tt], xi = sim[k * 33 + tt];
#pragma unroll
              for (int pp = 0; pp < 8; ++pp) y[pp] += cre[(ph * 8 + pp) * 64 + k] * xr - cim[(ph * 8 + pp) * 64 + k] * xi; }
          const size_t tok = (size_t)(b * SEQ + ch * 32 + tt);
          const v4u ur = *(const v4u*)(P + tok * PMW + C_U + g * 16 + ph * 8);
          const float uu[8] = {bflo(ur.x), bfhi(ur.x), bflo(ur.y), bfhi(ur.y), bflo(ur.z), bfhi(ur.z), bflo(ur.w), bfhi(ur.w)};
#pragma unroll
          for (int pp = 0; pp < 8; ++pp) y[pp] = gelu_t(y[pp] + dsk[pp] * uu[pp]);
          v4u o; o.x = pk2(y[0], y[1]); o.y = pk2(y[2], y[3]); o.z = pk2(y[4], y[5]); o.w = pk2(y[6], y[7]);
          *(v4u*)(Ypre + tok * 512 + g * 16 + ph * 8) = o; }
        LDS_WAIT(); asm volatile("" ::: "memory");
    }
}

__device__ __forceinline__ void mix_gdn_prep(Frame& F, const LayerP& L, const bf16* P, const Args& a, int first, int stride) {
    bf16* GQ = (bf16*)(a.ws + WS_GQ); bf16* GK = (bf16*)(a.ws + WS_GK); bf16* GV = (bf16*)(a.ws + WS_GV);
    float* GB = (float*)(a.ws + WS_GBETA); float* GLA = (float*)(a.ws + WS_GLA);
    for (int unit = first; unit < T * 4; unit += stride) {
        const int t = unit >> 2, h = unit & 3, tl = t & (SEQ - 1);
        float val[3][2];
#pragma unroll
        for (int part = 0; part < 3; ++part) { const int ch = part * 512 + h * 128 + F.lane * 2; float a0 = 0.f, a1 = 0.f;
#pragma unroll
            for (int j = 0; j < 4; ++j) { const int dtk = 3 - j; if (tl - dtk >= 0) { const unsigned w = *(const unsigned*)(P + (size_t)(t - dtk) * PMW + C_QKV + ch);
                    a0 += L.conv_w[j * 1536 + ch] * bflo(w); a1 += L.conv_w[j * 1536 + ch + 1] * bfhi(w); } }
            val[part][0] = silu_f(a0); val[part][1] = silu_f(a1); }
        const float qs = wave_sum(val[0][0] * val[0][0] + val[0][1] * val[0][1]), ks = wave_sum(val[1][0] * val[1][0] + val[1][1] * val[1][1]);
        const float qsc = (1.0f / sqrtf(qs + 1e-6f)) * 0.08838834764831845f, ksc = 1.0f / sqrtf(ks + 1e-6f);
        const size_t o = (size_t)t * 512 + h * 128 + F.lane * 2;
        *(unsigned*)(GQ + o) = pk2(val[0][0] * qsc, val[0][1] * qsc); *(unsigned*)(GK + o) = pk2(val[1][0] * ksc, val[1][1] * ksc); *(unsigned*)(GV + o) = pk2(val[2][0], val[2][1]);
        if (F.lane == 0) { const float av = bf2f(P[(size_t)t * PMW + C_A + h]), bv = bf2f(P[(size_t)t * PMW + C_B + h]);
            const float xx = av + L.dt_bias[h]; const float sp = xx > 20.f ? xx : log1pf(expf(xx));
            GB[t * 4 + h] = 1.0f / (1.0f + expf(-bv)); GLA[t * 4 + h] = -expf(L.a_log[h]) * sp; }
    }
}

__device__ __forceinline__ void mix_nsa_compress(Frame& F, const LayerP& L, const bf16* P, const Args& a, LAS float* hid, int first, int stride) {
    float* KCC = (float*)(a.ws + WS_KCC);
    for (int unit = first; unit < 2 * 2 * NCMP * 2; unit += stride) {
        const int g = unit & 1; int r = unit >> 1; const int c = r % NCMP; r /= NCMP; const int b = r & 1, kv = r >> 1;
        const float* pe = kv ? L.vpe : L.kpe; const float* w1 = kv ? L.vw1 : L.kw1; const float* w2 = kv ? L.vw2 : L.kw2;
        const bf16* src = P + (size_t)(b * SEQ + c * 16) * PMW + (kv ? C_VC : C_KC) + g * 64;
        float h0 = 0.f, h1 = 0.f;
        for (int l = 0; l < 32; ++l) {
#pragma unroll 4
            for (int d8 = 0; d8 < 8; ++d8) { const v4u raw = *(const v4u*)(src + (size_t)l * PMW + d8 * 8); const unsigned wv[4] = {raw.x, raw.y, raw.z, raw.w};
#pragma unroll
                for (int k = 0; k < 4; ++k) { const int d = d8 * 8 + 2 * k; const float x0 = bflo(wv[k]) + pe[l * 64 + d], x1 = bfhi(wv[k]) + pe[l * 64 + d + 1];
                    const float* wr0 = w1 + (size_t)(l * 64 + d) * 128; h0 += x0 * wr0[F.lane] + x1 * wr0[128 + F.lane]; h1 += x0 * wr0[64 + F.lane] + x1 * wr0[192 + F.lane]; } } }
        hid[F.lane] = gelu_t(h0); hid[64 + F.lane] = gelu_t(h1);
        LDS_WAIT(); asm volatile("" ::: "memory");
        float o = 0.f;
        for (int j = 0; j < 128; ++j) o += hid[j] * w2[j * 64 + F.lane];
        KCC[((size_t)((kv * 2 + b) * 512 + c) * 2 + g) * 64 + F.lane] = o;
        LDS_WAIT(); asm volatile("" ::: "memory");
    }
}

__device__ __forceinline__ void mix_gdn_naive(Frame& F, const LayerP& L, const bf16* P, const Args& a, bf16* Y1, int b, int h) {
    const bf16* GQ = (const bf16*)(a.ws + WS_GQ); const bf16* GK = (const bf16*)(a.ws + WS_GK); const bf16* GV = (const bf16*)(a.ws + WS_GV);
    const float* GB = (const float*)(a.ws + WS_GBETA); const float* GLA = (const float*)(a.ws + WS_GLA);
    LAS float* red1 = (LAS float*)(F.lds);
    LAS float* red2 = (LAS float*)(F.lds + 4096);
    float S0[16], S1[16];
#pragma unroll
    for (int i = 0; i < 16; ++i) { S0[i] = 0.f; S1[i] = 0.f; }
    const int w = F.wave, e0 = F.lane, e1 = F.lane + 64;
    const float ng0 = L.gdn_norm[e0], ng1 = L.gdn_norm[e1];
    for (int tl = 0; tl < SEQ; ++tl) {
        const size_t t = (size_t)b * SEQ + tl; const size_t base = t * 512 + h * 128;
        const v4u kr0 = *(const v4u*)(GK + base + w * 16), kr1 = *(const v4u*)(GK + base + w * 16 + 8);
        const v4u qr0 = *(const v4u*)(GQ + base + w * 16), qr1 = *(const v4u*)(GQ + base + w * 16 + 8);
        const float k[16] = {bflo(kr0.x), bfhi(kr0.x), bflo(kr0.y), bfhi(kr0.y), bflo(kr0.z), bfhi(kr0.z), bflo(kr0.w), bfhi(kr0.w), bflo(kr1.x), bfhi(kr1.x), bflo(kr1.y), bfhi(kr1.y), bflo(kr1.z), bfhi(kr1.z), bflo(kr1.w), bfhi(kr1.w)};
        const float q[16] = {bflo(qr0.x), bfhi(qr0.x), bflo(qr0.y), bfhi(qr0.y), bflo(qr0.z), bfhi(qr0.z), bflo(qr0.w), bfhi(qr0.w), bflo(qr1.x), bfhi(qr1.x), bflo(qr1.y), bfhi(qr1.y), bflo(qr1.z), bfhi(qr1.z), bflo(qr1.w), bfhi(qr1.w)};
        const float v0 = bf2f(GV[base + e0]), v1 = bf2f(GV[base + e1]);
        const float beta = GB[t * 4 + h], alpha = expf(GLA[t * 4 + h]);
        float p0 = 0.f, p1 = 0.f;
#pragma unroll
        for (int i = 0; i < 16; ++i) { p0 += k[i] * S0[i]; p1 += k[i] * S1[i]; }
        red1[w * 128 + e0] = p0; red1[w * 128 + e1] = p1;
        __syncthreads();
        float ks0 = 0.f, ks1 = 0.f;
#pragma unroll
        for (int ww = 0; ww < 8; ++ww) { ks0 += red1[ww * 128 + e0]; ks1 += red1[ww * 128 + e1]; }
        const float vn0 = beta * (v0 - alpha * ks0), vn1 = beta * (v1 - alpha * ks1);
        float o0 = 0.f, o1 = 0.f;
#pragma unroll
        for (int i = 0; i < 16; ++i) { S0[i] = alpha * S0[i] + k[i] * vn0; S1[i] = alpha * S1[i] + k[i] * vn1; o0 += q[i] * S0[i]; o1 += q[i] * S1[i]; }
        red2[w * 128 + e0] = o0; red2[w * 128 + e1] = o1;
        __syncthreads();
        if (w == 0) {
            float r0 = 0.f, r1 = 0.f;
#pragma unroll
            for (int ww = 0; ww < 8; ++ww) { r0 += red2[ww * 128 + e0]; r1 += red2[ww * 128 + e1]; }
            const float ms = wave_sum(r0 * r0 + r1 * r1) * (1.f / 128.f); const float rs = 1.0f / sqrtf(ms + RMS_EPS);
            const float z0 = bf2f(P[t * PMW + C_Z + h * 128 + e0]), z1 = bf2f(P[t * PMW + C_Z + h * 128 + e1]);
            Y1[base + e0] = (bf16)f2bf(r0 * rs * ng0 * silu_f(z0)); Y1[base + e1] = (bf16)f2bf(r1 * rs * ng1 * silu_f(z1));
        }
    }
    __syncthreads();
}

__device__ __forceinline__ void dot64x4(const bf16* krow, const LAS float* qs, float (&lg)[4]) {
    float s0 = 0.f, s1 = 0.f, s2 = 0.f, s3 = 0.f;
#pragma nounroll
    for (int i = 0; i < 8; ++i) { const v4u kr = ((const v4u*)krow)[i];
        const float kf[8] = {bflo(kr.x), bfhi(kr.x), bflo(kr.y), bfhi(kr.y), bflo(kr.z), bfhi(kr.z), bflo(kr.w), bfhi(kr.w)};
        const LAS float* qp = qs + i * 8;
        { const f32x4 qa = *(const LAS f32x4*)(qp), qb = *(const LAS f32x4*)(qp + 4);
          s0 += kf[0] * qa.x + kf[1] * qa.y + kf[2] * qa.z + kf[3] * qa.w + kf[4] * qb.x + kf[5] * qb.y + kf[6] * qb.z + kf[7] * qb.w; }
        { const f32x4 qa = *(const LAS f32x4*)(qp + 64), qb = *(const LAS f32x4*)(qp + 68);
          s1 += kf[0] * qa.x + kf[1] * qa.y + kf[2] * qa.z + kf[3] * qa.w + kf[4] * qb.x + kf[5] * qb.y + kf[6] * qb.z + kf[7] * qb.w; }
        { const f32x4 qa = *(const LAS f32x4*)(qp + 128), qb = *(const LAS f32x4*)(qp + 132);
          s2 += kf[0] * qa.x + kf[1] * qa.y + kf[2] * qa.z + kf[3] * qa.w + kf[4] * qb.x + kf[5] * qb.y + kf[6] * qb.z + kf[7] * qb.w; }
        { const f32x4 qa = *(const LAS f32x4*)(qp + 192), qb = *(const LAS f32x4*)(qp + 196);
          s3 += kf[0] * qa.x + kf[1] * qa.y + kf[2] * qa.z + kf[3] * qa.w + kf[4] * qb.x + kf[5] * qb.y + kf[6] * qb.z + kf[7] * qb.w; } }
    lg[0] = s0; lg[1] = s1; lg[2] = s2; lg[3] = s3;
}
__device__ __forceinline__ void nsa_chunk(Frame& F, const bf16* krow, const bf16* vbase, size_t vstride_tok0, bool kvalid, int dist, const LAS float* qs, const LAS float* lut, int g,
                                          LAS float* pb, float (&mrun)[4], float (&lrun)[4], float (&oacc)[4], const bf16* vrow0, int nkeys) {
    (void)vbase; (void)vstride_tok0;
    float lg[4];
    if (kvalid) { dot64x4(krow, qs, lg);
        const int dd = dist < 0 ? 0 : (dist > 128 ? 128 : dist); const f32x4 bs = *(const LAS f32x4*)(lut + dd * 8 + g * 4);
        lg[0] += bs.x; lg[1] += bs.y; lg[2] += bs.z; lg[3] += bs.w;
    } else { lg[0] = lg[1] = lg[2] = lg[3] = -1e30f; }
    float p[4];
#pragma unroll
    for (int h = 0; h < 4; ++h) { const float bm = wave_max(lg[h]); const float mn = fmaxf(mrun[h], bm); p[h] = kvalid ? __expf(lg[h] - mn) : 0.f;
        const float sc = __expf(mrun[h] - mn); lrun[h] = lrun[h] * sc + wave_sum(p[h]); oacc[h] *= sc; mrun[h] = mn; }
    *(LAS f32x4*)(pb + F.lane * 4) = (f32x4){p[0], p[1], p[2], p[3]};
    LDS_WAIT(); asm volatile("" ::: "memory");
#pragma unroll 2
    for (int kk = 0; kk < nkeys; ++kk) { const f32x4 pp = *(const LAS f32x4*)(pb + kk * 4); const float vv = bf2f(vrow0[(size_t)kk * PMW + F.lane]);
        oacc[0] += pp.x * vv; oacc[1] += pp.y * vv; oacc[2] += pp.z * vv; oacc[3] += pp.w * vv; }
    LDS_WAIT(); asm volatile("" ::: "memory");
}
__device__ __forceinline__ void mix_nsa_naive(Frame& F_, const LayerP& L, const bf16* P, const Args& a, bf16* Y2, const LAS float* lut, int first, int stride) {
    LAS float* wl = (LAS float*)(F_.lds + 8192 + F_.wave * 12288);
    LAS float* qs = wl;
    LAS float* pc = wl + 256;
    LAS float* pb = wl + 256 + 2048;
    LAS int* sel = (LAS int*)(wl + 256 + 2048 + 256);
    const float* KCC = (const float*)(a.ws + WS_KCC);
    for (int unit = first; unit < T * 2; unit += stride) {
        Frame F = F_; asm volatile("" : "+v"(F.lane));
        const int g = unit & 1, t = unit >> 1, b = t >> 13, tq = t & (SEQ - 1);
        const int post = L.pos[tq];
        { const bf16* qp = P + (size_t)t * PMW + C_NQ + g * 256; const unsigned long long r = *(const unsigned long long*)(qp + F.lane * 4); const unsigned lo = (unsigned)r, hi = (unsigned)(r >> 32);
          *(LAS f32x4*)(qs + F.lane * 4) = (f32x4){bflo(lo) * 0.125f, bfhi(lo) * 0.125f, bflo(hi) * 0.125f, bfhi(hi) * 0.125f}; }
        LDS_WAIT(); asm volatile("" ::: "memory");
        const int ncv = tq >= 31 ? ((tq - 31) >> 4) + 1 : 0;
        float oc[4] = {0.f, 0.f, 0.f, 0.f};
        float icn[4] = {0.f, 0.f, 0.f, 0.f};
        {
            float mloc[4] = {-1e30f, -1e30f, -1e30f, -1e30f};
#pragma nounroll
            for (int cc = 0; cc < 8; ++cc) { const int c = cc * 64 + F.lane; const bool valid = c < ncv; f32x4 lgv = (f32x4){-1e30f, -1e30f, -1e30f, -1e30f};
                if (valid) { const float* kr = KCC + ((size_t)((0 * 2 + b) * 512 + c) * 2 + g) * 64; const int dist = post - L.pos[16 * c + 31];
                    const int dd = dist < 0 ? 0 : (dist > 128 ? 128 : dist); const f32x4 bs = *(const LAS f32x4*)(lut + dd * 8 + g * 4);
                    float s0 = 0.f, s1 = 0.f, s2 = 0.f, s3 = 0.f;
#pragma unroll 2
                    for (int d4 = 0; d4 < 16; ++d4) { const f32x4 kv = *(const f32x4*)(kr + d4 * 4);
                        const f32x4 q0 = *(const LAS f32x4*)(qs + d4 * 4), q1 = *(const LAS f32x4*)(qs + 64 + d4 * 4), q2 = *(const LAS f32x4*)(qs + 128 + d4 * 4), q3 = *(const LAS f32x4*)(qs + 192 + d4 * 4);
                        s0 += kv.x * q0.x + kv.y * q0.y + kv.z * q0.z + kv.w * q0.w; s1 += kv.x * q1.x + kv.y * q1.y + kv.z * q1.z + kv.w * q1.w;
                        s2 += kv.x * q2.x + kv.y * q2.y + kv.z * q2.z + kv.w * q2.w; s3 += kv.x * q3.x + kv.y * q3.y + kv.z * q3.z + kv.w * q3.w; }
                    lgv = (f32x4){s0 + bs.x, s1 + bs.y, s2 + bs.z, s3 + bs.w}; }
                mloc[0] = fmaxf(mloc[0], lgv.x); mloc[1] = fmaxf(mloc[1], lgv.y); mloc[2] = fmaxf(mloc[2], lgv.z); mloc[3] = fmaxf(mloc[3], lgv.w);
                *(LAS f32x4*)(pc + c * 4) = lgv; }
            LDS_WAIT(); asm volatile("" ::: "memory");
            float mx[4], sl[4] = {0.f, 0.f, 0.f, 0.f};
#pragma unroll
            for (int h = 0; h < 4; ++h) mx[h] = wave_max(mloc[h]);
#pragma nounroll
            for (int cc = 0; cc < 8; ++cc) { const int c = cc * 64 + F.lane; const bool valid = c < ncv; const f32x4 lgv = *(const LAS f32x4*)(pc + c * 4);
                f32x4 pv; pv.x = valid ? __expf(lgv.x - mx[0]) : 0.f; pv.y = valid ? __expf(lgv.y - mx[1]) : 0.f; pv.z = valid ? __expf(lgv.z - mx[2]) : 0.f; pv.w = valid ? __expf(lgv.w - mx[3]) : 0.f;
                sl[0] += pv.x; sl[1] += pv.y; sl[2] += pv.z; sl[3] += pv.w; *(LAS f32x4*)(pc + c * 4) = pv; }
            LDS_WAIT(); asm volatile("" ::: "memory");
#pragma unroll
            for (int h = 0; h < 4; ++h) { const float sm = wave_sum(sl[h]); icn[h] = ncv > 0 ? 1.f / sm : 0.f; }
            const float* vcb = KCC + ((size_t)((1 * 2 + b) * 512) * 2 + g) * 64;
#pragma nounroll
            for (int c = 0; c < ncv; ++c) { const f32x4 pp = *(const LAS f32x4*)(pc + c * 4); const float vv = vcb[(size_t)c * 128 + F.lane];
                oc[0] += pp.x * vv; oc[1] += pp.y * vv; oc[2] += pp.z * vv; oc[3] += pp.w * vv; }
#pragma unroll
            for (int h = 0; h < 4; ++h) oc[h] *= icn[h];
        }
        const int tb = tq >> 6;
        float sc0, sc1;
        { float im[2];
#pragma unroll
          for (int q = 0; q < 2; ++q) { const int j = F.lane + 64 * q; float s = 0.f;
#pragma unroll
              for (int dc = -1; dc <= 3; ++dc) { const int c = 4 * j + dc; if (c >= 0 && c < NCMP) { const f32x4 pp = *(const LAS f32x4*)(pc + c * 4); s += (pp.x * icn[0] + pp.y * icn[1]) + (pp.z * icn[2] + pp.w * icn[3]); } }
              const bool forced = (j == 0) || (j == tb) || (j == tb - 1); const bool elig = j <= tb;
              im[q] = forced ? 1e9f : (elig ? s : -1e9f); }
          sc0 = im[0]; sc1 = im[1]; }
        int nsel = 0;
        for (int it = 0; it < 16; ++it) {
            float bv = sc0; int bi = F.lane; if (sc1 > sc0) { bv = sc1; bi = F.lane + 64; }
#pragma unroll
            for (int o = 1; o < 64; o <<= 1) { const float ov = __shfl_xor(bv, o); const int oi = __shfl_xor(bi, o); if (ov > bv || (ov == bv && oi < bi)) { bv = ov; bi = oi; } }
            if (bv <= -1e9f) break;
            if (F.lane == 0) sel[it] = bi;
            if (bi == F.lane) sc0 = -3.0e38f; if (bi == F.lane + 64) sc1 = -3.0e38f;
            nsel = it + 1;
        }
        LDS_WAIT(); asm volatile("" ::: "memory");
        float ms[4] = {-1e30f, -1e30f, -1e30f, -1e30f}, ls[4] = {0.f, 0.f, 0.f, 0.f}, os[4] = {0.f, 0.f, 0.f, 0.f};
#pragma nounroll
        for (int it = 0; it < nsel; ++it) { const int j = sel[it]; const int tok = j * 64 + F.lane; const bool valid = tok <= tq;
            const size_t gt = (size_t)b * SEQ + tok; const int nk = (tq - j * 64 + 1) < 64 ? (tq - j * 64 + 1) : 64;
            nsa_chunk(F, P + gt * PMW + C_KS + g * 64, nullptr, 0, valid, post - L.pos[tok], qs, lut, g, pb, ms, ls, os, P + ((size_t)b * SEQ + j * 64) * PMW + C_VS + g * 64, nk); }
        float mw[4] = {-1e30f, -1e30f, -1e30f, -1e30f}, lw[4] = {0.f, 0.f, 0.f, 0.f}, ow[4] = {0.f, 0.f, 0.f, 0.f};
#pragma nounroll
        for (int cc = 0; cc < 8; ++cc) { const int tok0 = tq - 511 + cc * 64; if (tok0 + 63 < 0) continue;
            const int tok = tok0 + F.lane; const bool valid = tok >= 0; const int tokc = valid ? tok : 0; const size_t gt = (size_t)b * SEQ + tokc;
            const int skip = tok0 < 0 ? -tok0 : 0;
            const int ltok = (tok0 < 0 ? 0 : tok0) + F.lane; const bool lvalid = (F.lane < 64 - skip);
            const size_t lgt = (size_t)b * SEQ + (lvalid ? ltok : 0);
            (void)gt; (void)tokc; (void)valid;
            nsa_chunk(F, P + lgt * PMW + C_KW + g * 64, nullptr, 0, lvalid, post - L.pos[lvalid ? ltok : 0], qs, lut, g, pb, mw, lw, ow, P + ((size_t)b * SEQ + (tok0 < 0 ? 0 : tok0)) * PMW + C_VW + g * 64, 64 - skip); }
        { const bf16* ngp = P + (size_t)t * PMW + C_NG + g * 12;
#pragma unroll
          for (int h = 0; h < 4; ++h) { const float gc = sigm(bf2f(ngp[h * 3])), gs = sigm(bf2f(ngp[h * 3 + 1])), gw_ = sigm(bf2f(ngp[h * 3 + 2]));
              const float y = gc * oc[h] + gs * (os[h] / ls[h]) + gw_ * (ow[h] / lw[h]);
              Y2[(size_t)t * 512 + g * 256 + h * 64 + F.lane] = (bf16)f2bf(y); } }
        LDS_WAIT(); asm volatile("" ::: "memory");
    }
}

__device__ __forceinline__ void make_layer(LayerP& L, const Args& args, int layer) { asm volatile("" : "+s"(layer));
        L.a_re = (const float*)inptr(args, 6) + layer * 2048; L.a_im = (const float*)inptr(args, 7) + layer * 2048; L.log_dt = (const float*)inptr(args, 8) + layer * 32;
        L.b_re = (const float*)inptr(args, 9) + layer * 32768; L.b_im = (const float*)inptr(args, 10) + layer * 32768; L.c_re = (const float*)inptr(args, 11) + layer * 32768; L.c_im = (const float*)inptr(args, 12) + layer * 32768;
        L.ssm_d = (const float*)inptr(args, 13) + layer * 512; L.conv_w = (const float*)inptr(args, 15) + layer * 4 * 1536; L.a_log = (const float*)inptr(args, 16) + layer * 4; L.dt_bias = (const float*)inptr(args, 17) + layer * 4;
        L.gdn_norm = (const float*)inptr(args, 18) + layer * 128;
        L.kpe = (const float*)inptr(args, 19) + layer * 2048; L.kw1 = (const float*)inptr(args, 20) + (size_t)layer * 2048 * 128; L.kw2 = (const float*)inptr(args, 21) + layer * 8192;
        L.vpe = (const float*)inptr(args, 22) + layer * 2048; L.vw1 = (const float*)inptr(args, 23) + (size_t)layer * 2048 * 128; L.vw2 = (const float*)inptr(args, 24) + layer * 8192;
        L.rel_bias = (const float*)inptr(args, 25); L.ln_g = (const float*)inptr(args, 26) + layer * 512; L.ln_b = (const float*)inptr(args, 27) + layer * 512;
        L.sgu_w = (const float*)inptr(args, 28) + (size_t)layer * 4 * 128 * 128; L.sgu_b = (const float*)inptr(args, 29) + layer * 512; L.pos = (const int*)inptr(args, 1);

}
__device__ __forceinline__ Frame make_frame(unsigned char* lds_generic, unsigned char* ws) {
    Frame F;
    F.lds = (LAS unsigned char*)lds_generic;
    F.MISC = (volatile LAS unsigned*)(F.lds + MISC_OFF);
    int t = threadIdx.x; asm volatile("" : "+v"(t));
    F.tid = t; F.lane = F.tid & 63; F.wave = __builtin_amdgcn_readfirstlane(F.tid >> 6);
    F.G = gridDim.x; { const int bx = blockIdx.x; F.vcu = (F.G % 8 == 0) ? (bx % 8) * (F.G / 8) + bx / 8 : bx; }
    F.gw = F.vcu * NWAVES + F.wave; F.NGW = F.G * NWAVES;
    F.ctl = (gu32*)(ws + WS_CTL);
    return F;
}
#define ws (args.ws)
#define F0 make_frame(lds, ws)
#define relaunder(x) (x)
#define IN(k) in_rng(lo, hi, (k))
#define GRID_BAR(k) do { if (IN(k) && IN((k) + 1)) { Frame Fb = F0; XcdBarrier bar; bar.bar = (unsigned*)(Fb.ctl + CW_BAR); bar.x = xb_xcc_id(); bar.st = Fb.MISC + 8; xcd_barrier(bar); } } while (0)

#define PA ((bf16*)(ws + WS_A))
#define YB ((bf16*)(ws + WS_B))
#define MGB ((bf16*)(ws + WS_D))
#define YPRE ((bf16*)(ws + WS_D))
#define HB ((bf16*)(ws + WS_C))
#define XW (args.out)

template <int layer>
__device__ __forceinline__ void layer_body(const Args& args, const int lo, const int hi, unsigned char* lds) {
        const int pb = 1 + layer * 10;
#define wl (ws + WS_WL + (size_t)layer * W_LAYER)
        if (IN(pb + 0)) { Frame F = relaunder(F0); p_norm<false, false>(F, layer == 0 ? (const float*)inptr(args, 0) : XW, (const float*)inptr(args, 2) + layer * DM, HB, nullptr, nullptr, args); }
        GRID_BAR(pb + 0);
        if (IN(pb + 1)) { Frame F = relaunder(F0); pg8::Gemm g{HB, (const bf16*)(wl + W_IN1), T, PMW, DM}; pg8::StaticOrder S; S.init(T, PMW, F.G, (int)blockIdx.x);
            pg8::EpiStore E{PA, PMW, 1 << 20, 0}; pg8::gemm_phase<pg8::EpiStore, pg8::StaticOrder, true, true>(F.lds, g, S, E); }
        GRID_BAR(pb + 1);
        if (IN(pb + 2)) {
            { Frame F = relaunder(F0); LayerP L; make_layer(L, args, layer); mix_sgu(F, L, PA, YB + (size_t)3 * T * 512); }
            if (F0.wave == 0 && F0.vcu < 64) { Frame F = relaunder(F0); LayerP L; make_layer(L, args, layer); mix_ssm_naive(F, L, PA, YPRE, F.vcu >> 5, F.vcu & 31); }
            else {
                Frame F = relaunder(F0);
                const int nw = F.NGW - 64; const int idx = F.vcu < 64 ? F.vcu * 7 + (F.wave - 1) : 64 * 7 + (F.vcu - 64) * 8 + F.wave;
                { LayerP L; make_layer(L, args, layer); mix_gdn_prep(F, L, PA, args, idx, nw); }
                { LayerP L; make_layer(L, args, layer); mix_nsa_compress(F, L, PA, args, (LAS float*)(F.lds + 65536 + F.wave * 1024), idx, nw); }
            }
        }
        GRID_BAR(pb + 2);
        if (IN(pb + 3)) {
            if (F0.vcu < 8) { Frame F = relaunder(F0); LayerP L; make_layer(L, args, layer); mix_gdn_naive(F, L, PA, args, YB + (size_t)1 * T * 512, F.vcu >> 2, F.vcu & 3); }
            { Frame F = relaunder(F0); pg8::Gemm g{YPRE, (const bf16*)(wl + W_GLU), T, 512, 512}; pg8::StaticOrder S; S.init(T, 512, F.G, (int)blockIdx.x);
              pg8::EpiGLU E{YPRE, YB}; pg8::gemm_phase<pg8::EpiGLU, pg8::StaticOrder, true, true>(F.lds, g, S, E); }
            __syncthreads();
            if (F0.vcu >= 8) { Frame F = relaunder(F0); LayerP L; make_layer(L, args, layer);
                LAS float* lut = (LAS float*)(F.lds);
                for (int i = F.tid; i < 129 * 8; i += NTHR) { const int d = i >> 3, hh = i & 7; int bk;
                    if (d < 16) bk = d; else { const float nf = (float)d; int lg2 = 16 + (int)(logf(nf / 16.0f) / 2.0794415416798357f * 16.0f); bk = lg2 > 31 ? 31 : lg2; }
                    if (d >= 128) bk = 31;
                    lut[i] = L.rel_bias[bk * 8 + hh]; }
                __syncthreads();
                mix_nsa_naive(F, L, PA, args, YB + (size_t)2 * T * 512, lut, (F.vcu - 8) * 8 + F.wave, (F.G - 8) * 8);
            }
        }
        GRID_BAR(pb + 3);
        if (IN(pb + 4)) { Frame F = relaunder(F0); pg8::Gemm g{HB, (const bf16*)(wl + W_IN2), T, NGATE, DM}; pg8::StaticOrder S; S.init(T, NGATE, F.G, (int)blockIdx.x);
            pg8::EpiStore E{PA, NGATE, 1 << 20, 1}; pg8::gemm_phase<pg8::EpiStore, pg8::StaticOrder, true, true>(F.lds, g, S, E); }
        GRID_BAR(pb + 4);
        if (IN(pb + 5)) { Frame F = relaunder(F0); pg8::Gemm g{YB, (const bf16*)(wl + W_BR), 4 * T, 4096, 512}; pg8::MergeOrder S; S.init(F.G, (int)blockIdx.x);
            pg8::EpiMerge E{PA, MGB, ((ABL_LAYERS >> layer) & 1) ? (ABL & 15) : 0}; pg8::gemm_phase<pg8::EpiMerge, pg8::MergeOrder, true, true>(F.lds, g, S, E); }
        GRID_BAR(pb + 5);
        if (IN(pb + 6)) { Frame F = relaunder(F0); pg8::Gemm g{MGB, (const bf16*)(wl + W_OUT), T, DM, DM}; pg8::StaticOrder S; S.init(T, DM, F.G, (int)blockIdx.x);
            pg8::EpiResid E{layer == 0 ? (const float*)inptr(args, 0) : XW, XW, DM}; pg8::gemm_phase<pg8::EpiResid, pg8::StaticOrder, true, true>(F.lds, g, S, E); }
        GRID_BAR(pb + 6);
        if (IN(pb + 7)) { Frame F = relaunder(F0);
            if (layer == 0) p_norm<false, false>(F, XW, (const float*)inptr(args, 3), HB, nullptr, nullptr, args);
            else { p_norm<true, false>(F, XW, (const float*)inptr(args, 3) + DM, HB, nullptr, (const float*)inptr(args, 38), args); p_conv_moe_down(F, args); }
        }
        GRID_BAR(pb + 7);
        if constexpr (layer == 0) {
            if (IN(9) && !(ABL & 16)) { Frame F = relaunder(F0); pg8::Gemm g{HB, (const bf16*)(ws + WS_FUP), T, 2 * FFD, DM}; pg8::StaticOrder S; S.init(T, 2 * FFD, F.G, (int)blockIdx.x);
                pg8::EpiSwiGLU E{PA, FFD, 1 << 20}; pg8::gemm_phase<pg8::EpiSwiGLU, pg8::StaticOrder, true, true>(F.lds, g, S, E); }
            GRID_BAR(9);
            if (IN(10) && !(ABL & 16)) { Frame F = relaunder(F0); pg8::Gemm g{PA, (const bf16*)(ws + WS_FDN), T, DM, FFD}; pg8::StaticOrder S; S.init(T, DM, F.G, (int)blockIdx.x);
                pg8::EpiResid E{XW, XW, DM}; pg8::gemm_phase<pg8::EpiResid, pg8::StaticOrder, true, true>(F.lds, g, S, E); }
            GRID_BAR(10);
        } else {
            {
                constexpr int pass = 0; constexpr int q0 = 19;
                MoeTiles mt;
                if (IN(q0) || IN(q0 + 1) || IN(q0 + 2) || IN(q0 + 3)) { Frame Fm = F0; moe_tiles(Fm, mt); }
                const int tile0 = pass * PASS_TILES; int ntp = mt.tb[8] - tile0; ntp = ntp < 0 ? 0 : (ntp > PASS_TILES ? PASS_TILES : ntp);
                if (IN(q0)) { Frame F = relaunder(F0); p_moe_gather(F, args, mt, pass); }
                GRID_BAR(q0);
                if (IN(q0 + 1)) { Frame F = relaunder(F0); pg8::Gemm g{(const bf16*)(ws + WS_B), (const bf16*)(ws + WS_MUP), PASS_TILES * 256, NEXP * 2 * FFE, DM};
                    pg8::MoeOrder S{ntp, tile0, 28, F.G, (int)blockIdx.x, mt.tb[1], mt.tb[2], mt.tb[3], mt.tb[4], mt.tb[5], mt.tb[6], mt.tb[7]};
                    pg8::EpiSwiGLU E{PA, FFE, 28}; pg8::gemm_phase<pg8::EpiSwiGLU, pg8::MoeOrder, true, true>(F.lds, g, S, E); }
                GRID_BAR(q0 + 1);
                if (IN(q0 + 2)) { Frame F = relaunder(F0); pg8::Gemm g{PA, (const bf16*)(ws + WS_MDN), PASS_TILES * 256, NEXP * DM, FFE};
                    pg8::MoeOrder S{ntp, tile0, 4, F.G, (int)blockIdx.x, mt.tb[1], mt.tb[2], mt.tb[3], mt.tb[4], mt.tb[5], mt.tb[6], mt.tb[7]};
                    pg8::EpiStore E{(bf16*)(ws + WS_YM), DM, 4, 0}; pg8::gemm_phase<pg8::EpiStore, pg8::MoeOrder, true, true>(F.lds, g, S, E); }
                GRID_BAR(q0 + 2);
                if (IN(q0 + 3) && !(ABL & 32)) { Frame F = relaunder(F0); p_moe_combine(F, args, mt, pass); }
                GRID_BAR(q0 + 3);
            }
            {
                constexpr int pass = 1; constexpr int q0 = 23;
                MoeTiles mt;
                if (IN(q0) || IN(q0 + 1) || IN(q0 + 2) || IN(q0 + 3)) { Frame Fm = F0; moe_tiles(Fm, mt); }
                const int tile0 = pass * PASS_TILES; int ntp = mt.tb[8] - tile0; ntp = ntp < 0 ? 0 : (ntp > PASS_TILES ? PASS_TILES : ntp);
                if (IN(q0)) { Frame F = relaunder(F0); p_moe_gather(F, args, mt, pass); }
                GRID_BAR(q0);
                if (IN(q0 + 1)) { Frame F = relaunder(F0); pg8::Gemm g{(const bf16*)(ws + WS_B), (const bf16*)(ws + WS_MUP), PASS_TILES * 256, NEXP * 2 * FFE, DM};
                    pg8::MoeOrder S{ntp, tile0, 28, F.G, (int)blockIdx.x, mt.tb[1], mt.tb[2], mt.tb[3], mt.tb[4], mt.tb[5], mt.tb[6], mt.tb[7]};
                    pg8::EpiSwiGLU E{PA, FFE, 28}; pg8::gemm_phase<pg8::EpiSwiGLU, pg8::MoeOrder, true, true>(F.lds, g, S, E); }
                GRID_BAR(q0 + 1);
                if (IN(q0 + 2)) { Frame F = relaunder(F0); pg8::Gemm g{PA, (const bf16*)(ws + WS_MDN), PASS_TILES * 256, NEXP * DM, FFE};
                    pg8::MoeOrder S{ntp, tile0, 4, F.G, (int)blockIdx.x, mt.tb[1], mt.tb[2], mt.tb[3], mt.tb[4], mt.tb[5], mt.tb[6], mt.tb[7]};
                    pg8::EpiStore E{(bf16*)(ws + WS_YM), DM, 4, 0}; pg8::gemm_phase<pg8::EpiStore, pg8::MoeOrder, true, true>(F.lds, g, S, E); }
                GRID_BAR(q0 + 2);
                if (IN(q0 + 3) && !(ABL & 32)) { Frame F = relaunder(F0); p_moe_combine(F, args, mt, pass); }
                GRID_BAR(q0 + 3);
            }
        }
    }
__global__ void __launch_bounds__(NTHR, 2) fwd(Args args) {
    extern __shared__ __attribute__((aligned(16))) unsigned char lds[];
    { Frame Fz = F0;
      for (int u = Fz.tid; u < (LDS_BYTES - LDSCTL_OFF) / 4; u += NTHR) ((LAS unsigned*)(Fz.lds + LDSCTL_OFF))[u] = 0u; }
    __syncthreads();
    const int lo = args.ph_lo, hi = args.ph_hi;
    if (hi - lo > 1) { Frame Fz = F0; (void)xcd_barrier_post((unsigned*)(Fz.ctl + CW_BAR), Fz.MISC + 8); }
    if (IN(0)) { Frame F = relaunder(F0); p_prologue(F, args); }
    GRID_BAR(0);

    layer_body<0>(args, lo, hi, lds);
    layer_body<1>(args, lo, hi, lds);
    if (IN(27)) { Frame F = relaunder(F0); p_norm<false, true>(F, XW, (const float*)inptr(args, 4), nullptr, XW, nullptr, args); }
#undef IN
#undef GRID_BAR
#undef ws
#undef F0
#undef relaunder
#undef PA
#undef YB
#undef MGB
#undef YPRE
#undef HB
#undef XW
#undef wl
}


#if SELFCHK
constexpr int CW_CHK = 32768;
__device__ __forceinline__ unsigned hsh(unsigned x) { x ^= x >> 16; x *= 0x7feb352du; x ^= x >> 15; x *= 0x846ca68bu; x ^= x >> 16; return x; }
__device__ __forceinline__ float rbf(float f) { return __uint_as_float(f2bf(f) << 16); }
__device__ __forceinline__ bool bad(float got, float ref, float rel, float ab) { const float d = fabsf(got - ref); return !(d <= rel * fabsf(ref) + ab); }
__global__ void __launch_bounds__(256) chk(Args a, int which, int layer) {
    const unsigned sid = blockIdx.x * 256 + threadIdx.x; unsigned char* ws = a.ws;
    const unsigned h1 = hsh(sid * 2654435761u + 12345u * (unsigned)which), h2 = hsh(h1 + 0x9e3779b9u);
    const int r = (int)(h1 % (unsigned)T);
    const bf16* H = (const bf16*)(ws + WS_C); const bf16* PAp = (const bf16*)(ws + WS_A); const bf16* Y = (const bf16*)(ws + WS_B); const bf16* MG = (const bf16*)(ws + WS_D);
    const float* w_in = (const float*)a.in[5] + (size_t)layer * DM * IN_COLS;
    unsigned* cnt = (unsigned*)(ws + WS_CTL) + CW_CHK + 64 * which;
    bool fail = false;
    if (which == 1) { const int c = (int)(h2 % (unsigned)NMIX); float s = 0.f; for (int k = 0; k < DM; ++k) s += bf2f(H[(size_t)r * DM + k]) * rbf(w_in[(size_t)k * IN_COLS + c]);
        fail = bad(bf2f(PAp[(size_t)r * PMW + c]), s, 0.02f, 0.02f); }
    else if (which == 2) { const int c = (int)(h2 % (unsigned)NGATE); float s = 0.f; for (int k = 0; k < DM; ++k) s += bf2f(H[(size_t)r * DM + k]) * rbf(w_in[(size_t)k * IN_COLS + NMIX + c]);
        fail = bad(bf2f(PAp[(size_t)r * NGATE + c]), 1.f / (1.f + expf(-s)), 0.02f, 0.01f); }
    else if (which == 3) { const int c = (int)(h2 % 512u); const bf16* yp = (const bf16*)(ws + WS_D); const float* glu = (const float*)a.in[14] + (size_t)layer * 512 * 512; float s = 0.f;
        for (int k = 0; k < 512; ++k) s += bf2f(yp[(size_t)r * 512 + k]) * rbf(glu[(size_t)k * 512 + c]);
        fail = bad(bf2f(Y[(size_t)r * 512 + c]), bf2f(yp[(size_t)r * 512 + c]) / (1.f + expf(-s)), 0.02f, 0.01f); }
    else if (which == 4) { const int c = (int)(h2 % 1024u); float tot = 0.f;
        for (int b = 0; b < 4; ++b) { const float* wb = (const float*)a.in[30 + b] + (size_t)layer * 512 * 1024; float s = 0.f;
            for (int k = 0; k < 512; ++k) s += bf2f(Y[((size_t)b * T + r) * 512 + k]) * rbf(wb[(size_t)k * 1024 + c]);
            tot += bf2f(PAp[(size_t)r * NGATE + b * 1024 + c]) * s; }
        fail = bad(bf2f(MG[(size_t)r * 1024 + c]), tot, 0.03f, 0.03f); }
    else if (which == 5 || which == 7) { const int c = (int)(h2 % 1024u); const float* wo = (const float*)a.in[34] + (size_t)layer * DM * DM; float s = ((const float*)a.in[0])[(size_t)r * DM + c];
        for (int k = 0; k < DM; ++k) s += bf2f(MG[(size_t)r * 1024 + k]) * rbf(wo[(size_t)k * DM + c]);
        if (which == 7) { const float* wd = (const float*)a.in[37]; for (int j = 0; j < FFD; ++j) s += bf2f(PAp[(size_t)r * FFD + j]) * rbf(wd[(size_t)j * DM + c]); }
        fail = bad(a.out[(size_t)r * DM + c], s, 0.01f, 0.03f); }
    else if (which == 6) { const int c = (int)(h2 % (unsigned)FFD); const float* wg = (const float*)a.in[35]; const float* wu = (const float*)a.in[36]; float g = 0.f, u = 0.f;
        for (int k = 0; k < DM; ++k) { const float hv = bf2f(H[(size_t)r * DM + k]); g += hv * rbf(wg[(size_t)k * FFD + c]); u += hv * rbf(wu[(size_t)k * FFD + c]); }
        fail = bad(bf2f(PAp[(size_t)r * FFD + c]), g / (1.f + expf(-g)) * u, 0.02f, 0.02f); }
    else if (which == 8 || which == 9) {
        int cn[8], tb[9], run = 0; for (int e = 0; e < 8; ++e) { cn[e] = (int)((unsigned*)(ws + WS_CTL))[CW_CNT + 64 * e]; tb[e] = run; run += (cn[e] + 255) >> 8; } tb[8] = run;
        const int ntp = run < PASS_TILES ? run : PASS_TILES; const int rl = (int)(h1 % (unsigned)(ntp * 256)); const int ti = rl >> 8; int e = 0; for (int k = 1; k < 8; ++k) e += (ti >= tb[k]);
        const int rin = (ti - tb[e]) * 256 + (rl & 255);
        if (rin < cn[e]) { const int tok = ((const int*)(ws + WS_ROWTOK))[e * T + rin];
            if (which == 8) { const int c = (int)(h2 % (unsigned)FFE); const float* wg = (const float*)a.in[39] + (size_t)e * DM * FFE; const float* wu = (const float*)a.in[40] + (size_t)e * DM * FFE; float g = 0.f, u = 0.f;
                for (int k = 0; k < DM; ++k) { const float hv = bf2f(H[(size_t)tok * DM + k]); g += hv * rbf(wg[(size_t)k * FFE + c]); u += hv * rbf(wu[(size_t)k * FFE + c]); }
                fail = bad(bf2f(PAp[(size_t)rl * FFE + c]), g / (1.f + expf(-g)) * u, 0.02f, 0.02f); }
            else { const int c = (int)(h2 % 1024u); const float* wd = (const float*)a.in[41] + (size_t)e * FFE * DM; float s = 0.f;
                for (int j = 0; j < FFE; ++j) s += bf2f(PAp[(size_t)rl * FFE + j]) * rbf(wd[(size_t)j * DM + c]);
                fail = bad(bf2f(((const bf16*)(ws + WS_YM))[(size_t)rl * DM + c]), s, 0.02f, 0.02f); } } }
    else if (which == 10) {
        const int c = (int)(h2 % 1024u); const float* x = (const float*)a.in[0] + (size_t)r * DM; float ss = 0.f; for (int k = 0; k < DM; ++k) ss += x[k] * x[k];
        const float ref = x[c] / sqrtf(ss / DM + RMS_EPS) * ((const float*)a.in[2])[c]; fail = bad(bf2f(H[(size_t)r * DM + c]), ref, 0.01f, 0.005f); }
    if (fail) { atomicAdd(cnt, 1u);
        if (which == 2) { const int c = (int)(h2 % (unsigned)NGATE); atomicAdd(cnt + 1 + (c >> 10), 1u);
            const int pm = r >> 8, pn = c >> 8; atomicOr(cnt + 8 + (pm >> 5), 1u << (pm & 31)); atomicOr(cnt + 10, 1u << pn);
            atomicOr(cnt + 11, 1u << ((r >> 4) & 15)); atomicOr(cnt + 12, 1u << (c & 31)); } }
}
__global__ void __launch_bounds__(256) chk_final(Args a) {
    const unsigned* c = (const unsigned*)(a.ws + WS_CTL) + CW_CHK; int first = 0;
    for (int k = 1; k <= 10; ++k) if (first == 0 && c[64 * k] != 0u) first = k;
#if SELFCHK == 2
    first = 0; { unsigned n = c[64 * 2] + 1u; while (n > 1u) { n >>= 1; ++first; } } if (c[64 * 2] == 0u) first = 0; else first += 0;
#elif SELFCHK == 4
    first = __builtin_popcount(c[64 * 2 + 8]) + __builtin_popcount(c[64 * 2 + 9]);
#elif SELFCHK == 5
    first = __builtin_popcount(c[64 * 2 + 10]);
#elif SELFCHK == 6
    first = __builtin_popcount(c[64 * 2 + 11]);
#elif SELFCHK == 7
    first = __builtin_popcount(c[64 * 2 + 12]);
#elif SELFCHK == 3
    first = (c[64 * 2 + 1] ? 1 : 0) | (c[64 * 2 + 2] ? 2 : 0) | (c[64 * 2 + 3] ? 4 : 0) | (c[64 * 2 + 4] ? 8 : 0);
#endif
    if (first) { const float v = 1.0f + (float)first; for (size_t i = (size_t)blockIdx.x * 256 + threadIdx.x; i < (size_t)T * DM; i += (size_t)gridDim.x * 256) a.out[i] = v; }
}
#endif
extern "C" void kernel_launch(void* const* d_in, const int* in_sizes, int n_in, void* d_out, int out_size, void* d_ws, size_t ws_size, hipStream_t stream) {
    static int grid = 0;
    if (grid == 0) {
        if (n_in != 42 || out_size != T * DM || ws_size < WS_END) { fprintf(stderr, "kernel_launch: unexpected shapes: n_in %d out %d ws %zu (need %zu)\n", n_in, out_size, ws_size, (size_t)WS_END); grid = -1; return; }
        int dev = 0, cus = 0, per_cu = 0;
        if (hipGetDevice(&dev) != hipSuccess || hipDeviceGetAttribute(&cus, hipDeviceAttributeMultiprocessorCount, dev) != hipSuccess) { grid = -1; return; }
        if (hipFuncSetAttribute((const void*)fwd, hipFuncAttributeMaxDynamicSharedMemorySize, LDS_BYTES) != hipSuccess) { fprintf(stderr, "kernel_launch: hipFuncSetAttribute failed\n"); grid = -1; return; }
        if (hipOccupancyMaxActiveBlocksPerMultiprocessor(&per_cu, (const void*)fwd, NTHR, LDS_BYTES) != hipSuccess || per_cu < 1) fprintf(stderr, "kernel_launch: occupancy query says %d\n", per_cu);
        (void)hipGetLastError();
        grid = cus;
    }
    if (grid < 0) return;
    (void)in_sizes;
    if (hipMemsetAsync((char*)d_ws + WS_CTL, 0, CTL_ZERO_BYTES, stream) != hipSuccess) return;
#if NANFILL & 64
    if (hipMemsetAsync((char*)d_ws + WS_W, 0xFF, WS_MDN - WS_W, stream) != hipSuccess) return;
#endif
    Args a{};
    for (int i = 0; i < 42; ++i) a.in[i] = d_in[i];
    a.out = (float*)d_out; a.ws = (unsigned char*)d_ws;
#if MK_MULTI
    for (int p = 0; p < NPH; ++p) { a.ph_lo = p; a.ph_hi = p + 1; hipLaunchKernelGGL(fwd, dim3(grid), dim3(NTHR), LDS_BYTES, stream, a);
#if SELFCHK
        const int after[11] = {0, 2, 5, 4, 6, 7, 9, 10, 20, 21, 1};
        for (int k = 1; k <= 10; ++k) if (after[k] == p) hipLaunchKernelGGL(chk, dim3(256), dim3(256), 0, stream, a, k, 0);
#endif
    }
#if SELFCHK
    hipLaunchKernelGGL(chk_final, dim3(1024), dim3(256), 0, stream, a);
#endif
#else
    a.ph_lo = 0; a.ph_hi = NPH; hipLaunchKernelGGL(fwd, dim3(grid), dim3(NTHR), LDS_BYTES, stream, a);
#endif
}
```

```cpp
#include <hip/hip_runtime.h>
#include <cstdio>
#include <cstdint>
namespace pg8 {
#define PG8_LAS __attribute__((address_space(3)))
typedef unsigned short bf16_t;
typedef short bf16x8 __attribute__((ext_vector_type(8)));
typedef float f32x4 __attribute__((ext_vector_type(4)));
typedef unsigned u32x4 __attribute__((ext_vector_type(4)));
constexpr int BM = 256, BK = 64, HALF = 128, HTB = HALF * BK * 2  , STAGE_BYTES = 8 * HTB, NXCD = 8, WGM = 8;

__host__ __device__ __forceinline__ int lds_byte(int r, int c) { const int st = (r >> 4) * 2 + (c >> 5), rr = r & 15, cc = c & 31, ob = rr * 64 + cc * 2; return st * 1024 + (ob ^ (((ob >> 9) & 1) << 5)); }
__host__ __device__ __forceinline__ void stage_rc(int b, int& R, int& C) { const int st = b / 1024, sb = b % 1024, swz = sb ^ (((sb >> 9) & 1) << 5); R = (st >> 1) * 16 + swz / 64; C = (st & 1) * 32 + (swz % 64) / 2; }
__host__ __device__ __forceinline__ int perm32(int rho) { const int n = rho >> 4, i = rho & 15; return 8 * (i >> 2) + 4 * n + (i & 3); }

struct Unit { int pm, pn; int ko = 0; };
struct Gemm { const bf16_t* A; const bf16_t* Bt; int M, N, K; int ld = 0; };

struct StaticOrder {
    int nM, nN, nwg, G, c;
    __host__ __device__ void init(int M, int N, int G_, int c_) { nM = M / BM; nN = N / BM; nwg = nM * nN; G = G_; c = c_; }
    __host__ __device__ bool next(int i, Unit& u) const {
        const long L = (long)i * G + c; if (L >= nwg) return false;
        int wgid = (int)L; { const int q = nwg / NXCD, r = nwg % NXCD, xcd = wgid % NXCD, off = wgid / NXCD; wgid = (xcd < r ? xcd * (q + 1) : r * (q + 1) + (xcd - r) * q) + off; }
        const int nig = WGM * nN, gid = wgid / nig, fm = gid * WGM, gsz = (nM - fm) < WGM ? (nM - fm) : WGM;
        u.pm = fm + ((wgid % nig) % gsz); u.pn = (wgid % nig) / gsz; return true;
    }
    __device__ __forceinline__ void a_ready(const Unit&) const {}
    __device__ __forceinline__ void done(const Unit&) const {}
};

typedef __bf16 bf16x2_cv __attribute__((ext_vector_type(2)));
typedef float f32x2_cv __attribute__((ext_vector_type(2)));
__device__ __forceinline__ unsigned cvt_pk_bf16(float lo, float hi) { const f32x2_cv v = {lo, hi}; const bf16x2_cv b = __builtin_convertvector(v, bf16x2_cv); return __builtin_bit_cast(unsigned, b); }
typedef float f32x2 __attribute__((ext_vector_type(2)));
__device__ __forceinline__ f32x2 gelu_pk(f32x2 v) {
    const f32x2 av = __builtin_elementwise_abs(v), d = av * 0.2316418882f + 1.0f;
    f32x2 t; t.x = __builtin_amdgcn_rcpf(d.x); t.y = __builtin_amdgcn_rcpf(d.y);
    f32x2 q = t * 0.5307027145f + (-0.7265760135f); q = q * t + 0.7107068705f; q = q * t + (-0.142248368f); q = q * t + 0.127414796f; q = q * t;
    const f32x2 s = (v * v) * (-0.72134752044f);
    f32x2 e; e.x = __builtin_amdgcn_exp2f(s.x); e.y = __builtin_amdgcn_exp2f(s.y);
    const f32x2 m = v * (q * e), r = v - m;
    f32x2 o; o.x = v.x < 0.f ? m.x : r.x; o.y = v.y < 0.f ? m.y : r.y; return o;
}

template <int ACT  > struct EpiBf16 {
    static constexpr bool PERM = true, AFTER_DRAIN = false; static_assert(ACT == 0 || ACT == 1, "EpiBf16: ACT is 0 (none) or 1 (gelu_pk)");
    bf16_t* O; int ldc; const float* bias; int split_cols; size_t split_stride; float scale0;
    __device__ __forceinline__ void operator()(const f32x4 (&acc)[2][2][4][2], const Unit& u, int wr, int wc, int fr, int fq) const {
        const int row0 = u.pm * BM + wr * 64 + fr; int colt = u.pn * BM; bf16_t* base = O;
        float sc = 1.f; if (split_cols) { const int t = colt / split_cols; base += (size_t)t * split_stride; colt -= t * split_cols; if (t == 0) sc = scale0; }
        const int col0 = colt + wc * 32 + 8 * fq, bcol0 = u.pn * BM + wc * 32 + 8 * fq;
        f32x4 bv[2][2];
#pragma unroll
        for (int bj = 0; bj < 2; ++bj)
#pragma unroll
            for (int n = 0; n < 2; ++n) bv[bj][n] = bias ? *(const f32x4*)(bias + bcol0 + bj * HALF + 4 * n) : (f32x4){0.f, 0.f, 0.f, 0.f};
#pragma unroll
        for (int ai = 0; ai < 2; ++ai)
#pragma unroll
            for (int m = 0; m < 4; ++m) { bf16_t* rowp = base + (size_t)(row0 + ai * HALF + m * 16) * ldc + col0;
#pragma unroll
                for (int bj = 0; bj < 2; ++bj) { f32x4 v0 = acc[ai][bj][m][0] + bv[bj][0], v1 = acc[ai][bj][m][1] + bv[bj][1];
                    if (ACT == 1) { f32x2 a = gelu_pk((f32x2){v0[0], v0[1]}), b = gelu_pk((f32x2){v0[2], v0[3]}), c = gelu_pk((f32x2){v1[0], v1[1]}), d = gelu_pk((f32x2){v1[2], v1[3]});
                        v0 = (f32x4){a.x, a.y, b.x, b.y}; v1 = (f32x4){c.x, c.y, d.x, d.y}; }
                    v0 = v0 * sc; v1 = v1 * sc; u32x4 w; w.x = cvt_pk_bf16(v0[0], v0[1]); w.y = cvt_pk_bf16(v0[2], v0[3]); w.z = cvt_pk_bf16(v1[0], v1[1]); w.w = cvt_pk_bf16(v1[2], v1[3]);
                    *(u32x4*)(rowp + bj * HALF) = w; } }
    }
};
template <class E, class = void> struct keeps_acc { static constexpr bool value = false; };
template <class E> struct keeps_acc<E, decltype((void)E::KEEP_ACC)> { static constexpr bool value = E::KEEP_ACC; };
template <class Epi, class Sched, bool ALIGN_EPI = false, bool SP2 = false, bool GATHER = false>
__device__ __forceinline__ void gemm_phase(PG8_LAS unsigned char* lds, const Gemm g, const Sched& S, const Epi& E) {
    int tid_l = threadIdx.x; asm volatile("" : "+v"(tid_l));
    const int tid = tid_l, wid = __builtin_amdgcn_readfirstlane(tid >> 6), lane = tid & 63, wr = wid >> 2, wc = wid & 3, fr = lane & 15, fq = lane >> 4;
    const int K = g.K, nt = K / BK, LD = g.ld ? g.ld : g.K;
    unsigned voffA[2], voffB[2];
    static_assert(!GATHER || SP2, "GATHER is wired into the SP2 loop only");
    int RA[2], CA[2];
#pragma unroll
    for (int i = 0; i < 2; ++i) { int R, C; stage_rc(tid * 16 + i * 8192, R, C); const int Rb = Epi::PERM ? ((R & ~31) + perm32(R & 31)) : R; RA[i] = R; CA[i] = C;
        voffA[i] = (unsigned)(R * LD + C) * 2u; voffB[i] = (unsigned)(Rb * LD + C) * 2u; }
    unsigned vgC[2][2] = {{0u, 0u}, {0u, 0u}}, vgN[2][2] = {{0u, 0u}, {0u, 0u}};
    const size_t kstep = (size_t)(BK * 2);
    const size_t hstep = (size_t)HALF * LD * 2;
    const size_t tstep = 2 * hstep;
    const unsigned ldsw = (unsigned)wid * 1024u;
    const int aoff = lds_byte(wr * 64 + fr, fq * 8), boff = lds_byte(wc * 32 + fr, fq * 8);
#define PG8_SA(b, h) (((b) * 2 + (h)) * HTB)
#define PG8_SB(b, h) ((4 + (b) * 2 + (h)) * HTB)
#define PG8_STAGE(bufoff, gbase, voff) do { _Pragma("unroll") for (int _i = 0; _i < 2; ++_i) \
        __builtin_amdgcn_global_load_lds((const unsigned*)((const char*)(gbase) + (voff)[_i]), (PG8_LAS unsigned*)(lds + (bufoff) + ldsw + _i * 8192), 16, 0, 0); } while (0)
#define PG8_STAGE_A(bufoff, kb, h, vsel) do { if constexpr (GATHER) { PG8_STAGE(bufoff, kb, vsel); } else { PG8_STAGE(bufoff, (kb) + (h) * hstep, voffA); } } while (0)
#define PG8_LDA(dst, b, h) do { _Pragma("unroll") for (int m = 0; m < 4; ++m) _Pragma("unroll") for (int k = 0; k < 2; ++k) dst[m][k] = *(const PG8_LAS bf16x8*)(lds + PG8_SA(b, h) + aoff + m * 2048 + k * 1024); } while (0)
#define PG8_LDB(dst, b, h) do { _Pragma("unroll") for (int n = 0; n < 2; ++n) _Pragma("unroll") for (int k = 0; k < 2; ++k) dst[n][k] = *(const PG8_LAS bf16x8*)(lds + PG8_SB(b, h) + boff + n * 2048 + k * 1024); } while (0)
#define PG8_MMA(ai, bj, At, Bt) do { __builtin_amdgcn_s_setprio(1); _Pragma("unroll") for (int m = 0; m < 4; ++m) _Pragma("unroll") for (int n = 0; n < 2; ++n) _Pragma("unroll") for (int k = 0; k < 2; ++k) \
        acc[ai][bj][m][n] = __builtin_amdgcn_mfma_f32_16x16x32_bf16(Bt[n][k], At[m][k], acc[ai][bj][m][n], 0, 0, 0); __builtin_amdgcn_s_setprio(0); } while (0)
#define PG8_WAIT_V(n) asm volatile("s_waitcnt vmcnt(" #n ")" ::: "memory")
#define PG8_WAIT_L(n) asm volatile("s_waitcnt lgkmcnt(" #n ")" ::: "memory")
#define PG8_BAR __builtin_amdgcn_s_barrier()
#define PG8_SCHED __builtin_amdgcn_sched_barrier(0)
    Unit cur, nxt; int ui = 0;
    if (!S.next(0, cur)) return;
    f32x4 acc[2][2][4][2];
#pragma unroll
    for (int a = 0; a < 2; ++a)
#pragma unroll
        for (int b = 0; b < 2; ++b)
#pragma unroll
            for (int m = 0; m < 4; ++m)
#pragma unroll
                for (int n = 0; n < 2; ++n) acc[a][b][m][n] = (f32x4){0.f, 0.f, 0.f, 0.f};
    bf16x8 At[4][2], B0[2][2], B1[2][2];
    const char* cA = (const char*)g.A + (GATHER ? (size_t)0 : (size_t)cur.pm * tstep) + (size_t)cur.ko * 2; const char* cB = (const char*)g.Bt + (size_t)cur.pn * tstep + (size_t)cur.ko * 2;
    S.a_ready(cur);
    if constexpr (GATHER) {
#pragma unroll
        for (int h = 0; h < 2; ++h)
#pragma unroll
            for (int i = 0; i < 2; ++i) vgC[h][i] = S.aoff(cur, h * HALF + RA[i]) + (unsigned)CA[i] * 2u; }
    if constexpr (SP2) {
        PG8_STAGE(PG8_SB(0, 0), cB, voffB); PG8_STAGE(PG8_SB(0, 1), cB + hstep, voffB); PG8_STAGE_A(PG8_SA(0, 0), cA, 0, vgC[0]); PG8_STAGE_A(PG8_SA(0, 1), cA, 1, vgC[1]);
        if (wr == 1) PG8_BAR;
        PG8_WAIT_V(2); PG8_BAR;
        PG8_STAGE(PG8_SB(1, 0), cB + kstep, voffB); PG8_STAGE_A(PG8_SA(1, 0), cA + kstep, 0, vgC[0]); PG8_STAGE(PG8_SB(1, 1), cB + hstep + kstep, voffB);
        PG8_WAIT_V(6); PG8_BAR;
    } else {
        PG8_STAGE(PG8_SB(0, 0), cB, voffB); PG8_STAGE(PG8_SA(0, 0), cA, voffA); PG8_STAGE(PG8_SB(0, 1), cB + hstep, voffB); PG8_STAGE(PG8_SA(0, 1), cA + hstep, voffA);
        if (wr == 1) PG8_BAR;
        PG8_WAIT_V(4); PG8_BAR;
        PG8_STAGE(PG8_SB(1, 0), cB + kstep, voffB); PG8_STAGE(PG8_SA(1, 0), cA + kstep, voffA); PG8_STAGE(PG8_SB(1, 1), cB + hstep + kstep, voffB);
        PG8_WAIT_V(6); PG8_BAR;
    }
    for (;;) {
        const bool has_next = S.next(ui + 1, nxt);
        if constexpr (GATHER) { if (has_next) {
#pragma unroll
            for (int h = 0; h < 2; ++h)
#pragma unroll
                for (int i = 0; i < 2; ++i) vgN[h][i] = S.aoff(nxt, h * HALF + RA[i]) + (unsigned)CA[i] * 2u; } }
        const char* nA = has_next ? (const char*)g.A + (GATHER ? (size_t)0 : (size_t)nxt.pm * tstep) + (size_t)nxt.ko * 2 : cA; const char* nB = has_next ? (const char*)g.Bt + (size_t)nxt.pn * tstep + (size_t)nxt.ko * 2 : cB;
        for (int t = 0; t < nt; t += 2) {
            const bool last = (t == nt - 2);
            const char* a1 = cA + (size_t)(t + 1) * kstep;
            const char* a2 = last ? nA : cA + (size_t)(t + 2) * kstep; const char* b2 = last ? nB : cB + (size_t)(t + 2) * kstep;
            const char* a3 = a2 + kstep; const char* b3 = b2 + kstep;
            if (last && has_next) S.a_ready(nxt);
            unsigned vs0[2] = {vgC[0][0], vgC[0][1]}, vs1[2] = {vgC[1][0], vgC[1][1]};
            if constexpr (GATHER) { if (last && has_next) {
#pragma unroll
                for (int i = 0; i < 2; ++i) { unsigned x0 = vgN[0][i], x1 = vgN[1][i]; asm volatile("" : "+v"(x0), "+v"(x1)); vs0[i] = x0; vs1[i] = x1; } } }
            if constexpr (SP2) {
            PG8_LDB(B0, 0, 0); PG8_LDB(B1, 0, 1); PG8_SCHED; PG8_LDA(At, 0, 0); PG8_STAGE_A(PG8_SA(1, 1), a1, 1, vgC[1]);
            PG8_WAIT_V(8); PG8_WAIT_L(0); PG8_BAR; PG8_MMA(0, 0, At, B0); PG8_MMA(0, 1, At, B1); PG8_BAR; PG8_SCHED;
            PG8_LDA(At, 0, 1); PG8_STAGE(PG8_SB(0, 0), b2, voffB); PG8_STAGE(PG8_SB(0, 1), b2 + hstep, voffB); PG8_STAGE_A(PG8_SA(0, 0), a2, 0, vs0);
            PG8_WAIT_V(8); PG8_WAIT_L(0); PG8_BAR; PG8_MMA(1, 0, At, B0); PG8_MMA(1, 1, At, B1); PG8_BAR; PG8_SCHED;
            PG8_LDB(B0, 1, 0); PG8_LDB(B1, 1, 1); PG8_SCHED; PG8_LDA(At, 1, 0); PG8_STAGE_A(PG8_SA(0, 1), a2, 1, vs1);
            PG8_WAIT_V(8); PG8_WAIT_L(0); PG8_BAR; PG8_MMA(0, 0, At, B0); PG8_MMA(0, 1, At, B1); PG8_BAR; PG8_SCHED;
            PG8_LDA(At, 1, 1); PG8_STAGE(PG8_SB(1, 0), b3, voffB); PG8_STAGE(PG8_SB(1, 1), b3 + hstep, voffB); PG8_STAGE_A(PG8_SA(1, 0), a3, 0, vs0);
            PG8_WAIT_V(8); PG8_WAIT_L(0); PG8_BAR; PG8_MMA(1, 0, At, B0); PG8_MMA(1, 1, At, B1); PG8_BAR; PG8_SCHED;
            } else {
            PG8_LDB(B0, 0, 0); PG8_SCHED; PG8_LDA(At, 0, 0); PG8_STAGE(PG8_SA(1, 1), a1 + hstep, voffA);
            PG8_WAIT_L(8); PG8_BAR; PG8_WAIT_L(0); PG8_MMA(0, 0, At, B0); PG8_BAR; PG8_SCHED;
            PG8_LDB(B1, 0, 1); PG8_STAGE(PG8_SB(0, 0), b2, voffB);
            PG8_BAR; PG8_WAIT_L(0); PG8_MMA(0, 1, At, B1); PG8_BAR;
            PG8_LDA(At, 0, 1); PG8_STAGE(PG8_SA(0, 0), a2, voffA);
            PG8_BAR; PG8_WAIT_L(0); PG8_MMA(1, 0, At, B0); PG8_BAR; PG8_SCHED;
            PG8_STAGE(PG8_SB(0, 1), b2 + hstep, voffB);
            PG8_WAIT_V(6); PG8_BAR; PG8_MMA(1, 1, At, B1); PG8_BAR;
            PG8_LDB(B0, 1, 0); PG8_SCHED; PG8_LDA(At, 1, 0); PG8_STAGE(PG8_SA(0, 1), a2 + hstep, voffA);
            PG8_WAIT_L(8); PG8_BAR; PG8_WAIT_L(0); PG8_MMA(0, 0, At, B0); PG8_BAR; PG8_SCHED;
            PG8_LDB(B1, 1, 1); PG8_STAGE(PG8_SB(1, 0), b3, voffB);
            PG8_BAR; PG8_WAIT_L(0); PG8_MMA(0, 1, At, B1); PG8_BAR;
            PG8_LDA(At, 1, 1); PG8_STAGE(PG8_SA(1, 0), a3, voffA);
            PG8_BAR; PG8_WAIT_L(0); PG8_MMA(1, 0, At, B0); PG8_BAR; PG8_SCHED;
            PG8_STAGE(PG8_SB(1, 1), b3 + hstep, voffB);
            PG8_WAIT_V(6); PG8_BAR; PG8_MMA(1, 1, At, B1); PG8_BAR;
            }
        }
        if constexpr (ALIGN_EPI) { if (wr == 0) PG8_BAR; }
        if constexpr (!Epi::AFTER_DRAIN) { if constexpr (keeps_acc<Epi>::value) E.keep(acc, cur, wr, wc, fr, fq); else E(acc, cur, wr, wc, fr, fq); S.done(cur); }
        if (!has_next) break;
        if constexpr (!keeps_acc<Epi>::value)
#pragma unroll
        for (int a = 0; a < 2; ++a)
#pragma unroll
            for (int b = 0; b < 2; ++b)
#pragma unroll
                for (int m = 0; m < 4; ++m)
#pragma unroll
                    for (int n = 0; n < 2; ++n) acc[a][b][m][n] = (f32x4){0.f, 0.f, 0.f, 0.f};
        cur = nxt; cA = nA; cB = nB; ++ui;
        if constexpr (GATHER) {
#pragma unroll
            for (int h = 0; h < 2; ++h)
#pragma unroll
                for (int i = 0; i < 2; ++i) vgC[h][i] = vgN[h][i]; }
        if constexpr (ALIGN_EPI) { if (wr == 1) PG8_BAR; }
    }
    PG8_WAIT_V(0);
    if constexpr (!ALIGN_EPI) { if (wr == 0) PG8_BAR; }
    PG8_BAR;
    if constexpr (Epi::AFTER_DRAIN) { E.fused(acc, cur, wr, wc, fr, fq, lds, wid, lane); S.done(cur); }
#undef PG8_SA
#undef PG8_SB
#undef PG8_STAGE
#undef PG8_STAGE_A
#undef PG8_LDA
#undef PG8_LDB
#undef PG8_MMA
#undef PG8_WAIT_V
#undef PG8_WAIT_L
#undef PG8_BAR
#undef PG8_SCHED
}
}

#define GAS __attribute__((address_space(1)))
#define LAS __attribute__((address_space(3)))
typedef unsigned short bf16;
typedef unsigned v4u __attribute__((ext_vector_type(4)));
typedef float f32x4 __attribute__((ext_vector_type(4)));
typedef short bf16x8 __attribute__((ext_vector_type(8)));
typedef GAS unsigned gu32;
typedef GAS unsigned long long gu64;
#define RLX_AGENT __ATOMIC_RELAXED, __HIP_MEMORY_SCOPE_AGENT
#define LDS_WAIT() asm volatile("s_waitcnt lgkmcnt(0)" ::: "memory")
#define VM_WAIT() asm volatile("s_waitcnt vmcnt(0)" ::: "memory")
__device__ __forceinline__ unsigned long long rt() { return __builtin_amdgcn_s_memrealtime(); }
__device__ __forceinline__ unsigned f2bf(float f) { unsigned u = __builtin_bit_cast(unsigned, f); return (u + 0x7fffu + ((u >> 16) & 1u)) >> 16; }
__device__ __forceinline__ unsigned pk2(float lo, float hi) { return f2bf(lo) | (f2bf(hi) << 16); }

#define XB_TMO      128
#define XB_XCNT(j)  (256  + 64 * (j))
#define XB_XSUB(j)  (1280 + 64 * (j))
#define XB_XGEN(j)  (2304 + 64 * (j))
#define XB_TOP      3328
#define XB_TOPGEN   3392
#define XCD_BAR_WORDS 3456
#define XB_SPIN_CAP (1u << 18)

__device__ __forceinline__ unsigned xb_ld(unsigned* p)              { return __hip_atomic_load(p, __ATOMIC_RELAXED, __HIP_MEMORY_SCOPE_AGENT); }
__device__ __forceinline__ unsigned xb_add(unsigned* p, unsigned v) { return __hip_atomic_fetch_add(p, v, __ATOMIC_RELAXED, __HIP_MEMORY_SCOPE_AGENT); }
__device__ __forceinline__ unsigned xb_xcc_id() { return (unsigned)__builtin_amdgcn_s_getreg((3 << 11) | 20) & 0xFu; }
#define XB_SPIN(cond, bar) do { unsigned _sp = 0; while (cond) { __builtin_amdgcn_s_sleep(1); \
    if ((++_sp & 255u) == 0u) { if (xb_ld(&(bar)[XB_TMO])) break; if (_sp > XB_SPIN_CAP) { atomicAdd(&(bar)[XB_TMO], 1u); break; } } } } while (0)

struct XcdBarrier {
    unsigned* bar; unsigned x;
    volatile LAS unsigned* st;
};

__device__ __forceinline__ XcdBarrier xcd_barrier_post(unsigned* bar, volatile LAS unsigned* st) {
    XcdBarrier b; b.bar = bar; b.x = xb_xcc_id(); b.st = st;
    if (threadIdx.x == 0) (void)xb_add(&bar[XB_XCNT(b.x)], 1u);
    return b;
}
__device__ __forceinline__ void xcd_barrier_complete(unsigned* bar, unsigned x, unsigned& nloc, unsigned& nx) {
    const unsigned G = gridDim.x * gridDim.y * gridDim.z;
    unsigned sum, cnt, mine, sp = 0u;
    for (;;) {
        sum = 0u; cnt = 0u; mine = 0u;
#pragma unroll
        for (unsigned j = 0; j < 16; ++j) { const unsigned c = xb_ld(&bar[XB_XCNT(j)]); sum += c; cnt += (c > 0u) ? 1u : 0u; mine = (j == x) ? c : mine; }
        if (sum == G) break;
        __builtin_amdgcn_s_sleep(1);
        if ((++sp & 255u) == 0u) { if (xb_ld(&bar[XB_TMO])) break; if (sp > XB_SPIN_CAP) { atomicAdd(&bar[XB_TMO], 1u); break; } }
    }
    nloc = mine > 0u ? mine : 1u; nx = cnt > 0u ? cnt : 1u;
}

__device__ __forceinline__ void xcd_barrier(const XcdBarrier& b) {
    asm volatile("s_waitcnt vmcnt(0)" ::: "memory");
    __syncthreads();
    if (threadIdx.x == 0) {
        unsigned* bar = b.bar;
        __builtin_amdgcn_s_waitcnt(0);
        unsigned nloc = b.st[0], nx = b.st[1];
        if (nloc == 0u) { xcd_barrier_complete(bar, b.x, nloc, nx); b.st[0] = nloc; b.st[1] = nx; }
        const unsigned old = xb_add(&bar[XB_XSUB(b.x)], 1u);
        const unsigned gen = old / nloc;
        if (old + 1u == (gen + 1u) * nloc) {
            __builtin_amdgcn_fence(__ATOMIC_RELEASE, "agent");
            asm volatile("s_waitcnt vmcnt(0)" ::: "memory");
            const unsigned og = xb_add(&bar[XB_TOP], 1u);
            const unsigned tg = og / nx;
            if (og + 1u == (tg + 1u) * nx) xb_add(&bar[XB_TOPGEN], 1u);
            else XB_SPIN(xb_ld(&bar[XB_TOPGEN]) == tg, bar);
            __builtin_amdgcn_fence(__ATOMIC_ACQUIRE, "agent");
            xb_add(&bar[XB_XGEN(b.x)], 1u);
            asm volatile("s_waitcnt vmcnt(0)" ::: "memory");
        } else {
            XB_SPIN(xb_ld(&bar[XB_XGEN(b.x)]) == gen, bar);
            __builtin_amdgcn_fence(__ATOMIC_ACQUIRE, "agent");
            asm volatile("s_waitcnt vmcnt(0)" ::: "memory");
        }
    }
    __syncthreads();
}

constexpr int NWAVES = 8, NTHR = 512;
constexpr int BATCH = 2, SEQ = 8192, T = BATCH * SEQ, DM = 1024;
constexpr int IN_COLS = 8992, PMW = 5120, NMIX = 4896, NGATE = 4096;
constexpr int C_U = 0, C_QKV = 512, C_A = 2048, C_B = 2052, C_Z = 2056, C_NQ = 2568, C_KC = 3080, C_VC = 3208, C_KS = 3336, C_VS = 3464, C_KW = 3592, C_VW = 3720, C_NG = 3848, C_SGU = 3872;
constexpr int FFD = 2816, FFE = 3584, NEXP = 8;
constexpr int NCMP = 511;
constexpr int PASS_TILES = 64, PASS_CAP1 = 72;
__device__ __forceinline__ constexpr int pass_cap(int pass) { return pass == 0 ? PASS_TILES : PASS_CAP1; }
constexpr float RMS_EPS = 1e-6f;
#ifndef MK_MULTI
#define MK_MULTI 0
#endif
constexpr int NPH = 28;
#ifndef ABL
#define ABL 0
#endif
#ifndef NANFILL
#define NANFILL 0
#endif
#ifndef SELFCHK
#define SELFCHK 0
#endif
#ifndef STAMPMASK
#define STAMPMASK 0
#endif
#ifndef STAMPSEL
#define STAMPSEL 0
#endif
#ifndef NSA_NAIVE
#define NSA_NAIVE 0
#endif
#ifndef ABL_LAYERS
#define ABL_LAYERS 3
#endif
#ifndef MASK_T0
#define MASK_T0 0
#endif
#ifndef MASK_T1
#define MASK_T1 0
#endif

constexpr size_t MiB = 1u << 20;
constexpr size_t WS_CTL = 0, CTL_ZERO_BYTES = 1 * MiB;
constexpr int CW_BAR = 4096;
constexpr int CW_NSAQ = 24576;
constexpr int CW_CNT = 16384;
constexpr size_t WS_ROWTOK = 1 * MiB;
constexpr size_t WS_TOKINFO = WS_ROWTOK + 512 * 1024;
constexpr size_t WS_TOKW = WS_TOKINFO + 128 * 1024;
constexpr size_t WS_GBETA = WS_TOKW + 128 * 1024;
constexpr size_t WS_GLA = WS_GBETA + 256 * 1024;
constexpr size_t WS_GSS = 1 * MiB;
constexpr size_t WS_SSME = 4 * MiB;
constexpr size_t WS_KCC = 3 * MiB;
constexpr size_t WS_W = 8 * MiB;
constexpr size_t W_IN1 = 0, W_IN2 = W_IN1 + (size_t)PMW * DM * 2, W_GLU = W_IN2 + (size_t)NGATE * DM * 2, W_BR = W_GLU + 512 * 512 * 2, W_OUT = W_BR + (size_t)4 * 1024 * 512 * 2, W_LAYER = W_OUT + (size_t)DM * DM * 2;
constexpr size_t WS_WL = WS_W;
constexpr size_t WS_FUP = WS_WL + 2 * W_LAYER;
constexpr size_t WS_FDN = WS_FUP + (size_t)2 * FFD * DM * 2;
constexpr size_t WS_MUP = WS_FDN + (size_t)FFD * DM * 2;
constexpr size_t WS_MDN = WS_MUP + (size_t)NEXP * 2 * FFE * DM * 2;
constexpr size_t WS_WEND = WS_MDN + (size_t)NEXP * FFE * DM * 2;
static_assert(WS_WEND <= 244 * MiB, "weights region");
constexpr size_t GDN_UNITS = (size_t)BATCH * (SEQ / 64) * 4;
constexpr size_t WS_GWF = WS_MDN;
constexpr size_t WS_GQF = WS_GWF + GDN_UNITS * 16384;
constexpr size_t WS_GKF = WS_GQF + GDN_UNITS * 16384;
constexpr size_t WS_GAF = WS_GKF + GDN_UNITS * 16384;
static_assert(WS_GAF + GDN_UNITS * 8192 <= WS_WEND, "scratch E");
constexpr size_t WS_GL = 2560 * 1024;
constexpr size_t WS_A = 244 * MiB;
constexpr int MOE_KSPLIT = 7, MOE_XROWS = (PASS_CAP1 - PASS_TILES) * 256;
constexpr size_t WS_YMX = 476 * MiB;
constexpr size_t WS_ZROW = 768 * 1024;
constexpr size_t WS_YM = 404 * MiB + 36 * MiB;
constexpr size_t WS_B = 404 * MiB;
constexpr size_t WS_NKSF = WS_B;
constexpr size_t WS_NVSF = WS_B + 4 * MiB;
constexpr size_t WS_NKWF = WS_B + 8 * MiB;
constexpr size_t WS_NVWF = WS_B + 12 * MiB;
constexpr size_t WS_CW1F = 5 * MiB, WS_CW2F = 7 * MiB, WS_CBIAS = 7 * MiB + 64 * 1024;
constexpr size_t WS_NKCF = 3 * MiB;
constexpr size_t WS_NVCF = 3 * MiB + 256 * 1024;
constexpr size_t WS_D = 468 * MiB;
constexpr size_t WS_GUF = WS_D + 16 * MiB;
constexpr size_t WS_C = 500 * MiB;
constexpr size_t WS_END = 532 * MiB;

constexpr int RING_BYTES = 131072;
constexpr int LDSCTL_OFF = 146432, MISC_OFF = LDSCTL_OFF + 320;
constexpr int LDS_BYTES = 147456;

typedef short bf16x8_t __attribute__((ext_vector_type(8)));
typedef int i32x4 __attribute__((ext_vector_type(4)));
__device__ __forceinline__ bf16x8_t pack_b(const f32x4& t0, const f32x4& t1) {
    const unsigned a = pk2(t0[0], t0[1]), b = pk2(t0[2], t0[3]), c = pk2(t1[0], t1[1]), d = pk2(t1[2], t1[3]); const v4u w = (v4u){a, b, c, d}; return __builtin_bit_cast(bf16x8_t, w);
}
__device__ __forceinline__ unsigned long long pk_fp8x8(float a0, float a1, float a2, float a3, float a4, float a5, float a6, float a7) {
    int lo = 0, hi = 0; lo = __builtin_amdgcn_cvt_pk_fp8_f32(a0, a1, lo, false); lo = __builtin_amdgcn_cvt_pk_fp8_f32(a2, a3, lo, true); hi = __builtin_amdgcn_cvt_pk_fp8_f32(a4, a5, hi, false); hi = __builtin_amdgcn_cvt_pk_fp8_f32(a6, a7, hi, true);
    return (unsigned long long)(unsigned)lo | ((unsigned long long)(unsigned)hi << 32);
}
__device__ __forceinline__ float bf2f(unsigned short b) { return __uint_as_float(((unsigned)b) << 16); }
__device__ __forceinline__ float bflo(unsigned w) { return __uint_as_float(w << 16); }
__device__ __forceinline__ float bfhi(unsigned w) { return __uint_as_float(w & 0xffff0000u); }
__device__ __forceinline__ float sigm(float x) { return __builtin_amdgcn_rcpf(1.f + __expf(-x)); }
__device__ __forceinline__ float gelu_t(float x) { const float p = fmaf(x * x, -0.102943240f, -2.302208199f); return x * __builtin_amdgcn_rcpf(1.f + __builtin_amdgcn_exp2f(x * p)); }
__device__ __forceinline__ float silu_f(float x) { return x * sigm(x); }
constexpr int DPP_X1 = 0xB1, DPP_X2 = 0x4E, DPP_ROR4 = 0x124, DPP_ROR8 = 0x128;
template <int CTRL> __device__ __forceinline__ float dppf(float v) { return __int_as_float(__builtin_amdgcn_update_dpp(0, __float_as_int(v), CTRL, 0xf, 0xf, true)); }
template <int CTRL> __device__ __forceinline__ int dppi(int v) { return __builtin_amdgcn_update_dpp(0, v, CTRL, 0xf, 0xf, true); }
__device__ __forceinline__ float x16_sum(float v) { const auto r = __builtin_amdgcn_permlane16_swap(__float_as_uint(v), __float_as_uint(v), false, false); return __uint_as_float(r[0]) + __uint_as_float(r[1]); }
__device__ __forceinline__ float x32_sum(float v) { const auto r = __builtin_amdgcn_permlane32_swap(__float_as_uint(v), __float_as_uint(v), false, false); return __uint_as_float(r[0]) + __uint_as_float(r[1]); }
__device__ __forceinline__ float x16_max(float v) { const auto r = __builtin_amdgcn_permlane16_swap(__float_as_uint(v), __float_as_uint(v), false, false); return fmaxf(__uint_as_float(r[0]), __uint_as_float(r[1])); }
__device__ __forceinline__ float x32_max(float v) { const auto r = __builtin_amdgcn_permlane32_swap(__float_as_uint(v), __float_as_uint(v), false, false); return fmaxf(__uint_as_float(r[0]), __uint_as_float(r[1])); }
__device__ __forceinline__ float row_sum(float v) { v += dppf<DPP_ROR8>(v); v += dppf<DPP_ROR4>(v); v += dppf<DPP_X2>(v); v += dppf<DPP_X1>(v); return v; }
__device__ __forceinline__ float row_max(float v) { v = fmaxf(v, dppf<DPP_ROR8>(v)); v = fmaxf(v, dppf<DPP_ROR4>(v)); v = fmaxf(v, dppf<DPP_X2>(v)); v = fmaxf(v, dppf<DPP_X1>(v)); return v; }
__device__ __forceinline__ float wave_sum(float v) { return x32_sum(x16_sum(row_sum(v))); }
__device__ __forceinline__ float wave_max(float v) { return x32_max(x16_max(row_max(v))); }

namespace pg8 {
struct EpiStore {
    static constexpr bool PERM = true, AFTER_DRAIN = false;
    bf16_t* O; int ldc; int pnmod; int act;
    __device__ __forceinline__ void operator()(const f32x4 (&acc)[2][2][4][2], const Unit& u, int wr, int wc, int fr, int fq) const {
        const int row0 = u.pm * BM + wr * 64 + fr, col0 = (u.pn % pnmod) * BM + wc * 32 + 8 * fq;
#pragma unroll
        for (int ai = 0; ai < 2; ++ai)
#pragma unroll
            for (int m = 0; m < 4; ++m) { bf16_t* rowp = O + (size_t)(row0 + ai * HALF + m * 16) * ldc + col0;
#pragma unroll
                for (int bj = 0; bj < 2; ++bj) { f32x4 v0 = acc[ai][bj][m][0], v1 = acc[ai][bj][m][1];
                    if (act == 1) {
#pragma unroll
                        for (int j = 0; j < 4; ++j) { v0[j] = sigm(v0[j]); v1[j] = sigm(v1[j]); } }
                    u32x4 w; w.x = cvt_pk_bf16(v0[0], v0[1]); w.y = cvt_pk_bf16(v0[2], v0[3]); w.z = cvt_pk_bf16(v1[0], v1[1]); w.w = cvt_pk_bf16(v1[2], v1[3]);
                    *(u32x4*)(rowp + bj * HALF) = w; } }
    }
};
struct EpiSwiGLU {
    static constexpr bool PERM = true, AFTER_DRAIN = false;
    bf16_t* O; int ldc; int npn;
    __device__ __forceinline__ void operator()(const f32x4 (&acc)[2][2][4][2], const Unit& u, int wr, int wc, int fr, int fq) const {
        const int row0 = u.pm * BM + wr * 64 + fr, col0 = (u.pn % npn) * HALF + wc * 32 + 8 * fq;
#pragma unroll
        for (int ai = 0; ai < 2; ++ai)
#pragma unroll
            for (int m = 0; m < 4; ++m) { bf16_t* rowp = O + (size_t)(row0 + ai * HALF + m * 16) * ldc + col0;
                f32x4 v0, v1;
#pragma unroll
                for (int j = 0; j < 4; ++j) { v0[j] = silu_f(acc[ai][0][m][0][j]) * acc[ai][1][m][0][j]; v1[j] = silu_f(acc[ai][0][m][1][j]) * acc[ai][1][m][1][j]; }
                u32x4 w; w.x = cvt_pk_bf16(v0[0], v0[1]); w.y = cvt_pk_bf16(v0[2], v0[3]); w.z = cvt_pk_bf16(v1[0], v1[1]); w.w = cvt_pk_bf16(v1[2], v1[3]);
                *(u32x4*)rowp = w; }
    }
};
struct EpiResid {
    static constexpr bool PERM = false, AFTER_DRAIN = false;
    const float* base; float* out; int ldc;
    __device__ __forceinline__ void operator()(const f32x4 (&acc)[2][2][4][2], const Unit& u, int wr, int wc, int fr, int fq) const {
        const int row0 = u.pm * BM + wr * 64 + fr, col0 = u.pn * BM + wc * 32 + 4 * fq;
#pragma unroll
        for (int ai = 0; ai < 2; ++ai)
#pragma unroll
            for (int m = 0; m < 4; ++m) { const size_t off = (size_t)(row0 + ai * HALF + m * 16) * ldc + col0;
#pragma unroll
                for (int bj = 0; bj < 2; ++bj)
#pragma unroll
                    for (int n = 0; n < 2; ++n) { const size_t o = off + bj * HALF + n * 16; *(f32x4*)(out + o) = *(const f32x4*)(base + o) + acc[ai][bj][m][n]; } }
    }
};
struct EpiGLU {
    static constexpr bool PERM = true, AFTER_DRAIN = false;
    const bf16_t* ypre; bf16_t* O;
    __device__ __forceinline__ void operator()(const f32x4 (&acc)[2][2][4][2], const Unit& u, int wr, int wc, int fr, int fq) const {
        const int row0 = u.pm * BM + wr * 64 + fr, col0 = u.pn * BM + wc * 32 + 8 * fq;
#pragma unroll
        for (int ai = 0; ai < 2; ++ai)
#pragma unroll
            for (int m = 0; m < 4; ++m) { const size_t off = (size_t)(row0 + ai * HALF + m * 16) * 512 + col0;
#pragma unroll
                for (int bj = 0; bj < 2; ++bj) { const u32x4 y = *(const u32x4*)(ypre + off + bj * HALF); const f32x4 a0 = acc[ai][bj][m][0], a1 = acc[ai][bj][m][1];
                    u32x4 w; w.x = cvt_pk_bf16(bflo(y.x) * sigm(a0[0]), bfhi(y.x) * sigm(a0[1])); w.y = cvt_pk_bf16(bflo(y.y) * sigm(a0[2]), bfhi(y.y) * sigm(a0[3]));
                    w.z = cvt_pk_bf16(bflo(y.z) * sigm(a1[0]), bfhi(y.z) * sigm(a1[1])); w.w = cvt_pk_bf16(bflo(y.w) * sigm(a1[2]), bfhi(y.w) * sigm(a1[3]));
                    *(u32x4*)(O + off + bj * HALF) = w; } }
    }
};
struct EpiMerge {
    static constexpr bool PERM = true, AFTER_DRAIN = false;
    const bf16_t* gate; bf16_t* O; int abl;
    __device__ __forceinline__ void operator()(const f32x4 (&acc)[2][2][4][2], const Unit& u, int wr, int wc, int fr, int fq) const {
        const int b = u.pm >> 6, pm = u.pm & 63, pn = u.pn & 3;
        const int row0 = pm * BM + wr * 64 + fr, col0 = pn * BM + wc * 32 + 8 * fq;
        if (b > 0) { __builtin_amdgcn_fence(__ATOMIC_ACQUIRE, "agent"); asm volatile("s_waitcnt vmcnt(0)" ::: "memory"); }
#pragma unroll
        for (int ai = 0; ai < 2; ++ai)
#pragma unroll
            for (int m = 0; m < 4; ++m) { const int row = row0 + ai * HALF + m * 16;
#pragma unroll
                for (int bj = 0; bj < 2; ++bj) { const int c = col0 + bj * HALF;
                    const u32x4 g = *(const u32x4*)(gate + (size_t)row * NGATE + b * 1024 + c); f32x4 a0 = acc[ai][bj][m][0], a1 = acc[ai][bj][m][1];
                    if ((abl >> b) & 1) { a0 = (f32x4){0.f, 0.f, 0.f, 0.f}; a1 = a0; }
                    float v[8] = {bflo(g.x) * a0[0], bfhi(g.x) * a0[1], bflo(g.y) * a0[2], bfhi(g.y) * a0[3], bflo(g.z) * a1[0], bfhi(g.z) * a1[1], bflo(g.w) * a1[2], bfhi(g.w) * a1[3]};
                    bf16_t* op = O + (size_t)row * 1024 + c;
                    if (b > 0) { const u32x4 p = *(const u32x4*)op; v[0] += bflo(p.x); v[1] += bfhi(p.x); v[2] += bflo(p.y); v[3] += bfhi(p.y); v[4] += bflo(p.z); v[5] += bfhi(p.z); v[6] += bflo(p.w); v[7] += bfhi(p.w); }
                    u32x4 w; w.x = cvt_pk_bf16(v[0], v[1]); w.y = cvt_pk_bf16(v[2], v[3]); w.z = cvt_pk_bf16(v[4], v[5]); w.w = cvt_pk_bf16(v[6], v[7]);
                    *(u32x4*)op = w; } }
    }
};
struct EpiGateRatio {
    static constexpr bool PERM = true, AFTER_DRAIN = false;
    bf16_t* O;
    __device__ __forceinline__ void operator()(const f32x4 (&acc)[2][2][4][2], const Unit& u, int wr, int wc, int fr, int fq) const {
        const int row0 = u.pm * BM + wr * 64 + fr, c0 = u.pn * 64 + 16 * wc + 4 * fq;
#pragma unroll
        for (int ai = 0; ai < 2; ++ai)
#pragma unroll
            for (int m = 0; m < 4; ++m) { bf16_t* rowp = O + (size_t)(row0 + ai * HALF + m * 16) * NGATE + c0; float g[4][4];
#pragma unroll
                for (int b = 0; b < 4; ++b)
#pragma unroll
                    for (int j = 0; j < 4; ++j) g[b][j] = fmaxf(sigm(acc[ai][b >> 1][m][b & 1][j]), 1e-20f);
#pragma unroll
                for (int b = 0; b < 4; ++b) { float r[4];
#pragma unroll
                    for (int j = 0; j < 4; ++j) r[j] = (b < 3) ? g[b][j] * __builtin_amdgcn_rcpf(g[b + 1 < 4 ? b + 1 : 3][j]) : g[3][j];
                    *(unsigned long long*)(rowp + b * 1024) = (unsigned long long)cvt_pk_bf16(r[0], r[1]) | ((unsigned long long)cvt_pk_bf16(r[2], r[3]) << 32); } }
    }
};
struct EpiMergeAcc {
    static constexpr bool PERM = true, AFTER_DRAIN = false, KEEP_ACC = true;
    const bf16_t* ratio; bf16_t* O;
    __device__ __forceinline__ void operator()(const f32x4 (&)[2][2][4][2], const Unit&, int, int, int, int) const {}
    __device__ __forceinline__ void keep(f32x4 (&acc)[2][2][4][2], const Unit& u, int wr, int wc, int fr, int fq) const {
        const int b = u.pm >> 6, pm = u.pm & 63, pn = u.pn & 3;
        const int row0 = pm * BM + wr * 64 + fr, col0 = pn * BM + wc * 32 + 8 * fq;
#pragma unroll
        for (int ai = 0; ai < 2; ++ai)
#pragma unroll
            for (int m = 0; m < 4; ++m) { const int row = row0 + ai * HALF + m * 16;
#pragma unroll
                for (int bj = 0; bj < 2; ++bj) { const int c = col0 + bj * HALF;
                    const u32x4 g = *(const u32x4*)(ratio + (size_t)row * NGATE + b * 1024 + c);
                    f32x4 a0 = acc[ai][bj][m][0], a1 = acc[ai][bj][m][1];
                    a0[0] *= bflo(g.x); a0[1] *= bfhi(g.x); a0[2] *= bflo(g.y); a0[3] *= bfhi(g.y); a1[0] *= bflo(g.z); a1[1] *= bfhi(g.z); a1[2] *= bflo(g.w); a1[3] *= bfhi(g.w);
                    if (b == 3) { u32x4 w; w.x = cvt_pk_bf16(a0[0], a0[1]); w.y = cvt_pk_bf16(a0[2], a0[3]); w.z = cvt_pk_bf16(a1[0], a1[1]); w.w = cvt_pk_bf16(a1[2], a1[3]);
                        *(u32x4*)(O + (size_t)row * 1024 + c) = w; a0 = (f32x4){0.f, 0.f, 0.f, 0.f}; a1 = a0; }
                    acc[ai][bj][m][0] = a0; acc[ai][bj][m][1] = a1; } }
    }
};
struct MergeOrder {
    StaticOrder so;
    __device__ void init(int G_, int c_) { so.init(T, 1024, G_, c_); }
    __device__ bool next(int i, Unit& u) const { Unit t; if (!so.next(i >> 2, t)) return false; const int b = i & 3; u.pm = b * 64 + t.pm; u.pn = b * 4 + t.pn; return true; }
    __device__ __forceinline__ void a_ready(const Unit&) const {}
    __device__ __forceinline__ void done(const Unit&) const {}
};
struct MoeOrder {
    int ntp, tile0, ncol, G, c; int tb1, tb2, tb3, tb4, tb5, tb6, tb7;
    const int* rowtok = nullptr; int cn0 = 0, cn1 = 0, cn2 = 0, cn3 = 0, cn4 = 0, cn5 = 0, cn6 = 0, cn7 = 0; unsigned hoff = 0, zoff = 0;
    __device__ __forceinline__ unsigned aoff(const Unit& u, int r) const {
        const int ti = tile0 + u.pm; const int e = (ti >= tb1) + (ti >= tb2) + (ti >= tb3) + (ti >= tb4) + (ti >= tb5) + (ti >= tb6) + (ti >= tb7);
        const int tbe = e == 0 ? 0 : e == 1 ? tb1 : e == 2 ? tb2 : e == 3 ? tb3 : e == 4 ? tb4 : e == 5 ? tb5 : e == 6 ? tb6 : tb7;
        const int ce = e == 0 ? cn0 : e == 1 ? cn1 : e == 2 ? cn2 : e == 3 ? cn3 : e == 4 ? cn4 : e == 5 ? cn5 : e == 6 ? cn6 : cn7;
        const int rin = (ti - tbe) * 256 + r; const bool valid = rin < ce; const int tok = rowtok[(size_t)e * T + (valid ? rin : 0)];
        return valid ? hoff + (unsigned)tok * (unsigned)(DM * 2) : zoff; }
    __device__ bool next(int i, Unit& u) const {
        const int L = i * G + c; if (L >= ntp * ncol) return false;
        const int pn = L / ntp, tl = L - pn * ntp, ti = tile0 + tl;
        const int e = (ti >= tb1) + (ti >= tb2) + (ti >= tb3) + (ti >= tb4) + (ti >= tb5) + (ti >= tb6) + (ti >= tb7);
        u.pm = tl; u.pn = e * ncol + pn; return true;
    }
    __device__ __forceinline__ void a_ready(const Unit&) const {}
    __device__ __forceinline__ void done(const Unit&) const {}
};
struct MoeSplitOrder {
    int nex, tile0, G, c; int tb1, tb2, tb3, tb4, tb5, tb6, tb7;
    __device__ bool next(int i, Unit& u) const {
        const int L = i * G + c; if (L >= nex * 4 * MOE_KSPLIT) return false;
        const int kp = L % MOE_KSPLIT, rest = L / MOE_KSPLIT, pn4 = rest & 3, tl = PASS_TILES + (rest >> 2), ti = tile0 + tl;
        const int e = (ti >= tb1) + (ti >= tb2) + (ti >= tb3) + (ti >= tb4) + (ti >= tb5) + (ti >= tb6) + (ti >= tb7);
        u.pm = tl; u.pn = e * 4 + pn4; u.ko = kp * (FFE / MOE_KSPLIT); return true;
    }
    __device__ __forceinline__ void a_ready(const Unit&) const {}
    __device__ __forceinline__ void done(const Unit&) const {}
};
struct EpiPartF32 {
    static constexpr bool PERM = false, AFTER_DRAIN = false;
    float* O;
    __device__ __forceinline__ void operator()(const f32x4 (&acc)[2][2][4][2], const Unit& u, int wr, int wc, int fr, int fq) const {
        const int kp = u.ko / (FFE / MOE_KSPLIT); const int row0 = (u.pm - PASS_TILES) * BM + wr * 64 + fr, col0 = (u.pn & 3) * BM + wc * 32 + 4 * fq;
        float* base = O + (size_t)kp * MOE_XROWS * 1024;
#pragma unroll
        for (int ai = 0; ai < 2; ++ai)
#pragma unroll
            for (int m = 0; m < 4; ++m) { const size_t off = (size_t)(row0 + ai * HALF + m * 16) * 1024 + col0;
#pragma unroll
                for (int bj = 0; bj < 2; ++bj)
#pragma unroll
                    for (int n = 0; n < 2; ++n) *(f32x4*)(base + off + bj * HALF + n * 16) = acc[ai][bj][m][n]; }
    }
};
}

struct Args { const void* in[42]; float* out; unsigned char* ws; int ph_lo, ph_hi; };
__device__ __forceinline__ const void* inptr(const Args& a, int i) { asm volatile("" : "+s"(i)); return a.in[i]; }
__device__ __forceinline__ bool in_rng(int lo, int hi, int k) { asm volatile("" : "+s"(lo), "+s"(hi)); return lo <= k && k < hi; }
struct Frame {
    LAS unsigned char* lds;
    volatile LAS unsigned* MISC;
    gu32* ctl;
    int tid, lane, wave, vcu, G, gw, NGW;
};

__device__ __forceinline__ Frame relaunder_unused(const Frame& F) { Frame R = F; asm volatile("" : "+v"(R.tid), "+v"(R.lane), "+s"(R.wave), "+s"(R.vcu), "+s"(R.gw)); return R; }
__device__ __forceinline__ void tr_item(const float* W, int ldw, int K, bf16* WT, int k0, int n0, int drow0, LAS float* scr, int lane, bool gperm = false, int cl0 = 0) {
#pragma unroll 8
    for (int i = 0; i < 32; ++i) { const int kk = 2 * i + (lane >> 5); scr[kk * 33 + (lane & 31)] = W[(size_t)(k0 + kk) * ldw + n0 + (lane & 31)]; }
    LDS_WAIT(); asm volatile("" ::: "memory");
    const int c = lane & 7;
#pragma unroll
    for (int j = 0; j < 4; ++j) { const int n = (lane >> 3) + 8 * j; const LAS float* s = scr + (8 * c) * 33 + n;
        v4u o; o.x = pk2(s[0 * 33], s[1 * 33]); o.y = pk2(s[2 * 33], s[3 * 33]); o.z = pk2(s[4 * 33], s[5 * 33]); o.w = pk2(s[6 * 33], s[7 * 33]);
        const int cl = cl0 + n; const int dr = gperm ? drow0 + 32 * (cl >> 4) + 8 * ((cl >> 2) & 3) + (cl & 3) : drow0 + n;
        *(GAS v4u*)(WT + (size_t)dr * K + k0 + 8 * c) = o; }
    LDS_WAIT(); asm volatile("" ::: "memory");
}
__device__ __forceinline__ void tr_job(Frame& F, const float* W, int ldw, int K, int ncols, bf16* WT, int mode, int& base, LAS float* scr) {
    const int nblk = ncols / 32, nit = (K / 64) * nblk;
    int first = (F.gw - base) % F.NGW; if (first < 0) first += F.NGW;
    for (int it = first; it < nit; it += F.NGW) { const int kb = it / nblk, nb = it - kb * nblk, n0 = 32 * nb;
        if (mode == 3) { const int b = n0 >> 10, cc = n0 & 1023;
            tr_item(W, ldw, K, WT, 64 * kb, n0, 256 * (cc >> 6) + 128 * (b >> 1) + 4 * (b & 1), scr, F.lane, true, cc & 63); }
        else { const int drow = mode == 0 ? n0 : (256 * (n0 >> 7) + (n0 & 127) + (mode == 2 ? 128 : 0));
        tr_item(W, ldw, K, WT, 64 * kb, n0, drow, scr, F.lane); } }
    base = (base + nit) % F.NGW;
}

__device__ __forceinline__ void p_compress_weights(Frame& F, const Args& a) {
    unsigned char* ws = a.ws;
    for (int lk = 0; lk < 4; ++lk) { const int l = lk >> 1, kv = lk & 1;
        const float* w1 = (const float*)inptr(a, kv ? 23 : 20) + (size_t)l * 2048 * 128; const float* w2 = (const float*)inptr(a, kv ? 24 : 21) + (size_t)l * 128 * 64; const float* pe = (const float*)inptr(a, kv ? 22 : 19) + (size_t)l * 2048;
        v4u* w1f = (v4u*)(ws + WS_CW1F + (size_t)lk * 512 * 1024); v4u* w2f = (v4u*)(ws + WS_CW2F + (size_t)lk * 16384); float* bias = (float*)(ws + WS_CBIAS) + lk * 128;
        for (int i = F.gw * 64 + F.lane; i < 64 * 8 * 64; i += F.NGW * 64) { const int lane = i & 63, nt = (i >> 6) & 7, ks = i >> 9; const int n = 16 * nt + (lane & 15), k0 = 32 * ks + 8 * (lane >> 4);
            v4u o; o.x = pk2(w1[(size_t)(k0 + 0) * 128 + n], w1[(size_t)(k0 + 1) * 128 + n]); o.y = pk2(w1[(size_t)(k0 + 2) * 128 + n], w1[(size_t)(k0 + 3) * 128 + n]);
            o.z = pk2(w1[(size_t)(k0 + 4) * 128 + n], w1[(size_t)(k0 + 5) * 128 + n]); o.w = pk2(w1[(size_t)(k0 + 6) * 128 + n], w1[(size_t)(k0 + 7) * 128 + n]); w1f[i] = o; }
        for (int i = F.gw * 64 + F.lane; i < 4 * 4 * 64; i += F.NGW * 64) { const int lane = i & 63, m = (i >> 6) & 3, ks2 = i >> 8; const int d = 16 * m + (lane & 15), lh = lane >> 4; float v[8];
#pragma unroll
            for (int j = 0; j < 8; ++j) v[j] = w2[(size_t)(32 * ks2 + 16 * (j >> 2) + 4 * lh + (j & 3)) * 64 + d];
            v4u o; o.x = pk2(v[0], v[1]); o.y = pk2(v[2], v[3]); o.z = pk2(v[4], v[5]); o.w = pk2(v[6], v[7]); w2f[i] = o; }
        for (int n = F.gw; n < 128; n += F.NGW) { float sacc = 0.f; for (int k = F.lane; k < 2048; k += 64) sacc += pe[k] * w1[(size_t)k * 128 + n]; sacc = wave_sum(sacc); if (F.lane == 0) bias[n] = sacc; }
    }
}
__device__ __forceinline__ void p_prologue(Frame& F, const Args& a) {
    LAS float* scr = (LAS float*)(F.lds + F.wave * 16384);
    unsigned char* ws = a.ws; int base = 0;
#if NANFILL
    { const v4u qn = (v4u){0x7FC07FC0u, 0x7FC07FC0u, 0x7FC07FC0u, 0x7FC07FC0u};
      const size_t lo_[6] = {WS_A, WS_B, WS_C, WS_D, WS_MDN, WS_ROWTOK}, hi_[6] = {WS_B, WS_D, WS_END, WS_C, WS_WEND, 5 * MiB};
#pragma unroll
      for (int r = 0; r < 6; ++r) if ((NANFILL >> r) & 1) { v4u* p = (v4u*)(ws + lo_[r]); const size_t n = (hi_[r] - lo_[r]) / 16;
          for (size_t i = (size_t)F.gw * 64 + F.lane; i < n; i += (size_t)F.NGW * 64) p[i] = qn; } }
#endif
    for (int l = 0; l < 2; ++l) {
        unsigned char* wl = ws + WS_WL + (size_t)l * W_LAYER;
        const float* w_in = (const float*)inptr(a, 5) + (size_t)l * DM * IN_COLS;
        tr_job(F, w_in, IN_COLS, DM, NMIX, (bf16*)(wl + W_IN1), 0, base, scr);
        tr_job(F, w_in + NMIX, IN_COLS, DM, NGATE, (bf16*)(wl + W_IN2), 3, base, scr);
        tr_job(F, (const float*)inptr(a, 14) + (size_t)l * 512 * 512, 512, 512, 512, (bf16*)(wl + W_GLU), 0, base, scr);
        for (int b = 0; b < 4; ++b) tr_job(F, (const float*)inptr(a, 30 + b) + (size_t)l * 512 * 1024, 1024, 512, 1024, (bf16*)(wl + W_BR) + (size_t)b * 1024 * 512, 0, base, scr);
        tr_job(F, (const float*)inptr(a, 34) + (size_t)l * DM * DM, DM, DM, DM, (bf16*)(wl + W_OUT), 0, base, scr);
        { v4u* z = (v4u*)((bf16*)(wl + W_IN1) + (size_t)NMIX * DM); const int n16 = (PMW - NMIX) * DM * 2 / 16;
          for (int i = F.gw * 64 + F.lane; i < n16; i += F.NGW * 64) z[i] = (v4u){0u, 0u, 0u, 0u}; }
    }
    p_compress_weights(F, a);
    tr_job(F, (const float*)inptr(a, 35), FFD, DM, FFD, (bf16*)(ws + WS_FUP), 1, base, scr);
    tr_job(F, (const float*)inptr(a, 36), FFD, DM, FFD, (bf16*)(ws + WS_FUP), 2, base, scr);
    tr_job(F, (const float*)inptr(a, 37), DM, FFD, DM, (bf16*)(ws + WS_FDN), 0, base, scr);
    for (int e = 0; e < NEXP; ++e) {
        tr_job(F, (const float*)inptr(a, 39) + (size_t)e * DM * FFE, FFE, DM, FFE, (bf16*)(ws + WS_MUP) + (size_t)e * 2 * FFE * DM, 1, base, scr);
        tr_job(F, (const float*)inptr(a, 40) + (size_t)e * DM * FFE, FFE, DM, FFE, (bf16*)(ws + WS_MUP) + (size_t)e * 2 * FFE * DM, 2, base, scr);
    }
}
__device__ __forceinline__ void p_conv_moe_down(Frame& F, const Args& a) {
    LAS float* scr = (LAS float*)(F.lds + F.wave * 16384); int base = 0;
    for (int e = 0; e < NEXP; ++e) tr_job(F, (const float*)inptr(a, 41) + (size_t)e * FFE * DM, DM, FFE, DM, (bf16*)(a.ws + WS_MDN) + (size_t)e * DM * FFE, 0, base, scr);
}

template <bool ROUTER, bool INPLACE_F32>
__device__ __forceinline__ void p_norm(Frame& F, const float* xin, const float* gain, bf16* hout, float* fout, const float* router, const Args& a) {
    const f32x4 g0 = ((const f32x4*)gain)[F.lane], g1 = ((const f32x4*)gain)[F.lane + 64], g2 = ((const f32x4*)gain)[F.lane + 128], g3 = ((const f32x4*)gain)[F.lane + 192];
    LAS unsigned* lcnt = (LAS unsigned*)F.lds; LAS unsigned* gbase = (LAS unsigned*)(F.lds + 64); LAS int* stash = (LAS int*)(F.lds + 1024 + F.wave * 256);
    int nstash = 0;
    if (ROUTER) { if (F.tid < 8) lcnt[F.tid] = 0u; __syncthreads(); }
    const int KT = (T + F.NGW - 1) / F.NGW;
    for (int kk = 0; kk < KT; ++kk) { const int m = F.gw + kk * F.NGW;
      if (m < T) {
        const f32x4* xr = (const f32x4*)(xin + (size_t)m * DM) + F.lane;
        f32x4 v[4]; float s = 0.f;
#pragma unroll
        for (int j = 0; j < 4; ++j) { v[j] = xr[64 * j]; s += (v[j].x * v[j].x + v[j].y * v[j].y) + (v[j].z * v[j].z + v[j].w * v[j].w); }
        const float rstd = 1.0f / sqrtf(wave_sum(s) * (1.f / DM) + RMS_EPS);
        v[0] = v[0] * rstd * g0; v[1] = v[1] * rstd * g1; v[2] = v[2] * rstd * g2; v[3] = v[3] * rstd * g3;
        if (INPLACE_F32) {
            if ((m & (SEQ - 1)) >= MASK_T0 && (m & (SEQ - 1)) < MASK_T1) { v[0] = (f32x4){0.f, 0.f, 0.f, 0.f}; v[1] = v[0]; v[2] = v[0]; v[3] = v[0]; }
            f32x4* o = (f32x4*)(fout + (size_t)m * DM) + F.lane;
#pragma unroll
            for (int j = 0; j < 4; ++j) o[64 * j] = v[j];
        } else {
            unsigned long long* o8 = (unsigned long long*)(hout + (size_t)m * DM) + F.lane;
#pragma unroll
            for (int j = 0; j < 4; ++j) o8[64 * j] = (unsigned long long)pk2(v[j].x, v[j].y) | ((unsigned long long)pk2(v[j].z, v[j].w) << 32);
        }
        if (ROUTER) {
            float lg[8];
#pragma unroll
            for (int e = 0; e < 8; ++e) lg[e] = 0.f;
#pragma unroll
            for (int j = 0; j < 4; ++j)
#pragma unroll
                for (int i = 0; i < 4; ++i) { const int c = 4 * (F.lane + 64 * j) + i; const f32x4 r0 = *(const f32x4*)(router + (size_t)c * 8), r1 = *(const f32x4*)(router + (size_t)c * 8 + 4); const float hv = v[j][i];
                    lg[0] += hv * r0.x; lg[1] += hv * r0.y; lg[2] += hv * r0.z; lg[3] += hv * r0.w; lg[4] += hv * r1.x; lg[5] += hv * r1.y; lg[6] += hv * r1.z; lg[7] += hv * r1.w; }
#pragma unroll
            for (int e = 0; e < 8; ++e) lg[e] = wave_sum(lg[e]);
            if (F.lane == 0) {
                int i1 = 0; float v1 = lg[0];
#pragma unroll
                for (int e = 1; e < 8; ++e) if (lg[e] > v1) { v1 = lg[e]; i1 = e; }
                int i2 = -1; float v2 = -3.0e38f;
#pragma unroll
                for (int e = 0; e < 8; ++e) if (e != i1 && lg[e] > v2) { v2 = lg[e]; i2 = e; }
                const float e2 = __expf(v2 - v1), w1 = 1.f / (1.f + e2), w2 = e2 / (1.f + e2);
                stash[4 * nstash] = i1 | (i2 << 8); stash[4 * nstash + 1] = m; stash[4 * nstash + 2] = __float_as_int(w1); stash[4 * nstash + 3] = __float_as_int(w2);
            }
            ++nstash; } }
        if (ROUTER) {
            if ((kk & 7) == 7 || kk == KT - 1) {
                LDS_WAIT(); asm volatile("" ::: "memory");
                const bool act = F.lane < 2 * nstash; const int st = F.lane >> 1, sk = F.lane & 1; int me = -1, mtok = 0; float mw = 0.f;
                if (act) { const int pk = stash[4 * st]; me = sk ? (pk >> 8) : (pk & 255); mtok = stash[4 * st + 1]; mw = __int_as_float(stash[4 * st + 2 + sk]); }
                int rank = 0; unsigned woff = 0u;
#pragma unroll
                for (int e = 0; e < 8; ++e) { const unsigned long long mask = __ballot(me == e);
                    if (mask != 0ull) { const int leader = __builtin_ctzll(mask); unsigned wo = 0u;
                        if (F.lane == leader) wo = __hip_atomic_fetch_add(lcnt + e, (unsigned)__builtin_popcountll(mask), __ATOMIC_RELAXED, __HIP_MEMORY_SCOPE_WORKGROUP);
                        wo = (unsigned)__builtin_amdgcn_readlane((int)wo, leader);
                        if (me == e) { rank = __builtin_popcountll(mask & ((1ull << F.lane) - 1ull)); woff = wo; } } }
                __syncthreads();
                if (F.tid < 8) { const unsigned n = lcnt[F.tid]; gbase[F.tid] = n ? __hip_atomic_fetch_add((unsigned*)(F.ctl + CW_CNT + 64 * F.tid), n, RLX_AGENT) : 0u; }
                __syncthreads();
                if (act) { int* rowtok = (int*)(a.ws + WS_ROWTOK); int* tokinfo = (int*)(a.ws + WS_TOKINFO); float* tokw = (float*)(a.ws + WS_TOKW);
                    const unsigned slot = gbase[me] + woff + (unsigned)rank;
                    rowtok[(size_t)me * T + slot] = mtok; tokinfo[2 * mtok + sk] = (me << 16) | (int)slot; tokw[2 * mtok + sk] = mw; }
                __syncthreads();
                if (F.tid < 8) lcnt[F.tid] = 0u;
                __syncthreads();
                nstash = 0; }
        }
    }
}

struct MoeTiles { int cnt[8]; int tb[9]; };
__device__ __forceinline__ void moe_tiles(Frame& F, MoeTiles& mt) {
    int run = 0;
#pragma unroll
    for (int e = 0; e < 8; ++e) { const int c = (int)__hip_atomic_load((unsigned*)(F.ctl + CW_CNT + 64 * e), RLX_AGENT); mt.cnt[e] = c; mt.tb[e] = run; run += (c + 255) >> 8; }
    mt.tb[8] = run;
}
__device__ __forceinline__ int moe_expert_of(const MoeTiles& mt, int ti) {
    int e = 0;
#pragma unroll
    for (int k = 1; k < 8; ++k) e += (ti >= mt.tb[k]);
    return e;
}
__device__ __forceinline__ void p_moe_gather(Frame& F, const Args& a, const MoeTiles& mt, int pass) {
    const int tile0 = pass * PASS_TILES; int ntp = mt.tb[8] - tile0; ntp = ntp < 0 ? 0 : (ntp > pass_cap(pass) ? pass_cap(pass) : ntp);
    const bf16* H = (const bf16*)(a.ws + WS_C); bf16* HG = (bf16*)(a.ws + WS_B); const int* rowtok = (const int*)(a.ws + WS_ROWTOK);
    for (int r = F.gw; r < ntp * 256; r += F.NGW) {
        const int ti = tile0 + (r >> 8); const int e = moe_expert_of(mt, ti);
        int tbe = 0, ce = 0;
#pragma unroll
        for (int k = 0; k < 8; ++k) { tbe = (k == e) ? mt.tb[k] : tbe; ce = (k == e) ? mt.cnt[k] : ce; }
        const int rin = (ti - tbe) * 256 + (r & 255);
        v4u x0 = (v4u){0u, 0u, 0u, 0u}, x1 = x0;
        if (rin < ce) { const int tok = rowtok[e * T + rin]; const v4u* src = (const v4u*)(H + (size_t)tok * DM); x0 = src[F.lane]; x1 = src[F.lane + 64]; }
        v4u* dst = (v4u*)(HG + (size_t)r * DM); dst[F.lane] = x0; dst[F.lane + 64] = x1;
    }
}
template <bool FINAL>
__device__ __forceinline__ void p_moe_combine(Frame& F, const Args& a, const MoeTiles& mt, int pass) {
    const int tile0 = pass * PASS_TILES;
    const int* tokinfo = (const int*)(a.ws + WS_TOKINFO); const float* tokw = (const float*)(a.ws + WS_TOKW); const bf16* YM = (const bf16*)(a.ws + WS_YM);
    int infA[2][2]; float wA[2][2];
#pragma unroll
    for (int t = 0; t < 2; ++t) { const int m = F.gw + t * F.NGW; const int mc = m < T ? m : 0; infA[t][0] = tokinfo[2 * mc]; infA[t][1] = tokinfo[2 * mc + 1]; wA[t][0] = tokw[2 * mc]; wA[t][1] = tokw[2 * mc + 1]; }
    for (int m0 = F.gw; m0 < T; m0 += 2 * F.NGW) {
        int inf[2][2]; float wv[2][2];
#pragma unroll
        for (int t = 0; t < 2; ++t) { inf[t][0] = infA[t][0]; inf[t][1] = infA[t][1]; wv[t][0] = wA[t][0]; wv[t][1] = wA[t][1]; }
#pragma unroll
        for (int t = 0; t < 2; ++t) { const int m = m0 + (2 + t) * F.NGW; const int mc = m < T ? m : 0; infA[t][0] = tokinfo[2 * mc]; infA[t][1] = tokinfo[2 * mc + 1]; wA[t][0] = tokw[2 * mc]; wA[t][1] = tokw[2 * mc + 1]; }
        bool inp[2][2], ksp[2][2], any[2]; int row[2][2]; f32x4 v[2][4]; unsigned long long ym[2][2][4];
#pragma unroll
        for (int t = 0; t < 2; ++t) { const int m = m0 + t * F.NGW; const bool tv = m < T; any[t] = FINAL && tv;
#pragma unroll
            for (int k = 0; k < 2; ++k) { const int info = inf[t][k]; const int e = info >> 16, pos = info & 0xffff; int tbe = 0;
#pragma unroll
                for (int q = 0; q < 8; ++q) tbe = (q == e) ? mt.tb[q] : tbe;
                const int ti = tbe + (pos >> 8); bool in = tv && ti >= tile0 && ti < tile0 + pass_cap(pass);
                if ((ABL & 64) && k == 1) in = false;
                if ((ABL & 128) && k == 0) in = false;
                inp[t][k] = in; ksp[t][k] = in && (ti - tile0 >= PASS_TILES); row[t][k] = (ti - tile0) * 256 + (pos & 255); any[t] = any[t] || in; } }
#pragma unroll
        for (int t = 0; t < 2; ++t) { const int m = m0 + t * F.NGW;
            if (any[t]) { const f32x4* xr = (const f32x4*)(a.out + (size_t)m * DM) + F.lane;
#pragma unroll
                for (int j = 0; j < 4; ++j) v[t][j] = xr[64 * j]; }
#pragma unroll
            for (int k = 0; k < 2; ++k) if (inp[t][k] && !ksp[t][k]) { const unsigned long long* y8 = (const unsigned long long*)(YM + (size_t)row[t][k] * DM) + F.lane;
#pragma unroll
                for (int j = 0; j < 4; ++j) ym[t][k][j] = y8[64 * j]; } }
#pragma unroll
        for (int t = 0; t < 2; ++t) { const int m = m0 + t * F.NGW; if (!any[t]) continue;
            f32x4* xr = (f32x4*)(a.out + (size_t)m * DM) + F.lane;
#pragma unroll
            for (int k = 0; k < 2; ++k) { if (!inp[t][k]) continue; const float w = wv[t][k];
                if (ksp[t][k]) {
                    const f32x4* px = (const f32x4*)((const float*)(a.ws + WS_YMX) + (size_t)(row[t][k] - PASS_TILES * 256) * DM) + F.lane;
#pragma unroll
                    for (int j = 0; j < 4; ++j) { f32x4 y = px[64 * j];
#pragma unroll
                        for (int kp = 1; kp < MOE_KSPLIT; ++kp) y = y + px[(size_t)kp * MOE_XROWS * (DM / 4) + 64 * j];
                        v[t][j] = v[t][j] + y * w; }
                } else {
#pragma unroll
                    for (int j = 0; j < 4; ++j) { const unsigned long long y = ym[t][k][j]; const unsigned lo = (unsigned)y, hi = (unsigned)(y >> 32);
                        v[t][j].x += w * bflo(lo); v[t][j].y += w * bfhi(lo); v[t][j].z += w * bflo(hi); v[t][j].w += w * bfhi(hi); } } }
            if (FINAL) { float s = 0.f;
#pragma unroll
                for (int j = 0; j < 4; ++j) s += (v[t][j].x * v[t][j].x + v[t][j].y * v[t][j].y) + (v[t][j].z * v[t][j].z + v[t][j].w * v[t][j].w);
                const float rstd = 1.0f / sqrtf(wave_sum(s) * (1.f / DM) + RMS_EPS); const f32x4* gn = (const f32x4*)inptr(a, 4) + F.lane;
#pragma unroll
                for (int j = 0; j < 4; ++j) { f32x4 o = v[t][j] * rstd * gn[64 * j];
                    if ((m & (SEQ - 1)) >= MASK_T0 && (m & (SEQ - 1)) < MASK_T1) o = (f32x4){0.f, 0.f, 0.f, 0.f};
                    xr[64 * j] = o; } }
            else {
#pragma unroll
                for (int j = 0; j < 4; ++j) xr[64 * j] = v[t][j]; } }
    }
}

struct LayerP {
    const float *a_re, *a_im, *log_dt, *b_re, *b_im, *c_re, *c_im, *ssm_d, *conv_w, *a_log, *dt_bias, *gdn_norm;
    const float *kpe, *kw1, *kw2, *vpe, *vw1, *vw2, *rel_bias, *ln_g, *ln_b, *sgu_w, *sgu_b; const int* pos;
};

__device__ __forceinline__ void mix_sgu(Frame& F, const LayerP& L, const bf16* P, bf16* Y3) {
    LAS float* stat = (LAS float*)(F.lds);
    LAS float* vn = (LAS float*)(F.lds + 1024);
    for (int item = F.vcu; item < 256; item += F.G) {
      const int ck = item >> 1, t0 = ck * 128;
      for (int gi = 0; gi < 2; ++gi) { const int gg = 2 * (item & 1) + gi;
        if (gi == 0) { v4u rawv[16];
#pragma unroll
          for (int i = 0; i < 16; ++i) rawv[i] = *(const v4u*)(P + (size_t)(t0 + F.wave * 16 + i) * PMW + C_SGU + 512 + F.lane * 8);
          __builtin_amdgcn_sched_barrier(0);
#pragma unroll
          for (int i = 0; i < 16; ++i) { const int tk = F.wave * 16 + i;
            const v4u raw = rawv[i];
            float x[8] = {gelu_t(bflo(raw.x)), gelu_t(bfhi(raw.x)), gelu_t(bflo(raw.y)), gelu_t(bfhi(raw.y)), gelu_t(bflo(raw.z)), gelu_t(bfhi(raw.z)), gelu_t(bflo(raw.w)), gelu_t(bfhi(raw.w))};
            float s = 0.f;
#pragma unroll
            for (int j = 0; j < 8; ++j) s += x[j];
            const float mu = wave_sum(s) * (1.f / 512.f); float q = 0.f;
#pragma unroll
            for (int j = 0; j < 8; ++j) { const float d = x[j] - mu; q += d * d; }
            const float rstd = 1.0f / sqrtf(wave_sum(q) * (1.f / 512.f) + RMS_EPS);
            if (F.lane == 0) { stat[2 * tk] = mu; stat[2 * tk + 1] = rstd; } } }
        __syncthreads();
        { const int j = F.tid >> 2, d0 = (F.tid & 3) * 32; const float mu = stat[2 * j], rstd = stat[2 * j + 1]; LAS bf16* vt = (LAS bf16*)vn;
#pragma unroll
          for (int q = 0; q < 4; ++q) { const v4u raw = *(const v4u*)(P + (size_t)(t0 + j) * PMW + C_SGU + 512 + gg * 128 + d0 + q * 8);
              const unsigned wv[4] = {raw.x, raw.y, raw.z, raw.w};
#pragma unroll
              for (int k = 0; k < 4; ++k) { const int d = d0 + q * 8 + 2 * k; const int ch = gg * 128 + d;
                  vt[d * 136 + j] = (bf16)f2bf((gelu_t(bflo(wv[k])) - mu) * rstd * L.ln_g[ch] + L.ln_b[ch]);
                  vt[(d + 1) * 136 + j] = (bf16)f2bf((gelu_t(bfhi(wv[k])) - mu) * rstd * L.ln_g[ch + 1] + L.ln_b[ch + 1]); } } }
        __syncthreads();
        { const int m = F.wave, lr = F.lane & 15, lh = F.lane >> 4; const int i = 16 * m + lr; const LAS bf16* vt = (const LAS bf16*)vn;
          const int nks = (16 * m + 15) / 32 + 1;
          bf16x8_t af[4];
#pragma unroll
          for (int ks = 0; ks < 4; ++ks) { const int j0 = 32 * ks + 8 * lh; const float* wr = L.sgu_w + ((size_t)gg * 128 + i) * 128 + j0; const f32x4 w0 = *(const f32x4*)wr, w1 = *(const f32x4*)(wr + 4);
              const float wv[8] = {w0.x, w0.y, w0.z, w0.w, w1.x, w1.y, w1.z, w1.w}; unsigned pw[4];
#pragma unroll
              for (int k = 0; k < 4; ++k) pw[k] = pk2((j0 + 2 * k <= i) ? wv[2 * k] : 0.f, (j0 + 2 * k + 1 <= i) ? wv[2 * k + 1] : 0.f);
              const v4u w = (v4u){pw[0], pw[1], pw[2], pw[3]}; af[ks] = __builtin_bit_cast(bf16x8_t, w); }
          unsigned long long urv[8];
#pragma unroll
          for (int n = 0; n < 8; ++n) urv[n] = *(const unsigned long long*)(P + (size_t)(t0 + 16 * m + lr) * PMW + C_SGU + gg * 128 + 16 * n + 4 * lh);
          const float bsv = L.sgu_b[gg * 128 + 16 * m + lr];
          __builtin_amdgcn_sched_barrier(0);
#pragma unroll
          for (int n = 0; n < 8; ++n) { f32x4 acc = (f32x4){0.f, 0.f, 0.f, 0.f};
#pragma unroll
              for (int ks = 0; ks < 4; ++ks) if (ks < nks) { const bf16x8_t bfr = *(const LAS bf16x8_t*)(vt + (16 * n + lr) * 136 + 32 * ks + 8 * lh); acc = __builtin_amdgcn_mfma_f32_16x16x32_bf16(bfr, af[ks], acc, 0, 0, 0); }
              { const int ii = 16 * m + lr, d = 16 * n + 4 * lh;
                const unsigned long long ur = urv[n]; const unsigned ulo = (unsigned)ur, uhi = (unsigned)(ur >> 32);
                const float y0 = gelu_t(bflo(ulo)) * (acc[0] + bsv), y1 = gelu_t(bfhi(ulo)) * (acc[1] + bsv), y2 = gelu_t(bflo(uhi)) * (acc[2] + bsv), y3 = gelu_t(bfhi(uhi)) * (acc[3] + bsv);
                *(unsigned long long*)(Y3 + (size_t)(t0 + ii) * 512 + gg * 128 + d) = (unsigned long long)pk2(y0, y1) | ((unsigned long long)pk2(y2, y3) << 32); } } }
        __syncthreads();
      }
    }
}

constexpr int SSM_SPAN = 256, SSM_NSPAN = SEQ / SSM_SPAN;
typedef short s16x4 __attribute__((ext_vector_type(4)));
typedef float f32x2v __attribute__((ext_vector_type(2)));
struct SsmLane { float abr, abi, alr, ali; s16x4 bre[4], bim[4]; };
__device__ __forceinline__ void ssm_lane_params(SsmLane& q, const LayerP& L, int g, int n) {
    const float are = L.a_re[g * 64 + n], aim = L.a_im[g * 64 + n], dt = expf(L.log_dt[g]);
    const float mag = expf(are * dt); q.abr = mag * cosf(aim * dt); q.abi = mag * sinf(aim * dt);
    const float magl = expf(are * dt * (float)SSM_SPAN), angl = aim * dt * (float)SSM_SPAN; q.alr = magl * cosf(angl); q.ali = magl * sinf(angl);
    const float nr = q.abr - 1.0f, ni = q.abi, den = are * are + aim * aim; const float sr = (nr * are + ni * aim) / den, si = (ni * are - nr * aim) / den;
    const int lr = n & 15, lh = n >> 4;
#pragma unroll
    for (int qq = 0; qq < 4; ++qq) { const int ns = 16 * qq + lr; const float srs = __shfl(sr, ns), sis = __shfl(si, ns);
        const f32x4 br = *(const f32x4*)(L.b_re + (g * 64 + ns) * 16 + 4 * lh), bi = *(const f32x4*)(L.b_im + (g * 64 + ns) * 16 + 4 * lh);
        unsigned wr[2], wi[2];
        wr[0] = pk2(srs * br[0] - sis * bi[0], srs * br[1] - sis * bi[1]); wr[1] = pk2(srs * br[2] - sis * bi[2], srs * br[3] - sis * bi[3]);
        wi[0] = pk2(srs * bi[0] + sis * br[0], srs * bi[1] + sis * br[1]); wi[1] = pk2(srs * bi[2] + sis * br[2], srs * bi[3] + sis * br[3]);
        q.bre[qq] = __builtin_bit_cast(s16x4, (unsigned long long)wr[0] | ((unsigned long long)wr[1] << 32)); q.bim[qq] = __builtin_bit_cast(s16x4, (unsigned long long)wi[0] | ((unsigned long long)wi[1] << 32)); }
}
__device__ __forceinline__ void ssm_bu16(const SsmLane& q, const LAS bf16* UT, LAS f32x2v* BU, int sb, int lr, int lh) {
    const s16x4 af = *(const LAS s16x4*)(UT + (16 * sb + lr) * 16 + 4 * lh);
#pragma unroll
    for (int qq = 0; qq < 4; ++qq) { const f32x4 z = (f32x4){0.f, 0.f, 0.f, 0.f};
        const f32x4 dr = __builtin_amdgcn_mfma_f32_16x16x16bf16_1k(af, q.bre[qq], z, 0, 0, 0), di = __builtin_amdgcn_mfma_f32_16x16x16bf16_1k(af, q.bim[qq], z, 0, 0, 0);
#pragma unroll
        for (int r = 0; r < 4; ++r) BU[(4 * lh + r) * 64 + 16 * qq + lr] = (f32x2v){dr[r], di[r]}; }
    LDS_WAIT(); asm volatile("" ::: "memory");
}
__device__ __forceinline__ void ssm_load_u(const bf16* P, size_t tok0, int g, int lane, v4u& r0, v4u& r1) { const bf16* src = P + (tok0 + lane) * PMW + C_U + g * 16; r0 = *(const v4u*)src; r1 = *(const v4u*)(src + 8); }
__device__ __forceinline__ void ssm_put_u(LAS bf16* UT, int lane, const v4u& r0, const v4u& r1) { *(LAS v4u*)(UT + lane * 16) = r0; *(LAS v4u*)(UT + lane * 16 + 8) = r1; LDS_WAIT(); asm volatile("" ::: "memory"); }
__device__ __forceinline__ void ssm_pass1(Frame& F_, const LayerP& L, const bf16* P, const Args& a, LAS unsigned char* wl, int first, int stride) {
    LAS bf16* UT = (LAS bf16*)wl; LAS f32x2v* BU = (LAS f32x2v*)(wl + 8192);
    for (int unit = first; unit < BATCH * 32 * SSM_NSPAN; unit += stride) {
        Frame F = F_; asm volatile("" : "+v"(F.lane));
        const int sp = unit % SSM_NSPAN, g = (unit / SSM_NSPAN) & 31, b = unit / (SSM_NSPAN * 32); const int lr = F.lane & 15, lh = F.lane >> 4;
        SsmLane q; ssm_lane_params(q, L, g, F.lane);
        float s_r = 0.f, s_i = 0.f; const size_t tok0 = (size_t)b * SEQ + (size_t)sp * SSM_SPAN;
        v4u r0, r1; ssm_load_u(P, tok0, g, F.lane, r0, r1);
#pragma unroll 1
        for (int blk = 0; blk < SSM_SPAN / 64; ++blk) { ssm_put_u(UT, F.lane, r0, r1);
            if (blk + 1 < SSM_SPAN / 64) ssm_load_u(P, tok0 + (blk + 1) * 64, g, F.lane, r0, r1);
#pragma unroll 1
            for (int sb = 0; sb < 4; ++sb) { ssm_bu16(q, UT, BU, sb, lr, lh);
#pragma unroll
                for (int tt = 0; tt < 16; ++tt) { const f32x2v bu = BU[tt * 64 + F.lane]; const float nsr = q.abr * s_r - q.abi * s_i + bu.x, nsi = q.abr * s_i + q.abi * s_r + bu.y; s_r = nsr; s_i = nsi; }
                LDS_WAIT(); asm volatile("" ::: "memory"); } }
        float2* E = (float2*)(a.ws + WS_SSME); E[(size_t)unit * 64 + F.lane] = make_float2(s_r, s_i);
    }
}
__device__ __forceinline__ void ssm_pass2(Frame& F_, const LayerP& L, const bf16* P, const Args& a, bf16* Ypre, LAS unsigned char* wl, int first, int stride) {
    constexpr int SP_ = 136;
    LAS bf16* UT = (LAS bf16*)wl; LAS bf16* ST = (LAS bf16*)(wl + 2048); LAS f32x2v* BU = (LAS f32x2v*)(wl + 8192);
    for (int unit = first; unit < BATCH * 32 * SSM_NSPAN; unit += stride) {
        Frame F = F_; asm volatile("" : "+v"(F.lane));
        const int sp = unit % SSM_NSPAN, g = (unit / SSM_NSPAN) & 31, b = unit / (SSM_NSPAN * 32); const int lr = F.lane & 15, lh = F.lane >> 4;
        SsmLane q; ssm_lane_params(q, L, g, F.lane);
        bf16x8_t cb[4];
#pragma unroll
        for (int ks = 0; ks < 4; ++ks) { const int kk = 32 * ks + 8 * lh; const float* cp = (kk < 64) ? L.c_re + (g * 16 + lr) * 64 + kk : L.c_im + (g * 16 + lr) * 64 + (kk - 64); const float sg = (kk < 64) ? 1.0f : -1.0f;
            const f32x4 c0 = *(const f32x4*)cp, c1 = *(const f32x4*)(cp + 4); const v4u w = (v4u){pk2(sg * c0.x, sg * c0.y), pk2(sg * c0.z, sg * c0.w), pk2(sg * c1.x, sg * c1.y), pk2(sg * c1.z, sg * c1.w)}; cb[ks] = __builtin_bit_cast(bf16x8_t, w); }
        const f32x4 dsk4 = *(const f32x4*)(L.ssm_d + g * 16 + 4 * lh);
        const size_t tok0 = (size_t)b * SEQ + (size_t)sp * SSM_SPAN;
        v4u r0, r1; ssm_load_u(P, tok0, g, F.lane, r0, r1);
        float s_r = 0.f, s_i = 0.f;
        { const float2* E = (const float2*)(a.ws + WS_SSME) + (size_t)(unit - sp) * 64 + F.lane;
#pragma unroll 4
          for (int k = 0; k < sp; ++k) { const float2 e = E[(size_t)k * 64]; const float nr = q.alr * s_r - q.ali * s_i + e.x, ni = q.alr * s_i + q.ali * s_r + e.y; s_r = nr; s_i = ni; } }
#pragma unroll 1
        for (int blk = 0; blk < SSM_SPAN / 64; ++blk) { ssm_put_u(UT, F.lane, r0, r1);
            if (blk + 1 < SSM_SPAN / 64) ssm_load_u(P, tok0 + (blk + 1) * 64, g, F.lane, r0, r1);
#pragma unroll 1
            for (int sb = 0; sb < 4; ++sb) { ssm_bu16(q, UT, BU, sb, lr, lh);
#pragma unroll
                for (int tt = 0; tt < 16; ++tt) { const f32x2v bu = BU[tt * 64 + F.lane]; const float nsr = q.abr * s_r - q.abi * s_i + bu.x, nsi = q.abr * s_i + q.abi * s_r + bu.y; s_r = nsr; s_i = nsi;
                    ST[tt * SP_ + F.lane] = (bf16)f2bf(s_r); ST[tt * SP_ + 64 + F.lane] = (bf16)f2bf(s_i); }
                LDS_WAIT(); asm volatile("" ::: "memory");
                f32x4 y = (f32x4){0.f, 0.f, 0.f, 0.f};
#pragma unroll
                for (int ks = 0; ks < 4; ++ks) { const bf16x8_t af = *(const LAS bf16x8_t*)(ST + lr * SP_ + 32 * ks + 8 * lh); y = __builtin_amdgcn_mfma_f32_16x16x32_bf16(cb[ks], af, y, 0, 0, 0); }
                { const int tk = sb * 16 + lr; const unsigned long long ur = *(const LAS unsigned long long*)(UT + tk * 16 + 4 * lh); const unsigned ulo = (unsigned)ur, uhi = (unsigned)(ur >> 32);
                  const float y0 = gelu_t(y[0] + dsk4[0] * bflo(ulo)), y1 = gelu_t(y[1] + dsk4[1] * bfhi(ulo)), y2 = gelu_t(y[2] + dsk4[2] * bflo(uhi)), y3 = gelu_t(y[3] + dsk4[3] * bfhi(uhi));
                  *(unsigned long long*)(Ypre + (tok0 + blk * 64 + tk) * 512 + g * 16 + 4 * lh) = (unsigned long long)pk2(y0, y1) | ((unsigned long long)pk2(y2, y3) << 32); }
                LDS_WAIT(); asm volatile("" ::: "memory"); } }
    }
}

__device__ __forceinline__ void nsa_compress_mfma(Frame& F_, const bf16* P, const Args& a, int layer) {
    unsigned char* ws = a.ws; LAS f32x4* PART = (LAS f32x4*)F_.lds;
    LAS f32x4* HT = (LAS f32x4*)(F_.lds + 65536);
    for (int unit = F_.vcu; unit < 2 * 2 * 2 * 32; unit += F_.G) {
        Frame F = F_; asm volatile("" : "+v"(F.lane));
        const int rt = unit & 31, g = (unit >> 5) & 1, b = (unit >> 6) & 1, kv = unit >> 7; const int lr = F.lane & 15, lh = F.lane >> 4, lk = layer * 2 + kv, bg = b * 2 + g, w = F.wave;
        const int c = 16 * rt + lr, cl = c < NCMP ? c : NCMP - 1;
        const bf16* src = P + ((size_t)b * SEQ + (size_t)16 * cl) * PMW + (kv ? C_VC : C_KC) + g * 64 + 8 * lh;
        const v4u* w1f = (const v4u*)(ws + WS_CW1F + (size_t)lk * 512 * 1024); const v4u* w2f = (const v4u*)(ws + WS_CW2F + (size_t)lk * 16384); const float* bias = (const float*)(ws + WS_CBIAS) + lk * 128;
        f32x4 acc[8];
#pragma unroll
        for (int nt = 0; nt < 8; ++nt) acc[nt] = (f32x4){0.f, 0.f, 0.f, 0.f};
#pragma unroll 2
        for (int k8 = 0; k8 < 8; ++k8) { const int ks = 8 * w + k8; const v4u bw = *(const v4u*)(src + (size_t)(ks >> 1) * PMW + (ks & 1) * 32); const bf16x8_t bfr = __builtin_bit_cast(bf16x8_t, bw);
#pragma unroll
            for (int nt = 0; nt < 8; ++nt) { const v4u aw = w1f[(ks * 8 + nt) * 64 + F.lane]; acc[nt] = __builtin_amdgcn_mfma_f32_16x16x32_bf16(__builtin_bit_cast(bf16x8_t, aw), bfr, acc[nt], 0, 0, 0); } }
#pragma unroll
        for (int nt = 0; nt < 8; ++nt) PART[(w * 8 + nt) * 64 + F.lane] = acc[nt];
        __syncthreads();
        { f32x4 sum = (f32x4){0.f, 0.f, 0.f, 0.f};
#pragma unroll
          for (int ww = 0; ww < 8; ++ww) sum = sum + PART[(ww * 8 + w) * 64 + F.lane];
          const f32x4 bv = *(const f32x4*)(bias + 16 * w + 4 * lh);
#pragma unroll
          for (int r = 0; r < 4; ++r) sum[r] = gelu_t(sum[r] + bv[r]);
          HT[w * 64 + F.lane] = sum; }
        __syncthreads();
        if (w < 4) { const int m = w; f32x4 o2 = (f32x4){0.f, 0.f, 0.f, 0.f};
#pragma unroll
            for (int ks2 = 0; ks2 < 4; ++ks2) { const f32x4 h0 = HT[(2 * ks2) * 64 + F.lane], h1 = HT[(2 * ks2 + 1) * 64 + F.lane]; const bf16x8_t hb = pack_b(h0, h1);
                const v4u aw = w2f[(ks2 * 4 + m) * 64 + F.lane]; o2 = __builtin_amdgcn_mfma_f32_16x16x32_bf16(__builtin_bit_cast(bf16x8_t, aw), hb, o2, 0, 0, 0); }
            const bool pad = (c >= NCMP);
            if (kv == 0) { bf16* kcf = (bf16*)(ws + WS_NKCF); const int ks = m >> 1, lhh = (2 * m + (lh >> 1)) & 3, j0 = 4 * (lh & 1);
                const unsigned long long pk = pad ? 0ull : ((unsigned long long)pk2(o2[0], o2[1]) | ((unsigned long long)pk2(o2[2], o2[3]) << 32));
                *(unsigned long long*)(kcf + ((size_t)((bg * 32 + rt) * 2 + ks) * 64 + lhh * 16 + lr) * 8 + j0) = pk; }
            else { bf16* vcf = (bf16*)(ws + WS_NVCF); const int pr = c >> 5, c5 = c & 31, j = 4 * (c5 >> 4) + (c5 & 3), lhh = (c5 >> 2) & 3;
#pragma unroll
                for (int r = 0; r < 4; ++r) vcf[((size_t)((bg * 16 + pr) * 4 + m) * 64 + lhh * 16 + 4 * lh + r) * 8 + j] = pad ? (bf16)0 : (bf16)f2bf(o2[r]); } }
        __syncthreads();
    }
}

__device__ __forceinline__ void mix_nsa_compress(Frame& F, const LayerP& L, const bf16* P, const Args& a, LAS float* hid, int first, int stride) {
#if NSA_NAIVE
    float* KCC = (float*)(a.ws + WS_KCC);
#endif
    for (int unit = first; unit < 2 * 2 * NCMP * 2; unit += stride) {
        const int g = unit & 1; int r = unit >> 1; const int c = r % NCMP; r /= NCMP; const int b = r & 1, kv = r >> 1;
        const float* pe = kv ? L.vpe : L.kpe; const float* w1 = kv ? L.vw1 : L.kw1; const float* w2 = kv ? L.vw2 : L.kw2;
        const bf16* src = P + (size_t)(b * SEQ + c * 16) * PMW + (kv ? C_VC : C_KC) + g * 64;
        float h0 = 0.f, h1 = 0.f;
        for (int l = 0; l < 32; ++l) {
#pragma unroll 4
            for (int d8 = 0; d8 < 8; ++d8) { const v4u raw = *(const v4u*)(src + (size_t)l * PMW + d8 * 8); const unsigned wv[4] = {raw.x, raw.y, raw.z, raw.w};
#pragma unroll
                for (int k = 0; k < 4; ++k) { const int d = d8 * 8 + 2 * k; const float x0 = bflo(wv[k]) + pe[l * 64 + d], x1 = bfhi(wv[k]) + pe[l * 64 + d + 1];
                    const float* wr0 = w1 + (size_t)(l * 64 + d) * 128; h0 += x0 * wr0[F.lane] + x1 * wr0[128 + F.lane]; h1 += x0 * wr0[64 + F.lane] + x1 * wr0[192 + F.lane]; } } }
        hid[F.lane] = gelu_t(h0); hid[64 + F.lane] = gelu_t(h1);
        LDS_WAIT(); asm volatile("" ::: "memory");
        float o = 0.f;
        for (int j = 0; j < 128; ++j) o += hid[j] * w2[j * 64 + F.lane];
#if NSA_NAIVE
        KCC[((size_t)((kv * 2 + b) * 512 + c) * 2 + g) * 64 + F.lane] = o;
#endif
        { const int bg = b * 2 + g, d = F.lane;
          for (int cc = c; cc <= (c == NCMP - 1 ? NCMP : c); ++cc) { const unsigned short val = (cc == c) ? (unsigned short)f2bf(o) : (unsigned short)0;
              if (kv == 0) { const int n = cc >> 4, lrr = cc & 15, ks = d >> 5, lhh = (d >> 3) & 3, j = d & 7; ((bf16*)(a.ws + WS_NKCF))[((size_t)((bg * 32 + n) * 2 + ks) * 64 + lhh * 16 + lrr) * 8 + j] = val; }
              else { const int pr = cc >> 5, c5 = cc & 31, j = 4 * (c5 >> 4) + (c5 & 3), lhh = (c5 >> 2) & 3, m = d >> 4, lrr = d & 15; ((bf16*)(a.ws + WS_NVCF))[((size_t)((bg * 16 + pr) * 4 + m) * 64 + lhh * 16 + lrr) * 8 + j] = val; } } }
        LDS_WAIT(); asm volatile("" ::: "memory");
    }
}

typedef short bf16x8_t __attribute__((ext_vector_type(8)));
__device__ __forceinline__ int permk(int j, int lh) { return 16 * (j >> 2) + 4 * lh + (j & 3); }
__device__ __forceinline__ void gdn_chunk_prep(Frame& F_, const LayerP& L, const bf16* P, const Args& a) {
    constexpr int KP = 136, AP = 68, TP = 72;
    Frame F = F_;
    LAS bf16* KB = (LAS bf16*)(F.lds);
    LAS bf16* QB = (LAS bf16*)(F.lds + 17408);
    LAS bf16* VB = (LAS bf16*)(F.lds + 34816);
    LAS float* AM = (LAS float*)(F.lds + 52224);
    LAS bf16* AT = (LAS bf16*)(F.lds + 69632);
    LAS float* SC = (LAS float*)(F.lds + 78848);
    LAS float* CW = (LAS float*)(F.lds + 80128);
    LAS bf16* XS = (LAS bf16*)(F.lds + 86272);
    unsigned char* ws = a.ws;
    v4u raw[3][4][2]; unsigned short avr = 0, bvr = 0;
#define PREP_LOAD(uu_) do { const int h_ = (uu_) & 3, cidx_ = ((uu_) >> 2) & 127, b_ = (uu_) >> 9; const int i_ = F.tid >> 3, cb_ = (F.tid & 7) * 16; \
        _Pragma("unroll") for (int part = 0; part < 3; ++part) _Pragma("unroll") for (int j = 0; j < 4; ++j) { const int tl = cidx_ * 64 + i_ - 3 + j; \
            const bf16* src = P + (size_t)(b_ * SEQ + (tl < 0 ? 0 : tl)) * PMW + C_QKV + part * 512 + h_ * 128 + cb_; raw[part][j][0] = *(const v4u*)src; raw[part][j][1] = *(const v4u*)(src + 8); } \
        avr = P[((size_t)(b_ * SEQ + cidx_ * 64) + i_) * PMW + C_A + h_]; bvr = P[((size_t)(b_ * SEQ + cidx_ * 64) + i_) * PMW + C_B + h_]; } while (0)
    if (F_.vcu < (int)GDN_UNITS) { F.tid = F_.tid; asm volatile("" : "+v"(F.tid)); PREP_LOAD(F_.vcu); }
    for (int u = F_.vcu; u < (int)GDN_UNITS; u += F_.G) {
        F.tid = F_.tid; asm volatile("" : "+v"(F.tid)); F.lane = F.tid & 63;
        const int h = u & 3, cidx = (u >> 2) & 127, b = u >> 9; const int t0 = b * SEQ + cidx * 64;
        if (u == F_.vcu || (F_.G & 3)) { for (int i = F.tid; i < 4 * 384; i += NTHR) { const int j = i / 384, cc = i - j * 384; const int part = cc >> 7, ch = cc & 127; CW[i] = L.conv_w[j * 1536 + part * 512 + h * 128 + ch]; } }
        { const int i = F.tid >> 3, sub = F.tid & 7, cb = sub * 16;
          __builtin_amdgcn_sched_barrier(0);
          __syncthreads();
#pragma unroll
          for (int part = 0; part < 3; ++part) {
              float acc[16];
#pragma unroll
              for (int q = 0; q < 16; ++q) acc[q] = 0.f;
#pragma unroll
              for (int j = 0; j < 4; ++j) { const int tl = cidx * 64 + i - 3 + j; if (tl >= 0) {
                      const v4u r0 = raw[part][j][0], r1 = raw[part][j][1];
                      const unsigned wv[8] = {r0.x, r0.y, r0.z, r0.w, r1.x, r1.y, r1.z, r1.w}; const LAS float* cw = CW + j * 384 + part * 128 + cb;
#pragma unroll
                      for (int q = 0; q < 8; ++q) { acc[2 * q] += cw[2 * q] * bflo(wv[q]); acc[2 * q + 1] += cw[2 * q + 1] * bfhi(wv[q]); } } }
              float ss = 0.f;
#pragma unroll
              for (int q = 0; q < 16; ++q) { acc[q] = silu_f(acc[q]); ss += acc[q] * acc[q]; }
              float sc = 1.f;
              if (part < 2) { ss += __shfl_xor(ss, 1); ss += __shfl_xor(ss, 2); ss += __shfl_xor(ss, 4); sc = (1.0f / sqrtf(ss + 1e-6f)) * (part == 0 ? 0.08838834764831845f : 1.0f); }
              v4u o0, o1; o0.x = pk2(acc[0] * sc, acc[1] * sc); o0.y = pk2(acc[2] * sc, acc[3] * sc); o0.z = pk2(acc[4] * sc, acc[5] * sc); o0.w = pk2(acc[6] * sc, acc[7] * sc);
              o1.x = pk2(acc[8] * sc, acc[9] * sc); o1.y = pk2(acc[10] * sc, acc[11] * sc); o1.z = pk2(acc[12] * sc, acc[13] * sc); o1.w = pk2(acc[14] * sc, acc[15] * sc);
              LAS bf16* dst = (part == 0 ? QB : (part == 1 ? KB : VB)) + i * KP + cb; *(LAS v4u*)dst = o0; *(LAS v4u*)(dst + 8) = o1; }
          if (sub == 0) { const float av = bf2f(avr), bv = bf2f(bvr);
              const float xx = av + L.dt_bias[h]; const float sp = xx > 20.f ? xx : log1pf(expf(xx)); SC[i] = 1.0f / (1.0f + expf(-bv)); SC[64 + i] = -expf(L.a_log[h]) * sp; } }
        if (u + F_.G < (int)GDN_UNITS) PREP_LOAD(u + F_.G);
        __syncthreads();
        if (F.wave == 0) { float x = SC[64 + F.lane];
#pragma unroll
            for (int o = 1; o < 64; o <<= 1) { const float y = __shfl_up(x, o); if (F.lane >= o) x += y; }
            const float gl = __shfl(x, 63); SC[128 + F.lane] = x; SC[192 + F.lane] = expf(x); SC[256 + F.lane] = expf(gl - x);
            if (F.lane == 63) ((float*)(ws + WS_GL))[u] = expf(x); }
        __syncthreads();
        { const int m = F.wave & 3, isq = F.wave >> 2, lr = F.lane & 15, lh = F.lane >> 4; const LAS bf16* SRC = isq ? QB : KB;
          bf16x8_t af[4];
#pragma unroll
          for (int ks = 0; ks < 4; ++ks) af[ks] = *(const LAS bf16x8_t*)(SRC + (16 * m + lr) * KP + 32 * ks + 8 * lh);
#pragma unroll
          for (int n = 0; n < 4; ++n) { f32x4 acc = (f32x4){0.f, 0.f, 0.f, 0.f};
#pragma unroll
              for (int ks = 0; ks < 4; ++ks) { const bf16x8_t bfr = *(const LAS bf16x8_t*)(KB + (16 * n + lr) * KP + 32 * ks + 8 * lh); acc = __builtin_amdgcn_mfma_f32_16x16x32_bf16(af[ks], bfr, acc, 0, 0, 0); }
              const int j = 16 * n + lr; const float gj = SC[128 + j];
#pragma unroll
              for (int r = 0; r < 4; ++r) { const int i = 16 * m + 4 * lh + r; const float dec = __expf(SC[128 + i] - gj);
                  if (!isq) AM[j * AP + i] = (j < i) ? SC[i] * acc[r] * dec : 0.0f;
                  else AT[i * TP + j] = (bf16)f2bf((j <= i) ? acc[r] * dec : 0.0f); } } }
        __syncthreads();
        LAS bf16* TB = (LAS bf16*)(F.lds + 119040);
        if (F.wave < 4) { const int B = F.wave, lr = F.lane & 15, lh = F.lane >> 4; LAS float* S = (LAS float*)(F.lds + 121088 + F.wave * 1280);
            const f32x4 z4 = (f32x4){0.f, 0.f, 0.f, 0.f};
            float na[4], nb[4];
#pragma unroll
            for (int q = 0; q < 4; ++q) { na[q] = AM[(16 * B + 4 * lh + q) * AP + 16 * B + lr]; nb[q] = AM[(16 * B + lr) * AP + 16 * B + 4 * lh + q]; }
#define PK4(a, b, c, d) __builtin_bit_cast(s16x4, (unsigned long long)pk2((a), (b)) | ((unsigned long long)pk2((c), (d)) << 32))
#define ACC_TO_AOP(acc_, out_) do { _Pragma("unroll") for (int r = 0; r < 4; ++r) S[(4 * lh + r) * 17 + lr] = (acc_)[r]; LDS_WAIT(); asm volatile("" ::: "memory"); \
                _Pragma("unroll") for (int q = 0; q < 4; ++q) (out_)[q] = S[lr * 17 + 4 * lh + q]; LDS_WAIT(); asm volatile("" ::: "memory"); } while (0)
            const s16x4 nA = PK4(na[0], na[1], na[2], na[3]), nAneg = PK4(-na[0], -na[1], -na[2], -na[3]), nB = PK4(nb[0], nb[1], nb[2], nb[3]);
            const f32x4 p2 = __builtin_amdgcn_mfma_f32_16x16x16bf16_1k(nA, nB, z4, 0, 0, 0);
            float p2a[4]; ACC_TO_AOP(p2, p2a); const s16x4 p2A = PK4(p2a[0], p2a[1], p2a[2], p2a[3]), p2B = PK4(p2[0], p2[1], p2[2], p2[3]);
            const f32x4 p4 = __builtin_amdgcn_mfma_f32_16x16x16bf16_1k(p2A, p2B, z4, 0, 0, 0);
            float p4a[4]; ACC_TO_AOP(p4, p4a); const s16x4 p4B = PK4(p4[0], p4[1], p4[2], p4[3]);
            const s16x4 p4A = PK4(p4a[0], p4a[1], p4a[2], p4a[3]);
            const f32x4 p8 = __builtin_amdgcn_mfma_f32_16x16x16bf16_1k(p4A, p4B, z4, 0, 0, 0);
            float ia[4]; f32x4 m1;
#pragma unroll
            for (int q = 0; q < 4; ++q) ia[q] = p4a[q] + ((lr == 4 * lh + q) ? 1.f : 0.f);
#pragma unroll
            for (int r = 0; r < 4; ++r) m1[r] = p4[r] + ((4 * lh + r == lr) ? 1.f : 0.f);
            m1 = __builtin_amdgcn_mfma_f32_16x16x16bf16_1k(PK4(ia[0], ia[1], ia[2], ia[3]), PK4(p8[0], p8[1], p8[2], p8[3]), m1, 0, 0, 0);
            const f32x4 m2 = __builtin_amdgcn_mfma_f32_16x16x16bf16_1k(p2A, PK4(m1[0], m1[1], m1[2], m1[3]), m1, 0, 0, 0);
            const f32x4 tt = __builtin_amdgcn_mfma_f32_16x16x16bf16_1k(nAneg, PK4(m2[0], m2[1], m2[2], m2[3]), m2, 0, 0, 0);
#pragma unroll
            for (int r = 0; r < 4; ++r) TB[B * 256 + (4 * lh + r) * 16 + lr] = (bf16)f2bf(tt[r]);
        } else {
            const int wq = F.wave - 4, lr = F.lane & 15, lh = F.lane >> 4;
            v4u* QF = (v4u*)(ws + WS_GQF + (size_t)u * 16384); v4u* KF = (v4u*)(ws + WS_GKF + (size_t)u * 16384); v4u* AF = (v4u*)(ws + WS_GAF + (size_t)u * 8192);
#pragma unroll
            for (int ks = 0; ks < 4; ++ks) { const int tok = 16 * wq + lr; const float sc = SC[192 + tok]; const LAS bf16* qp = QB + tok * KP + 32 * ks + 4 * lh;
                const unsigned long long q0 = *(const LAS unsigned long long*)qp, q1 = *(const LAS unsigned long long*)(qp + 16);
                v4u o; o.x = pk2(bflo((unsigned)q0) * sc, bfhi((unsigned)q0) * sc); o.y = pk2(bflo((unsigned)(q0 >> 32)) * sc, bfhi((unsigned)(q0 >> 32)) * sc);
                o.z = pk2(bflo((unsigned)q1) * sc, bfhi((unsigned)q1) * sc); o.w = pk2(bflo((unsigned)(q1 >> 32)) * sc, bfhi((unsigned)(q1 >> 32)) * sc);
                QF[(wq * 4 + ks) * 64 + F.lane] = o; }
#pragma unroll
            for (int mm = 0; mm < 2; ++mm)
#pragma unroll
                for (int ks2 = 0; ks2 < 2; ++ks2) { const int md = 2 * wq + mm, d = 16 * md + lr; float v[8];
#pragma unroll
                    for (int j = 0; j < 8; ++j) { const int tok = 32 * ks2 + permk(j, lh); v[j] = bf2f(KB[tok * KP + d]) * SC[256 + tok]; }
                    v4u o; o.x = pk2(v[0], v[1]); o.y = pk2(v[2], v[3]); o.z = pk2(v[4], v[5]); o.w = pk2(v[6], v[7]); KF[(md * 2 + ks2) * 64 + F.lane] = o; }
#pragma unroll
            for (int ks2 = 0; ks2 < 2; ++ks2) { const int i = 16 * wq + lr; const LAS bf16* ap = AT + i * TP + 32 * ks2 + 4 * lh;
                const unsigned long long a0 = *(const LAS unsigned long long*)ap, a1 = *(const LAS unsigned long long*)(ap + 16);
                v4u o; o.x = (unsigned)a0; o.y = (unsigned)(a0 >> 32); o.z = (unsigned)a1; o.w = (unsigned)(a1 >> 32); AF[(wq * 2 + ks2) * 64 + F.lane] = o; }
        }
        __syncthreads();
        { const int w = F.wave, lr = F.lane & 15, lh = F.lane >> 4; const f32x4 z4 = (f32x4){0.f, 0.f, 0.f, 0.f};
          s16x4 Xp[4][2]; unsigned long long* gu = (unsigned long long*)(ws + WS_GUF + (size_t)u * 16384);
#pragma unroll
          for (int B = 0; B < 4; ++B) { f32x4 R[2];
#pragma unroll
              for (int t = 0; t < 2; ++t) { const int c = 32 * w + 16 * t + lr;
#pragma unroll
                  for (int r = 0; r < 4; ++r) { const int i = 16 * B + 4 * lh + r; R[t][r] = (w < 4) ? SC[i] * bf2f(VB[i * KP + c]) : SC[i] * SC[192 + i] * bf2f(KB[i * KP + c - 128]); } }
#pragma unroll
              for (int Bp = 0; Bp < B; ++Bp) { float a[4];
#pragma unroll
                  for (int q = 0; q < 4; ++q) a[q] = -AM[(16 * Bp + 4 * lh + q) * AP + 16 * B + lr];
                  const s16x4 aop = PK4(a[0], a[1], a[2], a[3]);
#pragma unroll
                  for (int t = 0; t < 2; ++t) R[t] = __builtin_amdgcn_mfma_f32_16x16x16bf16_1k(aop, Xp[Bp][t], R[t], 0, 0, 0); }
              const s16x4 top = *(const LAS s16x4*)(TB + B * 256 + lr * 16 + 4 * lh);
#pragma unroll
              for (int t = 0; t < 2; ++t) { const f32x4 x = __builtin_amdgcn_mfma_f32_16x16x16bf16_1k(top, PK4(R[t][0], R[t][1], R[t][2], R[t][3]), z4, 0, 0, 0);
                  Xp[B][t] = PK4(x[0], x[1], x[2], x[3]);
                  if (w < 4) gu[((2 * w + t) * 4 + B) * 64 + F.lane] = __builtin_bit_cast(unsigned long long, Xp[B][t]);
                  else {
#pragma unroll
                      for (int r = 0; r < 4; ++r) XS[(16 * B + 4 * lh + r) * 256 + 32 * w + 16 * t + lr] = (bf16)f2bf(x[r]); } } } }
#undef PK4
#undef ACC_TO_AOP
        __syncthreads();
        { v4u* gwf = (v4u*)(ws + WS_GWF + (size_t)u * 16384);
#pragma unroll
          for (int k = 0; k < 2; ++k) { const int o = F.tid + 512 * k, l = o & 63, ks = (o >> 6) & 3, m = o >> 8; const int i = 16 * m + (l & 15); const LAS bf16* xp = XS + i * 256 + 128 + 32 * ks + 4 * (l >> 4);
              const unsigned long long w0 = *(const LAS unsigned long long*)xp, w1 = *(const LAS unsigned long long*)(xp + 16);
              v4u ov; ov.x = (unsigned)w0 ^ 0x80008000u; ov.y = (unsigned)(w0 >> 32) ^ 0x80008000u; ov.z = (unsigned)w1 ^ 0x80008000u; ov.w = (unsigned)(w1 >> 32) ^ 0x80008000u; gwf[o] = ov; } }
        __syncthreads();
    }
#undef PREP_LOAD
}

__device__ __forceinline__ void gdn_scan(Frame& F, const LayerP& L, const bf16* P, const Args& a, bf16* Y1, int b, int h, int half) {
    constexpr int BUFB = 57344, OTP = 72;
    unsigned char* ws = a.ws; const int w = F.wave, lr = F.lane & 15, lh = F.lane >> 4; const bool comp = w < 4; const int slice = half * 4 + (w & 3);
    LAS unsigned char* buf = F.lds; LAS bf16* OT = (LAS bf16*)(F.lds + 2 * BUFB);
    f32x4 Sacc[8]; bf16x8_t Sb[4];
#pragma unroll
    for (int i = 0; i < 8; ++i) Sacc[i] = (f32x4){0.f, 0.f, 0.f, 0.f};
#pragma unroll
    for (int i = 0; i < 4; ++i) Sb[i] = (bf16x8_t){0, 0, 0, 0, 0, 0, 0, 0};
    v4u stg[7]; unsigned long long uld[4] = {0ull, 0ull, 0ull, 0ull}; float gln = 0.f;
    const int ubase = (b * 128) * 4 + h; float* GSS = (float*)(ws + WS_GSS);
    const int htk = 16 * (w & 3) + (F.lane >> 2), hc0 = 16 * (F.lane & 3), hcol = h * 128 + half * 64 + hc0;
    float ngv[16]; v4u zq[2] = {(v4u){0u, 0u, 0u, 0u}, (v4u){0u, 0u, 0u, 0u}};
#pragma unroll
    for (int q = 0; q < 16; ++q) ngv[q] = comp ? 0.f : L.gdn_norm[half * 64 + hc0 + q];
    if (!comp) { const bf16* zp = P + ((size_t)b * SEQ + htk) * PMW + C_Z + hcol; zq[0] = *(const v4u*)zp; zq[1] = *(const v4u*)(zp + 8); }
    { const size_t u = (size_t)ubase;
#pragma unroll
      for (int k = 0; k < 7; ++k) { const unsigned char* src = (k < 2) ? ws + WS_GWF + u * 16384 + k * 8192 : (k < 4) ? ws + WS_GQF + u * 16384 + (k - 2) * 8192 : (k < 6) ? ws + WS_GKF + u * 16384 + (k - 4) * 8192 : ws + WS_GAF + u * 8192;
          stg[k] = *(const v4u*)(src + F.tid * 16); }
#pragma unroll
      for (int k = 0; k < 7; ++k) *(LAS v4u*)(buf + k * 8192 + F.tid * 16) = stg[k];
      if (comp) {
#pragma unroll
          for (int m = 0; m < 4; ++m) uld[m] = *(const unsigned long long*)(ws + WS_GUF + u * 16384 + (size_t)((slice * 4 + m) * 64 + F.lane) * 8);
          gln = ((const float*)(ws + WS_GL))[u]; } }
    for (int c = 0; c <= 128; ++c) {
        __syncthreads();
        const size_t u = (size_t)ubase + (size_t)c * 4;
        if (c + 1 < 128) { const size_t un = u + 4;
#pragma unroll
            for (int k = 0; k < 7; ++k) { const unsigned char* src = (k < 2) ? ws + WS_GWF + un * 16384 + k * 8192 : (k < 4) ? ws + WS_GQF + un * 16384 + (k - 2) * 8192 : (k < 6) ? ws + WS_GKF + un * 16384 + (k - 4) * 8192 : ws + WS_GAF + un * 8192;
                stg[k] = *(const v4u*)(src + F.tid * 16); } }
        if (comp) { if (c < 128) {
            f32x4 vn[4];
#pragma unroll
            for (int m = 0; m < 4; ++m) { const unsigned lo = (unsigned)uld[m], hi = (unsigned)(uld[m] >> 32); vn[m] = (f32x4){bflo(lo), bfhi(lo), bflo(hi), bfhi(hi)}; }
            const float gl = gln;
            if (c + 1 < 128) { const size_t un = u + 4;
#pragma unroll
                for (int m = 0; m < 4; ++m) uld[m] = *(const unsigned long long*)(ws + WS_GUF + un * 16384 + (size_t)((slice * 4 + m) * 64 + F.lane) * 8);
                gln = ((const float*)(ws + WS_GL))[un]; }
            const LAS unsigned char* cb = buf + (c & 1) * BUFB;
            const LAS bf16x8_t* WFp = (const LAS bf16x8_t*)cb; const LAS bf16x8_t* QFp = (const LAS bf16x8_t*)(cb + 16384); const LAS bf16x8_t* KFp = (const LAS bf16x8_t*)(cb + 32768); const LAS bf16x8_t* AFp = (const LAS bf16x8_t*)(cb + 49152);
            f32x4 o[4];
#pragma unroll
            for (int m = 0; m < 4; ++m) { o[m] = (f32x4){0.f, 0.f, 0.f, 0.f};
#pragma unroll
                for (int ks = 0; ks < 4; ++ks) { vn[m] = __builtin_amdgcn_mfma_f32_16x16x32_bf16(WFp[(m * 4 + ks) * 64 + F.lane], Sb[ks], vn[m], 0, 0, 0);
                    o[m] = __builtin_amdgcn_mfma_f32_16x16x32_bf16(QFp[(m * 4 + ks) * 64 + F.lane], Sb[ks], o[m], 0, 0, 0); } }
            bf16x8_t vb[2]; vb[0] = pack_b(vn[0], vn[1]); vb[1] = pack_b(vn[2], vn[3]);
#pragma unroll
            for (int m = 0; m < 4; ++m)
#pragma unroll
                for (int ks2 = 0; ks2 < 2; ++ks2) o[m] = __builtin_amdgcn_mfma_f32_16x16x32_bf16(AFp[(m * 2 + ks2) * 64 + F.lane], vb[ks2], o[m], 0, 0, 0);
#pragma unroll
            for (int md = 0; md < 8; ++md) { Sacc[md] = Sacc[md] * gl;
#pragma unroll
                for (int ks2 = 0; ks2 < 2; ++ks2) Sacc[md] = __builtin_amdgcn_mfma_f32_16x16x32_bf16(KFp[(md * 2 + ks2) * 64 + F.lane], vb[ks2], Sacc[md], 0, 0, 0); }
#pragma unroll
            for (int ks = 0; ks < 4; ++ks) Sb[ks] = pack_b(Sacc[2 * ks], Sacc[2 * ks + 1]);
            LAS bf16* ot = OT + (c & 1) * (64 * OTP);
#pragma unroll
            for (int m = 0; m < 4; ++m)
#pragma unroll
                for (int r = 0; r < 4; ++r) ot[(16 * m + 4 * lh + r) * OTP + 16 * w + lr] = (bf16)f2bf(o[m][r]);
        } } else {
            const v4u z0 = zq[0], z1 = zq[1];
            if (c < 128) { const bf16* zp = P + ((size_t)b * SEQ + (size_t)c * 64 + htk) * PMW + C_Z + hcol; zq[0] = *(const v4u*)zp; zq[1] = *(const v4u*)(zp + 8); }
            if (c > 0) { const LAS bf16* op = OT + ((c - 1) & 1) * (64 * OTP) + htk * OTP + hc0; const v4u o0 = *(const LAS v4u*)op, o1 = *(const LAS v4u*)(op + 8);
                const unsigned ow[8] = {o0.x, o0.y, o0.z, o0.w, o1.x, o1.y, o1.z, o1.w}, zw[8] = {z0.x, z0.y, z0.z, z0.w, z1.x, z1.y, z1.z, z1.w}; float ssq = 0.f; unsigned yw[8];
#pragma unroll
                for (int q = 0; q < 8; ++q) { const float a0 = bflo(ow[q]), a1 = bfhi(ow[q]); ssq += a0 * a0 + a1 * a1; yw[q] = pk2(a0 * ngv[2 * q] * silu_f(bflo(zw[q])), a1 * ngv[2 * q + 1] * silu_f(bfhi(zw[q]))); }
                ssq += dppf<DPP_X1>(ssq); ssq += dppf<DPP_X2>(ssq);
                const size_t t = (size_t)b * SEQ + (size_t)(c - 1) * 64 + htk; bf16* yp = Y1 + t * 512 + hcol;
                *(v4u*)yp = (v4u){yw[0], yw[1], yw[2], yw[3]}; *(v4u*)(yp + 8) = (v4u){yw[4], yw[5], yw[6], yw[7]};
                if ((F.lane & 3) == 0) GSS[(t * 4 + h) * 2 + half] = ssq; } }
        if (c + 1 < 128) {
#pragma unroll
            for (int k = 0; k < 7; ++k) *(LAS v4u*)(buf + ((c + 1) & 1) * BUFB + k * 8192 + F.tid * 16) = stg[k]; }
    }
    __syncthreads();
}
__device__ __forceinline__ void gdn_norm_pass(Frame& F, const Args& a, bf16* Y1) {
    const float* GSS = (const float*)(a.ws + WS_GSS);
    for (int t = F.gw; t < T; t += F.NGW) { const int hd = F.lane >> 4; const float rs = 1.0f / sqrtf((GSS[((size_t)t * 4 + hd) * 2] + GSS[((size_t)t * 4 + hd) * 2 + 1]) * (1.f / 128.f) + RMS_EPS);
        v4u* p = (v4u*)(Y1 + (size_t)t * 512) + F.lane; const v4u r = *p;
        v4u o; o.x = pk2(bflo(r.x) * rs, bfhi(r.x) * rs); o.y = pk2(bflo(r.y) * rs, bfhi(r.y) * rs); o.z = pk2(bflo(r.z) * rs, bfhi(r.z) * rs); o.w = pk2(bflo(r.w) * rs, bfhi(r.w) * rs); *p = o; }
}

__device__ __forceinline__ void nsa_tiles(Frame& F_, const bf16* P, const Args& a, LAS bf16* tile, int first, int stride) {
    constexpr int TPt = 72;
    for (int unit = first; unit < 2 * 2 * 2 * 128; unit += stride) {
        Frame F = F_; asm volatile("" : "+v"(F.lane));
        const int blk = unit & 127, g = (unit >> 7) & 1, b = (unit >> 8) & 1, which = unit >> 9; const int lr = F.lane & 15, lh = F.lane >> 4;
        const size_t ub = (size_t)((b * 2 + g) * 128 + blk) * 4096;
        v4u rk[8], rv[8];
        { const bf16* s0 = P + ((size_t)b * SEQ + (size_t)blk * 64 + F.lane) * PMW + (which ? C_KW : C_KS) + g * 64; const bf16* s1 = P + ((size_t)b * SEQ + (size_t)blk * 64 + F.lane) * PMW + (which ? C_VW : C_VS) + g * 64;
#pragma unroll
          for (int q = 0; q < 8; ++q) { rk[q] = *(const v4u*)(s0 + q * 8); rv[q] = *(const v4u*)(s1 + q * 8); } }
#pragma unroll
        for (int kv = 0; kv < 2; ++kv) {
#pragma unroll
            for (int q = 0; q < 8; ++q) *(LAS v4u*)(tile + F.lane * TPt + q * 8) = kv ? rv[q] : rk[q];
            LDS_WAIT(); asm volatile("" ::: "memory");
            v4u* out = (v4u*)(a.ws + (which ? (kv ? WS_NVWF : WS_NKWF) : (kv ? WS_NVSF : WS_NKSF)) + ub);
            if (kv == 0) {
#pragma unroll
                for (int m4 = 0; m4 < 4; ++m4) { unsigned long long fr2[2];
#pragma unroll
                    for (int ks = 0; ks < 2; ++ks) { const v4u r = *(const LAS v4u*)(tile + (16 * m4 + lr) * TPt + 32 * ks + 8 * lh);
                        fr2[ks] = pk_fp8x8(bflo(r.x), bfhi(r.x), bflo(r.y), bfhi(r.y), bflo(r.z), bfhi(r.z), bflo(r.w), bfhi(r.w)); }
                    out[m4 * 64 + F.lane] = (v4u){(unsigned)fr2[0], (unsigned)(fr2[0] >> 32), (unsigned)fr2[1], (unsigned)(fr2[1] >> 32)}; }
            } else {
#pragma unroll
                for (int f2 = 0; f2 < 4; ++f2) { const int kk = f2 >> 1, mp = f2 & 1; unsigned long long fr2[2];
#pragma unroll
                    for (int q = 0; q < 2; ++q) { const int m = 2 * mp + q; float v[8];
#pragma unroll
                        for (int k = 0; k < 8; ++k) v[k] = bf2f(tile[(32 * kk + permk(k, lh)) * TPt + 16 * m + lr]);
                        fr2[q] = pk_fp8x8(v[0], v[1], v[2], v[3], v[4], v[5], v[6], v[7]); }
                    out[f2 * 64 + F.lane] = (v4u){(unsigned)fr2[0], (unsigned)(fr2[0] >> 32), (unsigned)fr2[1], (unsigned)(fr2[1] >> 32)}; }
            }
            LDS_WAIT(); asm volatile("" ::: "memory");
        }
    }
}

__device__ __forceinline__ f32x4 nsa_qk(const v4u* kf2, int lane, const bf16x8_t (&qb)[2]) {
    const v4u w0 = kf2[lane], w1 = kf2[64 + lane];
    f32x4 acc = (f32x4){0.f, 0.f, 0.f, 0.f};
    acc = __builtin_amdgcn_mfma_f32_16x16x32_bf16(__builtin_bit_cast(bf16x8_t, w0), qb[0], acc, 0, 0, 0); acc = __builtin_amdgcn_mfma_f32_16x16x32_bf16(__builtin_bit_cast(bf16x8_t, w1), qb[1], acc, 0, 0, 0); return acc;
}
__device__ __forceinline__ f32x4 nsa_qk_lds(const LAS v4u* kf2, int lane, const bf16x8_t (&qb)[2]) {
    const v4u w0 = kf2[lane], w1 = kf2[64 + lane];
    f32x4 acc = (f32x4){0.f, 0.f, 0.f, 0.f};
    acc = __builtin_amdgcn_mfma_f32_16x16x32_bf16(__builtin_bit_cast(bf16x8_t, w0), qb[0], acc, 0, 0, 0); acc = __builtin_amdgcn_mfma_f32_16x16x32_bf16(__builtin_bit_cast(bf16x8_t, w1), qb[1], acc, 0, 0, 0); return acc;
}
__device__ __forceinline__ f32x4 nsa_qk8(const unsigned long long* kf2, int lane, const unsigned long long (&q8)[2]) {
    f32x4 acc = (f32x4){0.f, 0.f, 0.f, 0.f};
    acc = __builtin_amdgcn_mfma_f32_16x16x32_fp8_fp8((long)kf2[lane], (long)q8[0], acc, 0, 0, 0); acc = __builtin_amdgcn_mfma_f32_16x16x32_fp8_fp8((long)kf2[64 + lane], (long)q8[1], acc, 0, 0, 0); return acc;
}
__device__ __forceinline__ void nsa_pv8(f32x4 (&o)[4], const unsigned long long* vf4, int lane, const f32x4& p0, const f32x4& p1) {
    const long pb = (long)pk_fp8x8(p0[0] * 256.f, p0[1] * 256.f, p0[2] * 256.f, p0[3] * 256.f, p1[0] * 256.f, p1[1] * 256.f, p1[2] * 256.f, p1[3] * 256.f);
#pragma unroll
    for (int m = 0; m < 4; ++m) o[m] = __builtin_amdgcn_mfma_f32_16x16x32_fp8_fp8((long)vf4[m * 64 + lane], pb, o[m], 0, 0, 0);
}
__device__ __forceinline__ f32x4 nsa_qk8x(const v4u* kt, int lane, const unsigned long long (&q8)[2], f32x4 acc) {
    const v4u w = kt[lane]; const unsigned long long a0 = (unsigned long long)w.x | ((unsigned long long)w.y << 32), a1 = (unsigned long long)w.z | ((unsigned long long)w.w << 32);
    acc = __builtin_amdgcn_mfma_f32_16x16x32_fp8_fp8((long)a0, (long)q8[0], acc, 0, 0, 0); acc = __builtin_amdgcn_mfma_f32_16x16x32_fp8_fp8((long)a1, (long)q8[1], acc, 0, 0, 0); return acc;
}
__device__ __forceinline__ void nsa_pv8x(f32x4 (&o)[4], const v4u* vs, int lane, unsigned long long pb) {
#pragma unroll
    for (int mp = 0; mp < 2; ++mp) { const v4u w = vs[mp * 64 + lane]; const unsigned long long a0 = (unsigned long long)w.x | ((unsigned long long)w.y << 32), a1 = (unsigned long long)w.z | ((unsigned long long)w.w << 32);
        o[2 * mp] = __builtin_amdgcn_mfma_f32_16x16x32_fp8_fp8((long)a0, (long)pb, o[2 * mp], 0, 0, 0); o[2 * mp + 1] = __builtin_amdgcn_mfma_f32_16x16x32_fp8_fp8((long)a1, (long)pb, o[2 * mp + 1], 0, 0, 0); }
}
__device__ __forceinline__ unsigned long long nsa_pack_p8(const f32x4& p0, const f32x4& p1) { return pk_fp8x8(p0[0] * 256.f, p0[1] * 256.f, p0[2] * 256.f, p0[3] * 256.f, p1[0] * 256.f, p1[1] * 256.f, p1[2] * 256.f, p1[3] * 256.f); }
__device__ __forceinline__ void nsa_pv8p(f32x4 (&o)[4], const unsigned long long* vf4, int lane, unsigned long long pb) {
#pragma unroll
    for (int m = 0; m < 4; ++m) o[m] = __builtin_amdgcn_mfma_f32_16x16x32_fp8_fp8((long)vf4[m * 64 + lane], (long)pb, o[m], 0, 0, 0);
}
__device__ __forceinline__ float lutb(const LAS float* lut, int dist, int gh) { const int dd = dist < 0 ? 0 : (dist > 128 ? 128 : dist); return lut[dd * 8 + gh]; }
__device__ __forceinline__ float red_lh_max(float v) { return x32_max(x16_max(v)); }
__device__ __forceinline__ float red_lh_sum(float v) { return x32_sum(x16_sum(v)); }
__device__ __forceinline__ void nsa_pv(f32x4 (&o)[4], const v4u* vf4, int lane, const f32x4& p0, const f32x4& p1) {
    const bf16x8_t pb = pack_b(p0, p1);
#pragma unroll
    for (int m = 0; m < 4; ++m) { const v4u w = vf4[m * 64 + lane]; o[m] = __builtin_amdgcn_mfma_f32_16x16x32_bf16(__builtin_bit_cast(bf16x8_t, w), pb, o[m], 0, 0, 0); }
}
__device__ __forceinline__ void mix_nsa_mfma(Frame& F_, const LayerP& L, const bf16* P, const Args& a, bf16* Y2, const LAS float* lut, const LAS int* cpos, const LAS int* ptab, const LAS int* bmax, const LAS int* cmax, LAS float* wl, int first, int stride, int nlocal, int bsel, int gsel, int qt0, unsigned* qhead, unsigned* qhead2 = nullptr, int qt0b = 0, const LAS v4u* kclds = nullptr) {
#if STAMPMASK
    unsigned long long tsec[4] = {0ull, 0ull, 0ull, 0ull}, tmark = 0ull;
#define NSA_T0() (tmark = __builtin_amdgcn_s_memrealtime())
#define NSA_T1(k) do { const unsigned long long tn = __builtin_amdgcn_s_memrealtime(); tsec[k] += tn - tmark; tmark = tn; } while (0)
#else
#define NSA_T0() do { } while (0)
#define NSA_T1(k) do { } while (0)
#endif
    LAS float* impT = wl;
    LAS int* sel = (LAS int*)(wl + 512);
    const v4u* KCF = (const v4u*)(a.ws + WS_NKCF); const v4u* VCF = (const v4u*)(a.ws + WS_NVCF);
    const v4u* KSF = (const v4u*)(a.ws + WS_NKSF); const v4u* VSF = (const v4u*)(a.ws + WS_NVSF); const v4u* KWF = (const v4u*)(a.ws + WS_NKWF); const v4u* VWF = (const v4u*)(a.ws + WS_NVWF);
    bool stolen = false;
    for (int lu0 = first;; lu0 += stride) {
        Frame F = F_; asm volatile("" : "+v"(F.lane));
        int lu = lu0;
        if (qhead) { unsigned tk = 0u; if (F.lane == 0) tk = __hip_atomic_fetch_add(qhead, 1u, __ATOMIC_RELAXED, __HIP_MEMORY_SCOPE_AGENT); lu = (int)__builtin_amdgcn_readfirstlane(tk);
            if (lu >= nlocal) { if (!stolen && qhead2) { stolen = true; qhead = qhead2; qt0 = qt0b; continue; } break; }
            lu = nlocal - 1 - lu; }
        else if (lu >= nlocal) break;
        const int g = bsel < 0 ? (lu & 1) : gsel, qt = bsel < 0 ? ((lu >> 1) & (SEQ / 4 - 1)) : (qt0 + lu), b = bsel < 0 ? (lu >> 12) : bsel; const int lr = F.lane & 15, lh = F.lane >> 4, tokc = lr >> 2, head = lr & 3, gh = g * 4 + head, bg = b * 2 + g;
        const int tq0 = qt * 4, tq = tq0 + tokc, tb = tq0 >> 6; const int post = L.pos[tq]; const size_t bt = (size_t)b * SEQ;
        bf16x8_t qb[2]; unsigned long long q8[2];
#pragma unroll
        for (int ks = 0; ks < 2; ++ks) { const v4u r = *(const v4u*)(P + (bt + tq) * PMW + C_NQ + g * 256 + head * 64 + 32 * ks + 8 * lh);
            const v4u w = (v4u){pk2(bflo(r.x) * 0.125f, bfhi(r.x) * 0.125f), pk2(bflo(r.y) * 0.125f, bfhi(r.y) * 0.125f), pk2(bflo(r.z) * 0.125f, bfhi(r.z) * 0.125f), pk2(bflo(r.w) * 0.125f, bfhi(r.w) * 0.125f)}; qb[ks] = __builtin_bit_cast(bf16x8_t, w);
            q8[ks] = pk_fp8x8(bflo(r.x) * 0.125f, bfhi(r.x) * 0.125f, bflo(r.y) * 0.125f, bfhi(r.y) * 0.125f, bflo(r.z) * 0.125f, bfhi(r.z) * 0.125f, bflo(r.w) * 0.125f, bfhi(r.w) * 0.125f); }
        unsigned long long q8t[4][2];
#pragma unroll
        for (int tk = 0; tk < 4; ++tk) { q8t[tk][0] = (tokc == tk) ? q8[0] : 0ull; q8t[tk][1] = (tokc == tk) ? q8[1] : 0ull; }
        f32x4 outv[4];
#pragma unroll
        for (int m = 0; m < 4; ++m) outv[m] = (f32x4){0.f, 0.f, 0.f, 0.f};
        const bf16* ngp = P + (bt + tq) * PMW + C_NG + g * 12 + head * 3; const float gate_c = sigm(bf2f(ngp[0])), gate_s = sigm(bf2f(ngp[1])), gate_w = sigm(bf2f(ngp[2])); const float cbfar = lut[128 * 8 + gh];
        NSA_T0();
        const int ncv = tq >= 31 ? ((tq - 31) >> 4) + 1 : 0; const int nv3 = (tq0 + 3) >= 31 ? ((tq0 + 3 - 31) >> 4) + 1 : 0; const int npair = (nv3 + 31) >> 5;
        const v4u* kcf = KCF + (size_t)bg * 32 * 2 * 64; const v4u* vcf = VCF + (size_t)bg * 16 * 4 * 64;
        float mc = -1e30f, lc = 0.f;
#pragma unroll 2
        for (int n = 0; n < 2 * npair; ++n) { const f32x4 s = kclds ? nsa_qk_lds(kclds + n * 128, F.lane, qb) : nsa_qk(kcf + (size_t)n * 128, F.lane, qb); float sv[4]; float tm = -1e30f;
            if (__all((16 * n + 15 < ncv) && (post - cmax[n] >= 128))) {
#pragma unroll
                for (int r = 0; r < 4; ++r) { sv[r] = s[r] + cbfar; tm = fmaxf(tm, sv[r]); }
            } else { const i32x4 cp = *(const LAS i32x4*)(cpos + 16 * n + 4 * lh); const int cpv[4] = {cp.x, cp.y, cp.z, cp.w};
#pragma unroll
            for (int r = 0; r < 4; ++r) { const int c = 16 * n + 4 * lh + r; const bool valid = c < ncv; sv[r] = valid ? s[r] + lutb(lut, post - cpv[r], gh) : -1e30f; tm = fmaxf(tm, sv[r]); } }
            const float mn = fmaxf(mc, tm); float ad = 0.f;
#pragma unroll
            for (int r = 0; r < 4; ++r) ad += (sv[r] > -1e29f) ? __expf(sv[r] - mn) : 0.f;
            lc = lc * __expf(mc - mn) + ad; mc = mn; }
        { const float mt = red_lh_max(mc); lc = red_lh_sum(lc * __expf(mc - mt)); mc = mt; }
        const float icl = (ncv > 0 && lc > 0.f) ? 1.0f / lc : 0.f;
        { f32x4 oc[4];
#pragma unroll
          for (int m = 0; m < 4; ++m) oc[m] = (f32x4){0.f, 0.f, 0.f, 0.f};
          float carry = 0.f;
#pragma unroll 1
          for (int pr = 0; pr < npair; ++pr) { f32x4 pt[2];
#pragma unroll
              for (int h2 = 0; h2 < 2; ++h2) { const int n = 2 * pr + h2; const f32x4 s = kclds ? nsa_qk_lds(kclds + n * 128, F.lane, qb) : nsa_qk(kcf + (size_t)n * 128, F.lane, qb);
                  if (__all((16 * n + 15 < ncv) && (post - cmax[n] >= 128))) {
#pragma unroll
                      for (int r = 0; r < 4; ++r) pt[h2][r] = __expf(s[r] + cbfar - mc) * icl;
                  } else { const i32x4 cp = *(const LAS i32x4*)(cpos + 16 * n + 4 * lh); const int cpv[4] = {cp.x, cp.y, cp.z, cp.w};
#pragma unroll
                  for (int r = 0; r < 4; ++r) { const int c = 16 * n + 4 * lh + r; const bool valid = c < ncv; pt[h2][r] = valid ? __expf(s[r] + lutb(lut, post - cpv[r], gh) - mc) * icl : 0.f; } }
                  float up;
                  { const unsigned xb = __float_as_uint(pt[h2][3]); const auto r = __builtin_amdgcn_permlane16_swap(xb, xb, false, false);
                    const auto t = __builtin_amdgcn_permlane32_swap(r[1], r[1], false, false);
                    up = (lh == 0) ? carry : (lh == 2) ? __uint_as_float(t[0]) : __uint_as_float(r[0]); carry = __uint_as_float(t[1]); }
                  float e = (pt[h2][0] + pt[h2][1]) + (pt[h2][2] + pt[h2][3]) + up; e += dppf<DPP_X1>(e); e += dppf<DPP_X2>(e);
                  if (head == 0) impT[tokc * 128 + 4 * n + lh] = e; }
              nsa_pv(oc, vcf + (size_t)pr * 256, F.lane, pt[0], pt[1]); }
#pragma unroll
          for (int m = 0; m < 4; ++m) outv[m] = outv[m] + oc[m] * gate_c; }
        LDS_WAIT(); asm volatile("" ::: "memory");
        NSA_T1(0);
        const int nsel = (tb + 1) < 16 ? (tb + 1) : 16;
        { const int tks = lh; float sc[8];
#pragma unroll
          for (int q = 0; q < 8; ++q) { const int j = lr + 16 * q; const bool forced = (j == 0) || (j == tb) || (j == tb - 1); sc[q] = forced ? 1e9f : (j <= tb ? impT[tks * 128 + j] : -1e9f); }
#pragma unroll 1
          for (int it = 0; it < nsel; ++it) { float bv = sc[0]; int bi = lr;
#pragma unroll
              for (int q = 1; q < 8; ++q) if (sc[q] > bv) { bv = sc[q]; bi = lr + 16 * q; }
#pragma unroll
              for (int st = 0; st < 4; ++st) { const float ov = st == 0 ? dppf<DPP_ROR8>(bv) : st == 1 ? dppf<DPP_ROR4>(bv) : st == 2 ? dppf<DPP_X2>(bv) : dppf<DPP_X1>(bv);
                  const int oi = st == 0 ? dppi<DPP_ROR8>(bi) : st == 1 ? dppi<DPP_ROR4>(bi) : st == 2 ? dppi<DPP_X2>(bi) : dppi<DPP_X1>(bi); if (ov > bv || (ov == bv && oi < bi)) { bv = ov; bi = oi; } }
              if (lr == 0) sel[tks * 16 + it] = bi;
#pragma unroll
              for (int q = 0; q < 8; ++q) if (bi == lr + 16 * q) sc[q] = -3.0e38f; } }
        LDS_WAIT(); asm volatile("" ::: "memory");
        NSA_T1(1);
        { f32x4 os[4];
#pragma unroll
          for (int m = 0; m < 4; ++m) os[m] = (f32x4){0.f, 0.f, 0.f, 0.f};
          float ms = -1e30f, ls = 0.f;
#pragma unroll 1
          for (int it = 0; it < nsel; ++it) { int jt[4];
#pragma unroll
              for (int tk = 0; tk < 4; ++tk) jt[tk] = __builtin_amdgcn_readfirstlane(sel[tk * 16 + it]);
              const int jmine = sel[tokc * 16 + it]; f32x4 pt[4];
#pragma unroll
              for (int m4 = 0; m4 < 4; ++m4) pt[m4] = (f32x4){0.f, 0.f, 0.f, 0.f};
              const bool same = (jt[0] == jt[1]) && (jt[1] == jt[2]) && (jt[2] == jt[3]);
              v4u kw[4][4], vw[4][4];
              if (same) { const v4u* kf = KSF + (size_t)(bg * 128 + jt[0]) * 256 + F.lane;
#pragma unroll
                  for (int m4 = 0; m4 < 4; ++m4) kw[0][m4] = kf[m4 * 64];
                  __builtin_amdgcn_sched_barrier(0);
#pragma unroll
                  for (int m4 = 0; m4 < 4; ++m4) { const v4u w = kw[0][m4]; const unsigned long long a0 = (unsigned long long)w.x | ((unsigned long long)w.y << 32), a1 = (unsigned long long)w.z | ((unsigned long long)w.w << 32);
                      pt[m4] = __builtin_amdgcn_mfma_f32_16x16x32_fp8_fp8((long)a0, (long)q8[0], pt[m4], 0, 0, 0); pt[m4] = __builtin_amdgcn_mfma_f32_16x16x32_fp8_fp8((long)a1, (long)q8[1], pt[m4], 0, 0, 0); }
                  __builtin_amdgcn_sched_barrier(0);
                  const v4u* vf = VSF + (size_t)(bg * 128 + jt[0]) * 256 + F.lane;
#pragma unroll
                  for (int i4 = 0; i4 < 4; ++i4) vw[0][i4] = vf[i4 * 64];
                  __builtin_amdgcn_sched_barrier(0);
              } else {
#pragma unroll
              for (int tk = 0; tk < 4; ++tk) { const v4u* kf = KSF + (size_t)(bg * 128 + jt[tk]) * 256 + F.lane;
#pragma unroll
                  for (int m4 = 0; m4 < 4; ++m4) kw[tk][m4] = kf[m4 * 64]; }
              __builtin_amdgcn_sched_barrier(0);
#pragma unroll
              for (int tk = 0; tk < 4; ++tk)
#pragma unroll
                  for (int m4 = 0; m4 < 4; ++m4) { const v4u w = kw[tk][m4]; const unsigned long long a0 = (unsigned long long)w.x | ((unsigned long long)w.y << 32), a1 = (unsigned long long)w.z | ((unsigned long long)w.w << 32);
                      pt[m4] = __builtin_amdgcn_mfma_f32_16x16x32_fp8_fp8((long)a0, (long)q8t[tk][0], pt[m4], 0, 0, 0); pt[m4] = __builtin_amdgcn_mfma_f32_16x16x32_fp8_fp8((long)a1, (long)q8t[tk][1], pt[m4], 0, 0, 0); }
              __builtin_amdgcn_sched_barrier(0);
#pragma unroll
              for (int tk = 0; tk < 4; ++tk) { const v4u* vf = VSF + (size_t)(bg * 128 + jt[tk]) * 256 + F.lane;
#pragma unroll
                  for (int i4 = 0; i4 < 4; ++i4) vw[tk][i4] = vf[i4 * 64]; }
              __builtin_amdgcn_sched_barrier(0);
              }
              float tm = -1e30f; const int key0 = 64 * jmine;
              if (__all((jmine < tb) && (post - bmax[jmine] >= 128))) {
#pragma unroll
                  for (int m4 = 0; m4 < 4; ++m4)
#pragma unroll
                      for (int r = 0; r < 4; ++r) { pt[m4][r] += cbfar; tm = fmaxf(tm, pt[m4][r]); }
              } else {
#pragma unroll
              for (int m4 = 0; m4 < 4; ++m4) { const int kb4 = key0 + 16 * m4 + 4 * lh; const i32x4 kp = *(const LAS i32x4*)(ptab + kb4); const int kpv[4] = {kp.x, kp.y, kp.z, kp.w};
#pragma unroll
                  for (int r = 0; r < 4; ++r) { const bool valid = (kb4 + r <= tq); pt[m4][r] = valid ? pt[m4][r] + lutb(lut, post - kpv[r], gh) : -1e30f; tm = fmaxf(tm, pt[m4][r]); } } }
              tm = red_lh_max(tm); const float mn = fmaxf(ms, tm); const float scl = __expf(ms - mn); float ad = 0.f;
#pragma unroll
              for (int m4 = 0; m4 < 4; ++m4)
#pragma unroll
                  for (int r = 0; r < 4; ++r) { const float pv = (pt[m4][r] > -1e29f) ? __expf(pt[m4][r] - mn) : 0.f; pt[m4][r] = pv; ad += pv; }
              ls = ls * scl + red_lh_sum(ad); ms = mn;
#pragma unroll
              for (int m = 0; m < 4; ++m) os[m] = os[m] * scl;
              const unsigned long long pba = nsa_pack_p8(pt[0], pt[1]), pbb = nsa_pack_p8(pt[2], pt[3]);
              __builtin_amdgcn_sched_barrier(0);
              if (same) {
#pragma unroll
                  for (int i4 = 0; i4 < 4; ++i4) { const v4u w = vw[0][i4]; const unsigned long long a0 = (unsigned long long)w.x | ((unsigned long long)w.y << 32), a1 = (unsigned long long)w.z | ((unsigned long long)w.w << 32);
                      const unsigned long long pb = (i4 >> 1) ? pbb : pba; const int mp = i4 & 1;
                      os[2 * mp] = __builtin_amdgcn_mfma_f32_16x16x32_fp8_fp8((long)a0, (long)pb, os[2 * mp], 0, 0, 0); os[2 * mp + 1] = __builtin_amdgcn_mfma_f32_16x16x32_fp8_fp8((long)a1, (long)pb, os[2 * mp + 1], 0, 0, 0); }
              } else {
#pragma unroll
              for (int tk = 0; tk < 4; ++tk) { const bool mine = (tokc == tk);
#pragma unroll
                  for (int i4 = 0; i4 < 4; ++i4) { const v4u w = vw[tk][i4]; const unsigned long long a0 = (unsigned long long)w.x | ((unsigned long long)w.y << 32), a1 = (unsigned long long)w.z | ((unsigned long long)w.w << 32);
                      const unsigned long long pb = mine ? ((i4 >> 1) ? pbb : pba) : 0ull; const int mp = i4 & 1;
                      os[2 * mp] = __builtin_amdgcn_mfma_f32_16x16x32_fp8_fp8((long)a0, (long)pb, os[2 * mp], 0, 0, 0); os[2 * mp + 1] = __builtin_amdgcn_mfma_f32_16x16x32_fp8_fp8((long)a1, (long)pb, os[2 * mp + 1], 0, 0, 0); } } } }
          const float isl = ls > 0.f ? gate_s / (ls * 256.f) : 0.f;
#pragma unroll
          for (int m = 0; m < 4; ++m) outv[m] = outv[m] + os[m] * isl; }
        NSA_T1(2);
        { f32x4 ow[4];
#pragma unroll
          for (int m = 0; m < 4; ++m) ow[m] = (f32x4){0.f, 0.f, 0.f, 0.f};
          float mw = -1e30f, lw = 0.f; const int k32a = (tq0 - 511) > 0 ? ((tq0 - 511) >> 5) : 0, k32b = (tq0 + 3) >> 5;
#pragma unroll 2
          for (int k32 = k32a; k32 <= k32b; ++k32) { const int key0 = 32 * k32, half = k32 & 1; const size_t ub = (size_t)(bg * 128 + (k32 >> 1)) * 256; f32x4 pt[2]; float tm = -1e30f;
              const bool wfar = __all((key0 + 31 <= tq) && (key0 >= tq - 511) && (post - bmax[key0 >> 6] >= 128));
#pragma unroll
              for (int h2 = 0; h2 < 2; ++h2) { const f32x4 s = nsa_qk8x(KWF + ub + (2 * half + h2) * 64, F.lane, q8, (f32x4){0.f, 0.f, 0.f, 0.f});
                  if (wfar) {
#pragma unroll
                      for (int r = 0; r < 4; ++r) { pt[h2][r] = s[r] + cbfar; tm = fmaxf(tm, pt[h2][r]); }
                  } else { const int kb4 = key0 + 16 * h2 + 4 * lh; const i32x4 kp = *(const LAS i32x4*)(ptab + kb4); const int kpv[4] = {kp.x, kp.y, kp.z, kp.w};
#pragma unroll
                  for (int r = 0; r < 4; ++r) { const int key = kb4 + r; const bool valid = (key <= tq) && (key >= tq - 511); pt[h2][r] = valid ? s[r] + lutb(lut, post - kpv[r], gh) : -1e30f; tm = fmaxf(tm, pt[h2][r]); } } }
              tm = red_lh_max(tm); const float mn = fmaxf(mw, tm); const float scl = __expf(mw - mn); float ad = 0.f;
#pragma unroll
              for (int h2 = 0; h2 < 2; ++h2)
#pragma unroll
                  for (int r = 0; r < 4; ++r) { const float pv = (pt[h2][r] > -1e29f) ? __expf(pt[h2][r] - mn) : 0.f; pt[h2][r] = pv; ad += pv; }
              lw = lw * scl + red_lh_sum(ad); mw = mn;
#pragma unroll
              for (int m = 0; m < 4; ++m) ow[m] = ow[m] * scl;
              nsa_pv8x(ow, VWF + ub + half * 128, F.lane, nsa_pack_p8(pt[0], pt[1])); }
          const float iwl = lw > 0.f ? gate_w / (lw * 256.f) : 0.f;
#pragma unroll
          for (int m = 0; m < 4; ++m) outv[m] = outv[m] + ow[m] * iwl; }
        NSA_T1(3);
#pragma unroll
        for (int m = 0; m < 4; ++m) { const unsigned long long pk = (unsigned long long)pk2(outv[m][0], outv[m][1]) | ((unsigned long long)pk2(outv[m][2], outv[m][3]) << 32);
            *(unsigned long long*)(Y2 + (bt + tq) * 512 + g * 256 + head * 64 + 16 * m + 4 * lh) = pk; }
        LDS_WAIT(); asm volatile("" ::: "memory");
    }
#if STAMPMASK
    if (blockIdx.x == gridDim.x - 1 && threadIdx.x == 0) { unsigned long long* ts = (unsigned long long*)(a.ws + WS_CTL + 512 * 1024); for (int k = 0; k < 4; ++k) ts[44 + k] = tsec[k]; }
#endif
#undef NSA_T0
#undef NSA_T1
}

__device__ __forceinline__ void dot64x4(const bf16* krow, const LAS float* qs, float (&lg)[4]) {
    float s0 = 0.f, s1 = 0.f, s2 = 0.f, s3 = 0.f;
#pragma nounroll
    for (int i = 0; i < 8; ++i) { const v4u kr = ((const v4u*)krow)[i];
        const float kf[8] = {bflo(kr.x), bfhi(kr.x), bflo(kr.y), bfhi(kr.y), bflo(kr.z), bfhi(kr.z), bflo(kr.w), bfhi(kr.w)};
        const LAS float* qp = qs + i * 8;
        { const f32x4 qa = *(const LAS f32x4*)(qp), qb = *(const LAS f32x4*)(qp + 4);
          s0 += kf[0] * qa.x + kf[1] * qa.y + kf[2] * qa.z + kf[3] * qa.w + kf[4] * qb.x + kf[5] * qb.y + kf[6] * qb.z + kf[7] * qb.w; }
        { const f32x4 qa = *(const LAS f32x4*)(qp + 64), qb = *(const LAS f32x4*)(qp + 68);
          s1 += kf[0] * qa.x + kf[1] * qa.y + kf[2] * qa.z + kf[3] * qa.w + kf[4] * qb.x + kf[5] * qb.y + kf[6] * qb.z + kf[7] * qb.w; }
        { const f32x4 qa = *(const LAS f32x4*)(qp + 128), qb = *(const LAS f32x4*)(qp + 132);
          s2 += kf[0] * qa.x + kf[1] * qa.y + kf[2] * qa.z + kf[3] * qa.w + kf[4] * qb.x + kf[5] * qb.y + kf[6] * qb.z + kf[7] * qb.w; }
        { const f32x4 qa = *(const LAS f32x4*)(qp + 192), qb = *(const LAS f32x4*)(qp + 196);
          s3 += kf[0] * qa.x + kf[1] * qa.y + kf[2] * qa.z + kf[3] * qa.w + kf[4] * qb.x + kf[5] * qb.y + kf[6] * qb.z + kf[7] * qb.w; } }
    lg[0] = s0; lg[1] = s1; lg[2] = s2; lg[3] = s3;
}
__device__ __forceinline__ void nsa_chunk(Frame& F, const bf16* krow, const bf16* vbase, size_t vstride_tok0, bool kvalid, int dist, const LAS float* qs, const LAS float* lut, int g,
                                          LAS float* pb, float (&mrun)[4], float (&lrun)[4], float (&oacc)[4], const bf16* vrow0, int nkeys) {
    (void)vbase; (void)vstride_tok0;
    float lg[4];
    if (kvalid) { dot64x4(krow, qs, lg);
        const int dd = dist < 0 ? 0 : (dist > 128 ? 128 : dist); const f32x4 bs = *(const LAS f32x4*)(lut + dd * 8 + g * 4);
        lg[0] += bs.x; lg[1] += bs.y; lg[2] += bs.z; lg[3] += bs.w;
    } else { lg[0] = lg[1] = lg[2] = lg[3] = -1e30f; }
    float p[4];
#pragma unroll
    for (int h = 0; h < 4; ++h) { const float bm = wave_max(lg[h]); const float mn = fmaxf(mrun[h], bm); p[h] = kvalid ? __expf(lg[h] - mn) : 0.f;
        const float sc = __expf(mrun[h] - mn); lrun[h] = lrun[h] * sc + wave_sum(p[h]); oacc[h] *= sc; mrun[h] = mn; }
    *(LAS f32x4*)(pb + F.lane * 4) = (f32x4){p[0], p[1], p[2], p[3]};
    LDS_WAIT(); asm volatile("" ::: "memory");
#pragma unroll 2
    for (int kk = 0; kk < nkeys; ++kk) { const f32x4 pp = *(const LAS f32x4*)(pb + kk * 4); const float vv = bf2f(vrow0[(size_t)kk * PMW + F.lane]);
        oacc[0] += pp.x * vv; oacc[1] += pp.y * vv; oacc[2] += pp.z * vv; oacc[3] += pp.w * vv; }
    LDS_WAIT(); asm volatile("" ::: "memory");
}
__device__ __forceinline__ void mix_nsa_naive(Frame& F_, const LayerP& L, const bf16* P, const Args& a, bf16* Y2, const LAS float* lut, int first, int stride) {
    LAS float* wl = (LAS float*)(F_.lds + 8192 + F_.wave * 12288);
    LAS float* qs = wl;
    LAS float* pc = wl + 256;
    LAS float* pb = wl + 256 + 2048;
    LAS int* sel = (LAS int*)(wl + 256 + 2048 + 256);
    const float* KCC = (const float*)(a.ws + WS_KCC);
    for (int unit = first; unit < T * 2; unit += stride) {
        Frame F = F_; asm volatile("" : "+v"(F.lane));
        const int g = unit & 1, t = unit >> 1, b = t >> 13, tq = t & (SEQ - 1);
        const int post = L.pos[tq];
        { const bf16* qp = P + (size_t)t * PMW + C_NQ + g * 256; const unsigned long long r = *(const unsigned long long*)(qp + F.lane * 4); const unsigned lo = (unsigned)r, hi = (unsigned)(r >> 32);
          *(LAS f32x4*)(qs + F.lane * 4) = (f32x4){bflo(lo) * 0.125f, bfhi(lo) * 0.125f, bflo(hi) * 0.125f, bfhi(hi) * 0.125f}; }
        LDS_WAIT(); asm volatile("" ::: "memory");
        const int ncv = tq >= 31 ? ((tq - 31) >> 4) + 1 : 0;
        float oc[4] = {0.f, 0.f, 0.f, 0.f};
        float icn[4] = {0.f, 0.f, 0.f, 0.f};
        {
            float mloc[4] = {-1e30f, -1e30f, -1e30f, -1e30f};
#pragma nounroll
            for (int cc = 0; cc < 8; ++cc) { const int c = cc * 64 + F.lane; const bool valid = c < ncv; f32x4 lgv = (f32x4){-1e30f, -1e30f, -1e30f, -1e30f};
                if (valid) { const float* kr = KCC + ((size_t)((0 * 2 + b) * 512 + c) * 2 + g) * 64; const int dist = post - L.pos[16 * c + 31];
                    const int dd = dist < 0 ? 0 : (dist > 128 ? 128 : dist); const f32x4 bs = *(const LAS f32x4*)(lut + dd * 8 + g * 4);
                    float s0 = 0.f, s1 = 0.f, s2 = 0.f, s3 = 0.f;
#pragma unroll 2
                    for (int d4 = 0; d4 < 16; ++d4) { const f32x4 kv = *(const f32x4*)(kr + d4 * 4);
                        const f32x4 q0 = *(const LAS f32x4*)(qs + d4 * 4), q1 = *(const LAS f32x4*)(qs + 64 + d4 * 4), q2 = *(const LAS f32x4*)(qs + 128 + d4 * 4), q3 = *(const LAS f32x4*)(qs + 192 + d4 * 4);
                        s0 += kv.x * q0.x + kv.y * q0.y + kv.z * q0.z + kv.w * q0.w; s1 += kv.x * q1.x + kv.y * q1.y + kv.z * q1.z + kv.w * q1.w;
                        s2 += kv.x * q2.x + kv.y * q2.y + kv.z * q2.z + kv.w * q2.w; s3 += kv.x * q3.x + kv.y * q3.y + kv.z * q3.z + kv.w * q3.w; }
                    lgv = (f32x4){s0 + bs.x, s1 + bs.y, s2 + bs.z, s3 + bs.w}; }
                mloc[0] = fmaxf(mloc[0], lgv.x); mloc[1] = fmaxf(mloc[1], lgv.y); mloc[2] = fmaxf(mloc[2], lgv.z); mloc[3] = fmaxf(mloc[3], lgv.w);
                *(LAS f32x4*)(pc + c * 4) = lgv; }
            LDS_WAIT(); asm volatile("" ::: "memory");
            float mx[4], sl[4] = {0.f, 0.f, 0.f, 0.f};
#pragma unroll
            for (int h = 0; h < 4; ++h) mx[h] = wave_max(mloc[h]);
#pragma nounroll
            for (int cc = 0; cc < 8; ++cc) { const int c = cc * 64 + F.lane; const bool valid = c < ncv; const f32x4 lgv = *(const LAS f32x4*)(pc + c * 4);
                f32x4 pv; pv.x = valid ? __expf(lgv.x - mx[0]) : 0.f; pv.y = valid ? __expf(lgv.y - mx[1]) : 0.f; pv.z = valid ? __expf(lgv.z - mx[2]) : 0.f; pv.w = valid ? __expf(lgv.w - mx[3]) : 0.f;
                sl[0] += pv.x; sl[1] += pv.y; sl[2] += pv.z; sl[3] += pv.w; *(LAS f32x4*)(pc + c * 4) = pv; }
            LDS_WAIT(); asm volatile("" ::: "memory");
#pragma unroll
            for (int h = 0; h < 4; ++h) { const float sm = wave_sum(sl[h]); icn[h] = ncv > 0 ? 1.f / sm : 0.f; }
            const float* vcb = KCC + ((size_t)((1 * 2 + b) * 512) * 2 + g) * 64;
#pragma nounroll
            for (int c = 0; c < ncv; ++c) { const f32x4 pp = *(const LAS f32x4*)(pc + c * 4); const float vv = vcb[(size_t)c * 128 + F.lane];
                oc[0] += pp.x * vv; oc[1] += pp.y * vv; oc[2] += pp.z * vv; oc[3] += pp.w * vv; }
#pragma unroll
            for (int h = 0; h < 4; ++h) oc[h] *= icn[h];
        }
        const int tb = tq >> 6;
        float sc0, sc1;
        { float im[2];
#pragma unroll
          for (int q = 0; q < 2; ++q) { const int j = F.lane + 64 * q; float s = 0.f;
#pragma unroll
              for (int dc = -1; dc <= 3; ++dc) { const int c = 4 * j + dc; if (c >= 0 && c < NCMP) { const f32x4 pp = *(const LAS f32x4*)(pc + c * 4); s += (pp.x * icn[0] + pp.y * icn[1]) + (pp.z * icn[2] + pp.w * icn[3]); } }
              const bool forced = (j == 0) || (j == tb) || (j == tb - 1); const bool elig = j <= tb;
              im[q] = forced ? 1e9f : (elig ? s : -1e9f); }
          sc0 = im[0]; sc1 = im[1]; }
        int nsel = 0;
        for (int it = 0; it < 16; ++it) {
            float bv = sc0; int bi = F.lane; if (sc1 > sc0) { bv = sc1; bi = F.lane + 64; }
#pragma unroll
            for (int o = 1; o < 64; o <<= 1) { const float ov = __shfl_xor(bv, o); const int oi = __shfl_xor(bi, o); if (ov > bv || (ov == bv && oi < bi)) { bv = ov; bi = oi; } }
            if (bv <= -1e9f) break;
            if (F.lane == 0) sel[it] = bi;
            if (bi == F.lane) sc0 = -3.0e38f; if (bi == F.lane + 64) sc1 = -3.0e38f;
            nsel = it + 1;
        }
        LDS_WAIT(); asm volatile("" ::: "memory");
        float ms[4] = {-1e30f, -1e30f, -1e30f, -1e30f}, ls[4] = {0.f, 0.f, 0.f, 0.f}, os[4] = {0.f, 0.f, 0.f, 0.f};
#pragma nounroll
        for (int it = 0; it < nsel; ++it) { const int j = sel[it]; const int tok = j * 64 + F.lane; const bool valid = tok <= tq;
            const size_t gt = (size_t)b * SEQ + tok; const int nk = (tq - j * 64 + 1) < 64 ? (tq - j * 64 + 1) : 64;
            nsa_chunk(F, P + gt * PMW + C_KS + g * 64, nullptr, 0, valid, post - L.pos[tok], qs, lut, g, pb, ms, ls, os, P + ((size_t)b * SEQ + j * 64) * PMW + C_VS + g * 64, nk); }
        float mw[4] = {-1e30f, -1e30f, -1e30f, -1e30f}, lw[4] = {0.f, 0.f, 0.f, 0.f}, ow[4] = {0.f, 0.f, 0.f, 0.f};
#pragma nounroll
        for (int cc = 0; cc < 8; ++cc) { const int tok0 = tq - 511 + cc * 64; if (tok0 + 63 < 0) continue;
            const int tok = tok0 + F.lane; const bool valid = tok >= 0; const int tokc = valid ? tok : 0; const size_t gt = (size_t)b * SEQ + tokc;
            const int skip = tok0 < 0 ? -tok0 : 0;
            const int ltok = (tok0 < 0 ? 0 : tok0) + F.lane; const bool lvalid = (F.lane < 64 - skip);
            const size_t lgt = (size_t)b * SEQ + (lvalid ? ltok : 0);
            (void)gt; (void)tokc; (void)valid;
            nsa_chunk(F, P + lgt * PMW + C_KW + g * 64, nullptr, 0, lvalid, post - L.pos[lvalid ? ltok : 0], qs, lut, g, pb, mw, lw, ow, P + ((size_t)b * SEQ + (tok0 < 0 ? 0 : tok0)) * PMW + C_VW + g * 64, 64 - skip); }
        { const bf16* ngp = P + (size_t)t * PMW + C_NG + g * 12;
#pragma unroll
          for (int h = 0; h < 4; ++h) { const float gc = sigm(bf2f(ngp[h * 3])), gs = sigm(bf2f(ngp[h * 3 + 1])), gw_ = sigm(bf2f(ngp[h * 3 + 2]));
              const float y = gc * oc[h] + gs * (os[h] / ls[h]) + gw_ * (ow[h] / lw[h]);
              Y2[(size_t)t * 512 + g * 256 + h * 64 + F.lane] = (bf16)f2bf(y); } }
        LDS_WAIT(); asm volatile("" ::: "memory");
    }
}

__device__ __forceinline__ void make_layer(LayerP& L, const Args& args, int layer) { asm volatile("" : "+s"(layer));
        L.a_re = (const float*)inptr(args, 6) + layer * 2048; L.a_im = (const float*)inptr(args, 7) + layer * 2048; L.log_dt = (const float*)inptr(args, 8) + layer * 32;
        L.b_re = (const float*)inptr(args, 9) + layer * 32768; L.b_im = (const float*)inptr(args, 10) + layer * 32768; L.c_re = (const float*)inptr(args, 11) + layer * 32768; L.c_im = (const float*)inptr(args, 12) + layer * 32768;
        L.ssm_d = (const float*)inptr(args, 13) + layer * 512; L.conv_w = (const float*)inptr(args, 15) + layer * 4 * 1536; L.a_log = (const float*)inptr(args, 16) + layer * 4; L.dt_bias = (const float*)inptr(args, 17) + layer * 4;
        L.gdn_norm = (const float*)inptr(args, 18) + layer * 128;
        L.kpe = (const float*)inptr(args, 19) + layer * 2048; L.kw1 = (const float*)inptr(args, 20) + (size_t)layer * 2048 * 128; L.kw2 = (const float*)inptr(args, 21) + layer * 8192;
        L.vpe = (const float*)inptr(args, 22) + layer * 2048; L.vw1 = (const float*)inptr(args, 23) + (size_t)layer * 2048 * 128; L.vw2 = (const float*)inptr(args, 24) + layer * 8192;
        L.rel_bias = (const float*)inptr(args, 25); L.ln_g = (const float*)inptr(args, 26) + layer * 512; L.ln_b = (const float*)inptr(args, 27) + layer * 512;
        L.sgu_w = (const float*)inptr(args, 28) + (size_t)layer * 4 * 128 * 128; L.sgu_b = (const float*)inptr(args, 29) + layer * 512; L.pos = (const int*)inptr(args, 1);

}
__device__ __forceinline__ Frame make_frame(unsigned char* lds_generic, unsigned char* ws) {
    Frame F;
    F.lds = (LAS unsigned char*)lds_generic;
    F.MISC = (volatile LAS unsigned*)(F.lds + MISC_OFF);
    int t = threadIdx.x; asm volatile("" : "+v"(t));
    F.tid = t; F.lane = F.tid & 63; F.wave = __builtin_amdgcn_readfirstlane(F.tid >> 6);
    F.G = gridDim.x; { const int bx = blockIdx.x; F.vcu = (F.G % 8 == 0) ? (bx % 8) * (F.G / 8) + bx / 8 : bx; }
    F.gw = F.vcu * NWAVES + F.wave; F.NGW = F.G * NWAVES;
    F.ctl = (gu32*)(ws + WS_CTL);
    return F;
}
#define ws (args.ws)
#define F0 make_frame(lds, ws)
#define relaunder(x) (x)
#define IN(k) in_rng(lo, hi, (k))
#if STAMPMASK
#define STAMP_AT(k) do { if (blockIdx.x == 0 && threadIdx.x == 0) ((unsigned long long*)(ws + WS_CTL + 512 * 1024))[(k) + 1] = __builtin_amdgcn_s_memrealtime(); } while (0)
#else
#define STAMP_AT(k) do { } while (0)
#endif
#define GRID_BAR(k) do { if (IN(k) && IN((k) + 1)) { Frame Fb = F0; XcdBarrier bar; bar.bar = (unsigned*)(Fb.ctl + CW_BAR); bar.x = xb_xcc_id(); bar.st = Fb.MISC + 8; xcd_barrier(bar); } STAMP_AT(k); } while (0)

#define IS_SCAN_BLOCK(Fr) (((Fr).G == 256) ? (((Fr).vcu & 15) == 0) : ((Fr).vcu < 16))
#define PA ((bf16*)(ws + WS_A))
#define YB ((bf16*)(ws + WS_B))
#define MGB ((bf16*)(ws + WS_D))
#define YPRE ((bf16*)(ws + WS_D))
#define HB ((bf16*)(ws + WS_C))
#define XW (args.out)

template <int layer>
__device__ __forceinline__ void layer_body(const Args& args, const int lo, const int hi, unsigned char* lds) {
        const int pb = 1 + layer * 10;
#define wl (ws + WS_WL + (size_t)layer * W_LAYER)
        if (IN(pb + 0)) { Frame F = relaunder(F0); p_norm<false, false>(F, layer == 0 ? (const float*)inptr(args, 0) : XW, (const float*)inptr(args, 2) + layer * DM, HB, nullptr, nullptr, args); }
        GRID_BAR(pb + 0);
        if (IN(pb + 1)) { Frame F = relaunder(F0); pg8::Gemm g{HB, (const bf16*)(wl + W_IN1), T, PMW, DM}; pg8::StaticOrder S; S.init(T, PMW, F.G, (int)blockIdx.x);
            pg8::EpiStore E{PA, PMW, 1 << 20, 0}; pg8::gemm_phase<pg8::EpiStore, pg8::StaticOrder, true, true>(F.lds, g, S, E); }
        GRID_BAR(pb + 1);
        if (IN(pb + 2)) {
            { Frame F = relaunder(F0); LayerP L; make_layer(L, args, layer); mix_sgu(F, L, PA, YB + (size_t)3 * T * 512); }
#if STAMPMASK
            __syncthreads(); if (layer == 0 && blockIdx.x == gridDim.x - 1 && threadIdx.x == 0) ((unsigned long long*)(ws + WS_CTL + 512 * 1024))[48] = __builtin_amdgcn_s_memrealtime();
#endif
            { Frame F = relaunder(F0); LayerP L; make_layer(L, args, layer); gdn_chunk_prep(F, L, PA, args); }
#if !NSA_NAIVE
            { Frame F = relaunder(F0); nsa_compress_mfma(F, PA, args, layer); }
#endif
#if STAMPMASK
            __syncthreads(); if (layer == 0 && blockIdx.x == gridDim.x - 1 && threadIdx.x == 0) ((unsigned long long*)(ws + WS_CTL + 512 * 1024))[49] = __builtin_amdgcn_s_memrealtime();
#endif
            { Frame F = relaunder(F0);
              __syncthreads();
              { LayerP L; make_layer(L, args, layer); ssm_pass1(F, L, PA, args, F.lds + F.wave * 16384, F.gw, F.NGW); }
              __syncthreads();
#if STAMPMASK
              __syncthreads(); if (layer == 0 && blockIdx.x == gridDim.x - 1 && threadIdx.x == 0) ((unsigned long long*)(ws + WS_CTL + 512 * 1024))[50] = __builtin_amdgcn_s_memrealtime();
#endif
#if NSA_NAIVE
              { LayerP L; make_layer(L, args, layer); mix_nsa_compress(F, L, PA, args, (LAS float*)(F.lds + 73728 + F.wave * 4096), F.gw, F.NGW); }
#endif
#if STAMPMASK
              __syncthreads(); if (layer == 0 && blockIdx.x == gridDim.x - 1 && threadIdx.x == 0) ((unsigned long long*)(ws + WS_CTL + 512 * 1024))[51] = __builtin_amdgcn_s_memrealtime();
#endif
              nsa_tiles(F, PA, args, (LAS bf16*)(F.lds + F.wave * 9216), F.gw, F.NGW); }
        }
        GRID_BAR(pb + 2);
        if (IN(pb + 3)) {
            if (IS_SCAN_BLOCK(F0)) { Frame F = relaunder(F0); LayerP L; make_layer(L, args, layer); const int si = (F.G == 256) ? (F.vcu >> 4) : F.vcu; gdn_scan(F, L, PA, args, YB + (size_t)1 * T * 512, si >> 3, (si >> 1) & 3, si & 1); }
            __syncthreads();
#if STAMPMASK
            if (layer == 0 && blockIdx.x == 0 && threadIdx.x == 0) ((unsigned long long*)(ws + WS_CTL + 512 * 1024))[40] = __builtin_amdgcn_s_memrealtime();
#endif
            if (F0.G != 256) { Frame F = relaunder(F0); LayerP L; make_layer(L, args, layer); ssm_pass2(F, L, PA, args, YPRE, F.lds + F.wave * 16384, F.gw, F.NGW); }
            else if (!IS_SCAN_BLOCK(F0)) { Frame F = relaunder(F0); LayerP L; make_layer(L, args, layer);
              ssm_pass2(F, L, PA, args, YPRE, F.lds + F.wave * 16384, F.gw, 1 << 28);
              if ((F.vcu & 15) == 1) ssm_pass2(F, L, PA, args, YPRE, F.lds + F.wave * 16384, F.gw - NWAVES, 1 << 28); }
            __syncthreads();
#if STAMPMASK
            if (layer == 0 && blockIdx.x == gridDim.x - 1 && threadIdx.x == 0) ((unsigned long long*)(ws + WS_CTL + 512 * 1024))[41] = __builtin_amdgcn_s_memrealtime();
#endif
            if (!IS_SCAN_BLOCK(F0) || F0.G == 256) { Frame F = relaunder(F0); LayerP L; make_layer(L, args, layer);
                LAS float* lut = (LAS float*)(F.lds);
                for (int i = F.tid; i < 129 * 8; i += NTHR) { const int d = i >> 3, hh = i & 7; int bk;
                    if (d < 16) bk = d; else { const float nf = (float)d; int lg2 = 16 + (int)(logf(nf / 16.0f) / 2.0794415416798357f * 16.0f); bk = lg2 > 31 ? 31 : lg2; }
                    if (d >= 128) bk = 31;
                    lut[i] = L.rel_bias[bk * 8 + hh]; }
                LAS int* cpos = (LAS int*)(F.lds + 4352);
                for (int i = F.tid; i < 512; i += NTHR) cpos[i] = L.pos[16 * (i < NCMP ? i : NCMP - 1) + 31];
                LAS int* ptab = (LAS int*)(F.lds + 40960);
                for (int i = F.tid; i < SEQ; i += NTHR) ptab[i] = L.pos[i];
                LAS int* bmax = (LAS int*)(F.lds + 6400);
                __syncthreads();
                if (F.tid < 128) { int mx = ptab[64 * F.tid]; for (int k = 1; k < 64; ++k) mx = max(mx, ptab[64 * F.tid + k]); bmax[F.tid] = mx; }
                LAS int* cmax = (LAS int*)(F.lds + 6912);
                if (F.tid >= 128 && F.tid < 160) { const int n = F.tid - 128; int mx = cpos[16 * n]; for (int k = 1; k < 16; ++k) mx = max(mx, cpos[16 * n + k]); cmax[n] = mx; }
                __syncthreads();
#if NSA_NAIVE
                mix_nsa_naive(F, L, PA, args, YB + (size_t)2 * T * 512, lut, (F.vcu - 16) * 8 + F.wave, (F.G - 16) * 8);
#else
                if (F.G == 256) {
                    const int x = F.vcu >> 5;
                    LAS v4u* kcl = (LAS v4u*)(F.lds + 73728);
                    { const v4u* src = (const v4u*)(ws + WS_NKCF) + (size_t)(x & 3) * 4096; for (int i = F.tid; i < 4096; i += NTHR) kcl[i] = src[i]; }
                    __syncthreads();
                    mix_nsa_mfma(F, L, PA, args, YB + (size_t)2 * T * 512, lut, cpos, ptab, bmax, cmax, (LAS float*)(F.lds + 8192 + F.wave * 4096), 0, 0, SEQ / 8, (x & 3) >> 1, x & 1, (x >> 2) * (SEQ / 8), (unsigned*)(F.ctl + CW_NSAQ + 64 * (layer * 8 + x)), (unsigned*)(F.ctl + CW_NSAQ + 64 * (layer * 8 + (x ^ 4))), ((x ^ 4) >> 2) * (SEQ / 8), kcl);
                } else mix_nsa_mfma(F, L, PA, args, YB + (size_t)2 * T * 512, lut, cpos, ptab, bmax, cmax, (LAS float*)(F.lds + 8192 + F.wave * 4096), (F.vcu - 16) * 8 + F.wave, (F.G - 16) * 8, BATCH * 2 * (SEQ / 4), -1, 0, 0, nullptr);
#endif
            }
        }
#if STAMPMASK
        if (IN(pb + 3)) { __syncthreads(); if (layer == 0 && blockIdx.x == gridDim.x - 1 && threadIdx.x == 0) ((unsigned long long*)(ws + WS_CTL + 512 * 1024))[42] = __builtin_amdgcn_s_memrealtime(); }
#endif
        GRID_BAR(pb + 3);
        if (IN(pb + 4)) {
            { Frame F = relaunder(F0); gdn_norm_pass(F, args, YB + (size_t)1 * T * 512); }
            { Frame F = relaunder(F0); pg8::Gemm g{YPRE, (const bf16*)(wl + W_GLU), T, 512, 512}; pg8::StaticOrder S; S.init(T, 512, F.G, (int)blockIdx.x);
              pg8::EpiGLU E{YPRE, YB}; pg8::gemm_phase<pg8::EpiGLU, pg8::StaticOrder, true, true>(F.lds, g, S, E); }
            __syncthreads();
        }
        if (IN(pb + 4)) { Frame F = relaunder(F0); pg8::Gemm g{HB, (const bf16*)(wl + W_IN2), T, NGATE, DM}; pg8::StaticOrder S; S.init(T, NGATE, F.G, (int)blockIdx.x);
            pg8::EpiGateRatio E{PA}; pg8::gemm_phase<pg8::EpiGateRatio, pg8::StaticOrder, true, true>(F.lds, g, S, E); }
        GRID_BAR(pb + 4);
        if (IN(pb + 5)) { Frame F = relaunder(F0); pg8::Gemm g{YB, (const bf16*)(wl + W_BR), 4 * T, 4096, 512}; pg8::MergeOrder S; S.init(F.G, (int)blockIdx.x);
            pg8::EpiMergeAcc E{PA, MGB}; pg8::gemm_phase<pg8::EpiMergeAcc, pg8::MergeOrder, true, true>(F.lds, g, S, E); }
        GRID_BAR(pb + 5);
        if (IN(pb + 6)) { Frame F = relaunder(F0); pg8::Gemm g{MGB, (const bf16*)(wl + W_OUT), T, DM, DM}; pg8::StaticOrder S; S.init(T, DM, F.G, (int)blockIdx.x);
            pg8::EpiResid E{layer == 0 ? (const float*)inptr(args, 0) : XW, XW, DM}; pg8::gemm_phase<pg8::EpiResid, pg8::StaticOrder, true, true>(F.lds, g, S, E); }
        GRID_BAR(pb + 6);
        if (IN(pb + 7)) { Frame F = relaunder(F0);
            if (layer == 0) p_norm<false, false>(F, XW, (const float*)inptr(args, 3), HB, nullptr, nullptr, args);
            else { p_norm<true, false>(F, XW, (const float*)inptr(args, 3) + DM, HB, nullptr, (const float*)inptr(args, 38), args); p_conv_moe_down(F, args); }
        }
        GRID_BAR(pb + 7);
        if constexpr (layer == 0) {
            if (IN(9) && !(ABL & 16)) { Frame F = relaunder(F0); pg8::Gemm g{HB, (const bf16*)(ws + WS_FUP), T, 2 * FFD, DM}; pg8::StaticOrder S; S.init(T, 2 * FFD, F.G, (int)blockIdx.x);
                pg8::EpiSwiGLU E{PA, FFD, 1 << 20}; pg8::gemm_phase<pg8::EpiSwiGLU, pg8::StaticOrder, true, true>(F.lds, g, S, E); }
            GRID_BAR(9);
            if (IN(10) && !(ABL & 16)) { Frame F = relaunder(F0); pg8::Gemm g{PA, (const bf16*)(ws + WS_FDN), T, DM, FFD}; pg8::StaticOrder S; S.init(T, DM, F.G, (int)blockIdx.x);
                pg8::EpiResid E{XW, XW, DM}; pg8::gemm_phase<pg8::EpiResid, pg8::StaticOrder, true, true>(F.lds, g, S, E); }
            GRID_BAR(10);
        } else {
            {
                constexpr int pass = 0; constexpr int q0 = 19;
                MoeTiles mt;
                if (IN(q0) || IN(q0 + 1) || IN(q0 + 2) || IN(q0 + 3)) { Frame Fm = F0; moe_tiles(Fm, mt); }
                const int tile0 = pass * PASS_TILES; int ntp = mt.tb[8] - tile0; ntp = ntp < 0 ? 0 : (ntp > pass_cap(pass) ? pass_cap(pass) : ntp);
                if (IN(q0 + 1)) { Frame F = relaunder(F0); pg8::Gemm g{(const bf16*)ws, (const bf16*)(ws + WS_MUP), PASS_CAP1 * 256, NEXP * 2 * FFE, DM};
                    pg8::MoeOrder S{ntp, tile0, 28, F.G, (int)blockIdx.x, mt.tb[1], mt.tb[2], mt.tb[3], mt.tb[4], mt.tb[5], mt.tb[6], mt.tb[7],
                                    (const int*)(ws + WS_ROWTOK), mt.cnt[0], mt.cnt[1], mt.cnt[2], mt.cnt[3], mt.cnt[4], mt.cnt[5], mt.cnt[6], mt.cnt[7], (unsigned)WS_C, (unsigned)WS_ZROW};
                    pg8::EpiSwiGLU E{PA, FFE, 28}; pg8::gemm_phase<pg8::EpiSwiGLU, pg8::MoeOrder, true, true, true>(F.lds, g, S, E); }
                GRID_BAR(q0 + 1);
                if (IN(q0 + 2)) { Frame F = relaunder(F0); pg8::Gemm g{PA, (const bf16*)(ws + WS_MDN), PASS_CAP1 * 256, NEXP * DM, FFE};
                    pg8::MoeOrder S{ntp, tile0, 4, F.G, (int)blockIdx.x, mt.tb[1], mt.tb[2], mt.tb[3], mt.tb[4], mt.tb[5], mt.tb[6], mt.tb[7]};
                    pg8::EpiStore E{(bf16*)(ws + WS_YM), DM, 4, 0}; pg8::gemm_phase<pg8::EpiStore, pg8::MoeOrder, true, true>(F.lds, g, S, E); }
                GRID_BAR(q0 + 2);
                if (IN(q0 + 3) && !(ABL & 32)) { Frame F = relaunder(F0); p_moe_combine<false>(F, args, mt, pass); }
            }
            {
                constexpr int pass = 1; constexpr int q0 = 23;
                MoeTiles mt;
                if (IN(q0) || IN(q0 + 1) || IN(q0 + 2) || IN(q0 + 3)) { Frame Fm = F0; moe_tiles(Fm, mt); }
                const int tile0 = pass * PASS_TILES; int ntp = mt.tb[8] - tile0; ntp = ntp < 0 ? 0 : (ntp > pass_cap(pass) ? pass_cap(pass) : ntp);
                if (IN(q0 + 1)) { Frame F = relaunder(F0); pg8::Gemm g{(const bf16*)ws, (const bf16*)(ws + WS_MUP), PASS_CAP1 * 256, NEXP * 2 * FFE, DM};
                    pg8::MoeOrder S{ntp, tile0, 28, F.G, (int)blockIdx.x, mt.tb[1], mt.tb[2], mt.tb[3], mt.tb[4], mt.tb[5], mt.tb[6], mt.tb[7],
                                    (const int*)(ws + WS_ROWTOK), mt.cnt[0], mt.cnt[1], mt.cnt[2], mt.cnt[3], mt.cnt[4], mt.cnt[5], mt.cnt[6], mt.cnt[7], (unsigned)WS_C, (unsigned)WS_ZROW};
                    pg8::EpiSwiGLU E{PA, FFE, 28}; pg8::gemm_phase<pg8::EpiSwiGLU, pg8::MoeOrder, true, true, true>(F.lds, g, S, E); }
                GRID_BAR(q0 + 1);
                if (IN(q0 + 2)) { Frame F = relaunder(F0); pg8::Gemm g{PA, (const bf16*)(ws + WS_MDN), PASS_CAP1 * 256, NEXP * DM, FFE};
                    const int ntA = ntp < PASS_TILES ? ntp : PASS_TILES;
                    pg8::MoeOrder S{ntA, tile0, 4, F.G, (int)blockIdx.x, mt.tb[1], mt.tb[2], mt.tb[3], mt.tb[4], mt.tb[5], mt.tb[6], mt.tb[7]};
                    pg8::EpiStore E{(bf16*)(ws + WS_YM), DM, 4, 0}; pg8::gemm_phase<pg8::EpiStore, pg8::MoeOrder, true, true>(F.lds, g, S, E); }
                if (IN(q0 + 2)) { __syncthreads(); Frame F = relaunder(F0); pg8::Gemm g{PA, (const bf16*)(ws + WS_MDN), PASS_CAP1 * 256, NEXP * DM, FFE / MOE_KSPLIT, FFE};
                    pg8::MoeSplitOrder S{ntp > PASS_TILES ? ntp - PASS_TILES : 0, tile0, F.G, (int)blockIdx.x, mt.tb[1], mt.tb[2], mt.tb[3], mt.tb[4], mt.tb[5], mt.tb[6], mt.tb[7]};
                    pg8::EpiPartF32 E{(float*)(ws + WS_YMX)}; pg8::gemm_phase<pg8::EpiPartF32, pg8::MoeSplitOrder, true, true>(F.lds, g, S, E); }
                GRID_BAR(q0 + 2);
                if (IN(q0 + 3) && !(ABL & 32)) { Frame F = relaunder(F0); p_moe_combine<true>(F, args, mt, pass); }
            }
        }
    }
__global__ void __launch_bounds__(NTHR, 2) fwd(Args args) {
    extern __shared__ __attribute__((aligned(16))) unsigned char lds[];
    { Frame Fz = F0;
      for (int u = Fz.tid; u < (LDS_BYTES - LDSCTL_OFF) / 4; u += NTHR) ((LAS unsigned*)(Fz.lds + LDSCTL_OFF))[u] = 0u; }
    __syncthreads();
    const int lo = args.ph_lo, hi = args.ph_hi;
    STAMP_AT(-1);
    if (hi - lo > 1) { Frame Fz = F0; (void)xcd_barrier_post((unsigned*)(Fz.ctl + CW_BAR), Fz.MISC + 8); }
    if (IN(0)) { Frame F = relaunder(F0); p_prologue(F, args); }
    GRID_BAR(0);

    layer_body<0>(args, lo, hi, lds);
    layer_body<1>(args, lo, hi, lds);
#if STAMPMASK
    __syncthreads();
    if (blockIdx.x == 0) { STAMP_AT(27); __syncthreads();
        const unsigned long long* ts = (const unsigned long long*)(ws + WS_CTL + 512 * 1024); unsigned long long tot = 0;
        for (int k = 0; k < 28; ++k) if ((STAMPMASK >> k) & 1) tot += ts[k + 1] - ts[k];
        if (STAMPSEL >= 9) tot = ts[39 + STAMPSEL] - ts[3]; else if (STAMPSEL >= 5) tot = ts[39 + STAMPSEL]; else if (STAMPSEL) tot = ts[39 + STAMPSEL] - ts[4];
        const float vraw = (float)tot * 1e-3f;
        const float v = exp2f(rintf(log2f(vraw > 1e-3f ? vraw : 1e-3f) * 2.0f) * 0.5f);
        for (size_t i = threadIdx.x; i < (size_t)T * DM; i += NTHR) XW[i] = v; }
#endif
#undef IN
#undef GRID_BAR
#undef ws
#undef F0
#undef relaunder
#undef PA
#undef YB
#undef MGB
#undef YPRE
#undef HB
#undef XW
#undef wl
}


#if SELFCHK
constexpr int CW_CHK = 32768;
__device__ __forceinline__ unsigned hsh(unsigned x) { x ^= x >> 16; x *= 0x7feb352du; x ^= x >> 15; x *= 0x846ca68bu; x ^= x >> 16; return x; }
__device__ __forceinline__ float rbf(float f) { return __uint_as_float(f2bf(f) << 16); }
__device__ __forceinline__ bool bad(float got, float ref, float rel, float ab) { const float d = fabsf(got - ref); return !(d <= rel * fabsf(ref) + ab); }
__global__ void __launch_bounds__(256) chk(Args a, int which, int layer) {
    const unsigned sid = blockIdx.x * 256 + threadIdx.x; unsigned char* ws = a.ws;
    const unsigned h1 = hsh(sid * 2654435761u + 12345u * (unsigned)which), h2 = hsh(h1 + 0x9e3779b9u);
    const int r = (int)(h1 % (unsigned)T);
    const bf16* H = (const bf16*)(ws + WS_C); const bf16* PAp = (const bf16*)(ws + WS_A); const bf16* Y = (const bf16*)(ws + WS_B); const bf16* MG = (const bf16*)(ws + WS_D);
    const float* w_in = (const float*)a.in[5] + (size_t)layer * DM * IN_COLS;
    unsigned* cnt = (unsigned*)(ws + WS_CTL) + CW_CHK + 64 * which;
    bool fail = false;
    if (which == 1) { const int c = (int)(h2 % (unsigned)NMIX); float s = 0.f; for (int k = 0; k < DM; ++k) s += bf2f(H[(size_t)r * DM + k]) * rbf(w_in[(size_t)k * IN_COLS + c]);
        fail = bad(bf2f(PAp[(size_t)r * PMW + c]), s, 0.02f, 0.02f); }
    else if (which == 2) { const int c = (int)(h2 % (unsigned)NGATE); float s = 0.f; for (int k = 0; k < DM; ++k) s += bf2f(H[(size_t)r * DM + k]) * rbf(w_in[(size_t)k * IN_COLS + NMIX + c]);
        fail = bad(bf2f(PAp[(size_t)r * NGATE + c]), 1.f / (1.f + expf(-s)), 0.02f, 0.01f); }
    else if (which == 3) { const int c = (int)(h2 % 512u); const bf16* yp = (const bf16*)(ws + WS_D); const float* glu = (const float*)a.in[14] + (size_t)layer * 512 * 512; float s = 0.f;
        for (int k = 0; k < 512; ++k) s += bf2f(yp[(size_t)r * 512 + k]) * rbf(glu[(size_t)k * 512 + c]);
        fail = bad(bf2f(Y[(size_t)r * 512 + c]), bf2f(yp[(size_t)r * 512 + c]) / (1.f + expf(-s)), 0.02f, 0.01f); }
    else if (which == 4) { const int c = (int)(h2 % 1024u); float tot = 0.f;
        for (int b = 0; b < 4; ++b) { const float* wb = (const float*)a.in[30 + b] + (size_t)layer * 512 * 1024; float s = 0.f;
            for (int k = 0; k < 512; ++k) s += bf2f(Y[((size_t)b * T + r) * 512 + k]) * rbf(wb[(size_t)k * 1024 + c]);
            tot += bf2f(PAp[(size_t)r * NGATE + b * 1024 + c]) * s; }
        fail = bad(bf2f(MG[(size_t)r * 1024 + c]), tot, 0.03f, 0.03f); }
    else if (which == 5 || which == 7) { const int c = (int)(h2 % 1024u); const float* wo = (const float*)a.in[34] + (size_t)layer * DM * DM; float s = ((const float*)a.in[0])[(size_t)r * DM + c];
        for (int k = 0; k < DM; ++k) s += bf2f(MG[(size_t)r * 1024 + k]) * rbf(wo[(size_t)k * DM + c]);
        if (which == 7) { const float* wd = (const float*)a.in[37]; for (int j = 0; j < FFD; ++j) s += bf2f(PAp[(size_t)r * FFD + j]) * rbf(wd[(size_t)j * DM + c]); }
        fail = bad(a.out[(size_t)r * DM + c], s, 0.01f, 0.03f); }
    else if (which == 6) { const int c = (int)(h2 % (unsigned)FFD); const float* wg = (const float*)a.in[35]; const float* wu = (const float*)a.in[36]; float g = 0.f, u = 0.f;
        for (int k = 0; k < DM; ++k) { const float hv = bf2f(H[(size_t)r * DM + k]); g += hv * rbf(wg[(size_t)k * FFD + c]); u += hv * rbf(wu[(size_t)k * FFD + c]); }
        fail = bad(bf2f(PAp[(size_t)r * FFD + c]), g / (1.f + expf(-g)) * u, 0.02f, 0.02f); }
    else if (which == 8 || which == 9) {
        int cn[8], tb[9], run = 0; for (int e = 0; e < 8; ++e) { cn[e] = (int)((unsigned*)(ws + WS_CTL))[CW_CNT + 64 * e]; tb[e] = run; run += (cn[e] + 255) >> 8; } tb[8] = run;
        const int ntp = run < PASS_TILES ? run : PASS_TILES; const int rl = (int)(h1 % (unsigned)(ntp * 256)); const int ti = rl >> 8; int e = 0; for (int k = 1; k < 8; ++k) e += (ti >= tb[k]);
        const int rin = (ti - tb[e]) * 256 + (rl & 255);
        if (rin < cn[e]) { const int tok = ((const int*)(ws + WS_ROWTOK))[e * T + rin];
            if (which == 8) { const int c = (int)(h2 % (unsigned)FFE); const float* wg = (const float*)a.in[39] + (size_t)e * DM * FFE; const float* wu = (const float*)a.in[40] + (size_t)e * DM * FFE; float g = 0.f, u = 0.f;
                for (int k = 0; k < DM; ++k) { const float hv = bf2f(H[(size_t)tok * DM + k]); g += hv * rbf(wg[(size_t)k * FFE + c]); u += hv * rbf(wu[(size_t)k * FFE + c]); }
                fail = bad(bf2f(PAp[(size_t)rl * FFE + c]), g / (1.f + expf(-g)) * u, 0.02f, 0.02f); }
            else { const int c = (int)(h2 % 1024u); const float* wd = (const float*)a.in[41] + (size_t)e * FFE * DM; float s = 0.f;
                for (int j = 0; j < FFE; ++j) s += bf2f(PAp[(size_t)rl * FFE + j]) * rbf(wd[(size_t)j * DM + c]);
                fail = bad(bf2f(((const bf16*)(ws + WS_YM))[(size_t)rl * DM + c]), s, 0.02f, 0.02f); } } }
    else if (which == 10) {
        const int c = (int)(h2 % 1024u); const float* x = (const float*)a.in[0] + (size_t)r * DM; float ss = 0.f; for (int k = 0; k < DM; ++k) ss += x[k] * x[k];
        const float ref = x[c] / sqrtf(ss / DM + RMS_EPS) * ((const float*)a.in[2])[c]; fail = bad(bf2f(H[(size_t)r * DM + c]), ref, 0.01f, 0.005f); }
    if (fail) { atomicAdd(cnt, 1u);
        if (which == 2) { const int c = (int)(h2 % (unsigned)NGATE); atomicAdd(cnt + 1 + (c >> 10), 1u);
            const int pm = r >> 8, pn = c >> 8; atomicOr(cnt + 8 + (pm >> 5), 1u << (pm & 31)); atomicOr(cnt + 10, 1u << pn);
            atomicOr(cnt + 11, 1u << ((r >> 4) & 15)); atomicOr(cnt + 12, 1u << (c & 31)); } }
}
__global__ void __launch_bounds__(256) chk_final(Args a) {
    const unsigned* c = (const unsigned*)(a.ws + WS_CTL) + CW_CHK; int first = 0;
    for (int k = 1; k <= 10; ++k) if (first == 0 && c[64 * k] != 0u) first = k;
#if SELFCHK == 2
    first = 0; { unsigned n = c[64 * 2] + 1u; while (n > 1u) { n >>= 1; ++first; } } if (c[64 * 2] == 0u) first = 0; else first += 0;
#elif SELFCHK == 4
    first = __builtin_popcount(c[64 * 2 + 8]) + __builtin_popcount(c[64 * 2 + 9]);
#elif SELFCHK == 5
    first = __builtin_popcount(c[64 * 2 + 10]);
#elif SELFCHK == 6
    first = __builtin_popcount(c[64 * 2 + 11]);
#elif SELFCHK == 7
    first = __builtin_popcount(c[64 * 2 + 12]);
#elif SELFCHK == 3
    first = (c[64 * 2 + 1] ? 1 : 0) | (c[64 * 2 + 2] ? 2 : 0) | (c[64 * 2 + 3] ? 4 : 0) | (c[64 * 2 + 4] ? 8 : 0);
#endif
    if (first) { const float v = 1.0f + (float)first; for (size_t i = (size_t)blockIdx.x * 256 + threadIdx.x; i < (size_t)T * DM; i += (size_t)gridDim.x * 256) a.out[i] = v; }
}
#endif
extern "C" void kernel_launch(void* const* d_in, const int* in_sizes, int n_in, void* d_out, int out_size, void* d_ws, size_t ws_size, hipStream_t stream) {
    static int grid = 0;
    if (grid == 0) {
        if (n_in != 42 || out_size != T * DM || ws_size < WS_END) { fprintf(stderr, "kernel_launch: unexpected shapes: n_in %d out %d ws %zu (need %zu)\n", n_in, out_size, ws_size, (size_t)WS_END); grid = -1; return; }
        int dev = 0, cus = 0, per_cu = 0;
        if (hipGetDevice(&dev) != hipSuccess || hipDeviceGetAttribute(&cus, hipDeviceAttributeMultiprocessorCount, dev) != hipSuccess) { grid = -1; return; }
        if (hipFuncSetAttribute((const void*)fwd, hipFuncAttributeMaxDynamicSharedMemorySize, LDS_BYTES) != hipSuccess) { fprintf(stderr, "kernel_launch: hipFuncSetAttribute failed\n"); grid = -1; return; }
        if (hipOccupancyMaxActiveBlocksPerMultiprocessor(&per_cu, (const void*)fwd, NTHR, LDS_BYTES) != hipSuccess || per_cu < 1) fprintf(stderr, "kernel_launch: occupancy query says %d\n", per_cu);
        (void)hipGetLastError();
        grid = cus;
    }
    if (grid < 0) return;
    (void)in_sizes;
    if (hipMemsetAsync((char*)d_ws + WS_CTL, 0, CTL_ZERO_BYTES, stream) != hipSuccess) return;
#if NANFILL & 64
    if (hipMemsetAsync((char*)d_ws + WS_W, 0xFF, WS_MDN - WS_W, stream) != hipSuccess) return;
#endif
    Args a{};
    for (int i = 0; i < 42; ++i) a.in[i] = d_in[i];
    a.out = (float*)d_out; a.ws = (unsigned char*)d_ws;
#if MK_MULTI
    for (int p = 0; p < NPH; ++p) { a.ph_lo = p; a.ph_hi = p + 1; hipLaunchKernelGGL(fwd, dim3(grid), dim3(NTHR), LDS_BYTES, stream, a);
#if SELFCHK
        const int after[11] = {0, 2, 5, 4, 6, 7, 9, 10, 20, 21, 1};
        for (int k = 1; k <= 10; ++k) if (after[k] == p) hipLaunchKernelGGL(chk, dim3(256), dim3(256), 0, stream, a, k, 0);
#endif
    }
#if SELFCHK
    hipLaunchKernelGGL(chk_final, dim3(1024), dim3(256), 0, stream, a);
#endif
#else
    a.ph_lo = 0; a.ph_hi = NPH; hipLaunchKernelGGL(fwd, dim3(grid), dim3(NTHR), LDS_BYTES, stream, a);
#endif
}
```

```cpp
#include <hip/hip_runtime.h>
#include <cstdio>
#include <cstdint>
namespace pg8 {
#define PG8_LAS __attribute__((address_space(3)))
typedef unsigned short bf16_t;
typedef short bf16x8 __attribute__((ext_vector_type(8)));
typedef float f32x4 __attribute__((ext_vector_type(4)));
typedef unsigned u32x4 __attribute__((ext_vector_type(4)));
constexpr int BM = 256, BK = 64, HALF = 128, HTB = HALF * BK * 2  , STAGE_BYTES = 8 * HTB, NXCD = 8, WGM = 8;

__host__ __device__ __forceinline__ int lds_byte(int r, int c) { const int st = (r >> 4) * 2 + (c >> 5), rr = r & 15, cc = c & 31, ob = rr * 64 + cc * 2; return st * 1024 + (ob ^ (((ob >> 9) & 1) << 5)); }
__host__ __device__ __forceinline__ void stage_rc(int b, int& R, int& C) { const int st = b / 1024, sb = b % 1024, swz = sb ^ (((sb >> 9) & 1) << 5); R = (st >> 1) * 16 + swz / 64; C = (st & 1) * 32 + (swz % 64) / 2; }
__host__ __device__ __forceinline__ int perm32(int rho) { const int n = rho >> 4, i = rho & 15; return 8 * (i >> 2) + 4 * n + (i & 3); }

struct Unit { int pm, pn; int ko = 0; };
struct Gemm { const bf16_t* A; const bf16_t* Bt; int M, N, K; int ld = 0; };

struct StaticOrder {
    int nM, nN, nwg, G, c;
    __host__ __device__ void init(int M, int N, int G_, int c_) { nM = M / BM; nN = N / BM; nwg = nM * nN; G = G_; c = c_; }
    __host__ __device__ bool next(int i, Unit& u) const {
        const long L = (long)i * G + c; if (L >= nwg) return false;
        int wgid = (int)L; { const int q = nwg / NXCD, r = nwg % NXCD, xcd = wgid % NXCD, off = wgid / NXCD; wgid = (xcd < r ? xcd * (q + 1) : r * (q + 1) + (xcd - r) * q) + off; }
        const int nig = WGM * nN, gid = wgid / nig, fm = gid * WGM, gsz = (nM - fm) < WGM ? (nM - fm) : WGM;
        u.pm = fm + ((wgid % nig) % gsz); u.pn = (wgid % nig) / gsz; return true;
    }
    __device__ __forceinline__ void a_ready(const Unit&) const {}
    __device__ __forceinline__ void done(const Unit&) const {}
};

typedef __bf16 bf16x2_cv __attribute__((ext_vector_type(2)));
typedef float f32x2_cv __attribute__((ext_vector_type(2)));
__device__ __forceinline__ unsigned cvt_pk_bf16(float lo, float hi) { const f32x2_cv v = {lo, hi}; const bf16x2_cv b = __builtin_convertvector(v, bf16x2_cv); return __builtin_bit_cast(unsigned, b); }
typedef float f32x2 __attribute__((ext_vector_type(2)));
__device__ __forceinline__ f32x2 gelu_pk(f32x2 v) {
    const f32x2 av = __builtin_elementwise_abs(v), d = av * 0.2316418882f + 1.0f;
    f32x2 t; t.x = __builtin_amdgcn_rcpf(d.x); t.y = __builtin_amdgcn_rcpf(d.y);
    f32x2 q = t * 0.5307027145f + (-0.7265760135f); q = q * t + 0.7107068705f; q = q * t + (-0.142248368f); q = q * t + 0.127414796f; q = q * t;
    const f32x2 s = (v * v) * (-0.72134752044f);
    f32x2 e; e.x = __builtin_amdgcn_exp2f(s.x); e.y = __builtin_amdgcn_exp2f(s.y);
    const f32x2 m = v * (q * e), r = v - m;
    f32x2 o; o.x = v.x < 0.f ? m.x : r.x; o.y = v.y < 0.f ? m.y : r.y; return o;
}

template <int ACT  > struct EpiBf16 {
    static constexpr bool PERM = true, AFTER_DRAIN = false; static_assert(ACT == 0 || ACT == 1, "EpiBf16: ACT is 0 (none) or 1 (gelu_pk)");
    bf16_t* O; int ldc; const float* bias; int split_cols; size_t split_stride; float scale0;
    __device__ __forceinline__ void operator()(const f32x4 (&acc)[2][2][4][2], const Unit& u, int wr, int wc, int fr, int fq) const {
        const int row0 = u.pm * BM + wr * 64 + fr; int colt = u.pn * BM; bf16_t* base = O;
        float sc = 1.f; if (split_cols) { const int t = colt / split_cols; base += (size_t)t * split_stride; colt -= t * split_cols; if (t == 0) sc = scale0; }
        const int col0 = colt + wc * 32 + 8 * fq, bcol0 = u.pn * BM + wc * 32 + 8 * fq;
        f32x4 bv[2][2];
#pragma unroll
        for (int bj = 0; bj < 2; ++bj)
#pragma unroll
            for (int n = 0; n < 2; ++n) bv[bj][n] = bias ? *(const f32x4*)(bias + bcol0 + bj * HALF + 4 * n) : (f32x4){0.f, 0.f, 0.f, 0.f};
#pragma unroll
        for (int ai = 0; ai < 2; ++ai)
#pragma unroll
            for (int m = 0; m < 4; ++m) { bf16_t* rowp = base + (size_t)(row0 + ai * HALF + m * 16) * ldc + col0;
#pragma unroll
                for (int bj = 0; bj < 2; ++bj) { f32x4 v0 = acc[ai][bj][m][0] + bv[bj][0], v1 = acc[ai][bj][m][1] + bv[bj][1];
                    if (ACT == 1) { f32x2 a = gelu_pk((f32x2){v0[0], v0[1]}), b = gelu_pk((f32x2){v0[2], v0[3]}), c = gelu_pk((f32x2){v1[0], v1[1]}), d = gelu_pk((f32x2){v1[2], v1[3]});
                        v0 = (f32x4){a.x, a.y, b.x, b.y}; v1 = (f32x4){c.x, c.y, d.x, d.y}; }
                    v0 = v0 * sc; v1 = v1 * sc; u32x4 w; w.x = cvt_pk_bf16(v0[0], v0[1]); w.y = cvt_pk_bf16(v0[2], v0[3]); w.z = cvt_pk_bf16(v1[0], v1[1]); w.w = cvt_pk_bf16(v1[2], v1[3]);
                    *(u32x4*)(rowp + bj * HALF) = w; } }
    }
};
template <class E, class = void> struct keeps_acc { static constexpr bool value = false; };
template <class E> struct keeps_acc<E, decltype((void)E::KEEP_ACC)> { static constexpr bool value = E::KEEP_ACC; };
template <class Epi, class Sched, bool ALIGN_EPI = false, bool SP2 = false, bool GATHER = false>
__device__ __forceinline__ void gemm_phase(PG8_LAS unsigned char* lds, const Gemm g, const Sched& S, const Epi& E) {
    int tid_l = threadIdx.x; asm volatile("" : "+v"(tid_l));
    const int tid = tid_l, wid = __builtin_amdgcn_readfirstlane(tid >> 6), lane = tid & 63, wr = wid >> 2, wc = wid & 3, fr = lane & 15, fq = lane >> 4;
    const int K = g.K, nt = K / BK, LD = g.ld ? g.ld : g.K;
    unsigned voffA[2], voffB[2];
    static_assert(!GATHER || SP2, "GATHER is wired into the SP2 loop only");
    int RA[2], CA[2];
#pragma unroll
    for (int i = 0; i < 2; ++i) { int R, C; stage_rc(tid * 16 + i * 8192, R, C); const int Rb = Epi::PERM ? ((R & ~31) + perm32(R & 31)) : R; RA[i] = R; CA[i] = C;
        voffA[i] = (unsigned)(R * LD + C) * 2u; voffB[i] = (unsigned)(Rb * LD + C) * 2u; }
    unsigned vgC[2][2] = {{0u, 0u}, {0u, 0u}}, vgN[2][2] = {{0u, 0u}, {0u, 0u}};
    const size_t kstep = (size_t)(BK * 2);
    const size_t hstep = (size_t)HALF * LD * 2;
    const size_t tstep = 2 * hstep;
    const unsigned ldsw = (unsigned)wid * 1024u;
    const int aoff = lds_byte(wr * 64 + fr, fq * 8), boff = lds_byte(wc * 32 + fr, fq * 8);
#define PG8_SA(b, h) (((b) * 2 + (h)) * HTB)
#define PG8_SB(b, h) ((4 + (b) * 2 + (h)) * HTB)
#define PG8_STAGE(bufoff, gbase, voff) do { _Pragma("unroll") for (int _i = 0; _i < 2; ++_i) \
        __builtin_amdgcn_global_load_lds((const unsigned*)((const char*)(gbase) + (voff)[_i]), (PG8_LAS unsigned*)(lds + (bufoff) + ldsw + _i * 8192), 16, 0, 0); } while (0)
#define PG8_STAGE_A(bufoff, kb, h, vsel) do { if constexpr (GATHER) { PG8_STAGE(bufoff, kb, vsel); } else { PG8_STAGE(bufoff, (kb) + (h) * hstep, voffA); } } while (0)
#define PG8_LDA(dst, b, h) do { _Pragma("unroll") for (int m = 0; m < 4; ++m) _Pragma("unroll") for (int k = 0; k < 2; ++k) dst[m][k] = *(const PG8_LAS bf16x8*)(lds + PG8_SA(b, h) + aoff + m * 2048 + k * 1024); } while (0)
#define PG8_LDB(dst, b, h) do { _Pragma("unroll") for (int n = 0; n < 2; ++n) _Pragma("unroll") for (int k = 0; k < 2; ++k) dst[n][k] = *(const PG8_LAS bf16x8*)(lds + PG8_SB(b, h) + boff + n * 2048 + k * 1024); } while (0)
#define PG8_MMA(ai, bj, At, Bt) do { __builtin_amdgcn_s_setprio(1); _Pragma("unroll") for (int m = 0; m < 4; ++m) _Pragma("unroll") for (int n = 0; n < 2; ++n) _Pragma("unroll") for (int k = 0; k < 2; ++k) \
        acc[ai][bj][m][n] = __builtin_amdgcn_mfma_f32_16x16x32_bf16(Bt[n][k], At[m][k], acc[ai][bj][m][n], 0, 0, 0); __builtin_amdgcn_s_setprio(0); } while (0)
#define PG8_WAIT_V(n) asm volatile("s_waitcnt vmcnt(" #n ")" ::: "memory")
#define PG8_WAIT_L(n) asm volatile("s_waitcnt lgkmcnt(" #n ")" ::: "memory")
#define PG8_BAR __builtin_amdgcn_s_barrier()
#define PG8_SCHED __builtin_amdgcn_sched_barrier(0)
    Unit cur, nxt; int ui = 0;
    if (!S.next(0, cur)) return;
    f32x4 acc[2][2][4][2];
#pragma unroll
    for (int a = 0; a < 2; ++a)
#pragma unroll
        for (int b = 0; b < 2; ++b)
#pragma unroll
            for (int m = 0; m < 4; ++m)
#pragma unroll
                for (int n = 0; n < 2; ++n) acc[a][b][m][n] = (f32x4){0.f, 0.f, 0.f, 0.f};
    bf16x8 At[4][2], B0[2][2], B1[2][2];
    const char* cA = (const char*)g.A + (GATHER ? (size_t)0 : (size_t)cur.pm * tstep) + (size_t)cur.ko * 2; const char* cB = (const char*)g.Bt + (size_t)cur.pn * tstep + (size_t)cur.ko * 2;
    S.a_ready(cur);
    if constexpr (GATHER) {
#pragma unroll
        for (int h = 0; h < 2; ++h)
#pragma unroll
            for (int i = 0; i < 2; ++i) vgC[h][i] = S.aoff(cur, h * HALF + RA[i]) + (unsigned)CA[i] * 2u; }
    if constexpr (SP2) {
        PG8_STAGE(PG8_SB(0, 0), cB, voffB); PG8_STAGE(PG8_SB(0, 1), cB + hstep, voffB); PG8_STAGE_A(PG8_SA(0, 0), cA, 0, vgC[0]); PG8_STAGE_A(PG8_SA(0, 1), cA, 1, vgC[1]);
        if (wr == 1) PG8_BAR;
        PG8_WAIT_V(2); PG8_BAR;
        PG8_STAGE(PG8_SB(1, 0), cB + kstep, voffB); PG8_STAGE_A(PG8_SA(1, 0), cA + kstep, 0, vgC[0]); PG8_STAGE(PG8_SB(1, 1), cB + hstep + kstep, voffB);
        PG8_WAIT_V(6); PG8_BAR;
    } else {
        PG8_STAGE(PG8_SB(0, 0), cB, voffB); PG8_STAGE(PG8_SA(0, 0), cA, voffA); PG8_STAGE(PG8_SB(0, 1), cB + hstep, voffB); PG8_STAGE(PG8_SA(0, 1), cA + hstep, voffA);
        if (wr == 1) PG8_BAR;
        PG8_WAIT_V(4); PG8_BAR;
        PG8_STAGE(PG8_SB(1, 0), cB + kstep, voffB); PG8_STAGE(PG8_SA(1, 0), cA + kstep, voffA); PG8_STAGE(PG8_SB(1, 1), cB + hstep + kstep, voffB);
        PG8_WAIT_V(6); PG8_BAR;
    }
    for (;;) {
        const bool has_next = S.next(ui + 1, nxt);
        if constexpr (GATHER) { if (has_next) {
#pragma unroll
            for (int h = 0; h < 2; ++h)
#pragma unroll
                for (int i = 0; i < 2; ++i) vgN[h][i] = S.aoff(nxt, h * HALF + RA[i]) + (unsigned)CA[i] * 2u; } }
        const char* nA = has_next ? (const char*)g.A + (GATHER ? (size_t)0 : (size_t)nxt.pm * tstep) + (size_t)nxt.ko * 2 : cA; const char* nB = has_next ? (const char*)g.Bt + (size_t)nxt.pn * tstep + (size_t)nxt.ko * 2 : cB;
        for (int t = 0; t < nt; t += 2) {
            const bool last = (t == nt - 2);
            const char* a1 = cA + (size_t)(t + 1) * kstep;
            const char* a2 = last ? nA : cA + (size_t)(t + 2) * kstep; const char* b2 = last ? nB : cB + (size_t)(t + 2) * kstep;
            const char* a3 = a2 + kstep; const char* b3 = b2 + kstep;
            if (last && has_next) S.a_ready(nxt);
            unsigned vs0[2] = {vgC[0][0], vgC[0][1]}, vs1[2] = {vgC[1][0], vgC[1][1]};
            if constexpr (GATHER) { if (last && has_next) {
#pragma unroll
                for (int i = 0; i < 2; ++i) { unsigned x0 = vgN[0][i], x1 = vgN[1][i]; asm volatile("" : "+v"(x0), "+v"(x1)); vs0[i] = x0; vs1[i] = x1; } } }
            if constexpr (SP2) {
            PG8_LDB(B0, 0, 0); PG8_LDB(B1, 0, 1); PG8_SCHED; PG8_LDA(At, 0, 0); PG8_STAGE_A(PG8_SA(1, 1), a1, 1, vgC[1]);
            PG8_WAIT_V(8); PG8_WAIT_L(0); PG8_BAR; PG8_MMA(0, 0, At, B0); PG8_MMA(0, 1, At, B1); PG8_BAR; PG8_SCHED;
            PG8_LDA(At, 0, 1); PG8_STAGE(PG8_SB(0, 0), b2, voffB); PG8_STAGE(PG8_SB(0, 1), b2 + hstep, voffB); PG8_STAGE_A(PG8_SA(0, 0), a2, 0, vs0);
            PG8_WAIT_V(8); PG8_WAIT_L(0); PG8_BAR; PG8_MMA(1, 0, At, B0); PG8_MMA(1, 1, At, B1); PG8_BAR; PG8_SCHED;
            PG8_LDB(B0, 1, 0); PG8_LDB(B1, 1, 1); PG8_SCHED; PG8_LDA(At, 1, 0); PG8_STAGE_A(PG8_SA(0, 1), a2, 1, vs1);
            PG8_WAIT_V(8); PG8_WAIT_L(0); PG8_BAR; PG8_MMA(0, 0, At, B0); PG8_MMA(0, 1, At, B1); PG8_BAR; PG8_SCHED;
            PG8_LDA(At, 1, 1); PG8_STAGE(PG8_SB(1, 0), b3, voffB); PG8_STAGE(PG8_SB(1, 1), b3 + hstep, voffB); PG8_STAGE_A(PG8_SA(1, 0), a3, 0, vs0);
            PG8_WAIT_V(8); PG8_WAIT_L(0); PG8_BAR; PG8_MMA(1, 0, At, B0); PG8_MMA(1, 1, At, B1); PG8_BAR; PG8_SCHED;
            } else {
            PG8_LDB(B0, 0, 0); PG8_SCHED; PG8_LDA(At, 0, 0); PG8_STAGE(PG8_SA(1, 1), a1 + hstep, voffA);
            PG8_WAIT_L(8); PG8_BAR; PG8_WAIT_L(0); PG8_MMA(0, 0, At, B0); PG8_BAR; PG8_SCHED;
            PG8_LDB(B1, 0, 1); PG8_STAGE(PG8_SB(0, 0), b2, voffB);
            PG8_BAR; PG8_WAIT_L(0); PG8_MMA(0, 1, At, B1); PG8_BAR;
            PG8_LDA(At, 0, 1); PG8_STAGE(PG8_SA(0, 0), a2, voffA);
            PG8_BAR; PG8_WAIT_L(0); PG8_MMA(1, 0, At, B0); PG8_BAR; PG8_SCHED;
            PG8_STAGE(PG8_SB(0, 1), b2 + hstep, voffB);
            PG8_WAIT_V(6); PG8_BAR; PG8_MMA(1, 1, At, B1); PG8_BAR;
            PG8_LDB(B0, 1, 0); PG8_SCHED; PG8_LDA(At, 1, 0); PG8_STAGE(PG8_SA(0, 1), a2 + hstep, voffA);
            PG8_WAIT_L(8); PG8_BAR; PG8_WAIT_L(0); PG8_MMA(0, 0, At, B0); PG8_BAR; PG8_SCHED;
            PG8_LDB(B1, 1, 1); PG8_STAGE(PG8_SB(1, 0), b3, voffB);
            PG8_BAR; PG8_WAIT_L(0); PG8_MMA(0, 1, At, B1); PG8_BAR;
            PG8_LDA(At, 1, 1); PG8_STAGE(PG8_SA(1, 0), a3, voffA);
            PG8_BAR; PG8_WAIT_L(0); PG8_MMA(1, 0, At, B0); PG8_BAR; PG8_SCHED;
            PG8_STAGE(PG8_SB(1, 1), b3 + hstep, voffB);
            PG8_WAIT_V(6); PG8_BAR; PG8_MMA(1, 1, At, B1); PG8_BAR;
            }
        }
        if constexpr (ALIGN_EPI) { if (wr == 0) PG8_BAR; }
        if constexpr (!Epi::AFTER_DRAIN) { if constexpr (keeps_acc<Epi>::value) E.keep(acc, cur, wr, wc, fr, fq); else E(acc, cur, wr, wc, fr, fq); S.done(cur); }
        if (!has_next) break;
        if constexpr (!keeps_acc<Epi>::value)
#pragma unroll
        for (int a = 0; a < 2; ++a)
#pragma unroll
            for (int b = 0; b < 2; ++b)
#pragma unroll
                for (int m = 0; m < 4; ++m)
#pragma unroll
                    for (int n = 0; n < 2; ++n) acc[a][b][m][n] = (f32x4){0.f, 0.f, 0.f, 0.f};
        cur = nxt; cA = nA; cB = nB; ++ui;
        if constexpr (GATHER) {
#pragma unroll
            for (int h = 0; h < 2; ++h)
#pragma unroll
                for (int i = 0; i < 2; ++i) vgC[h][i] = vgN[h][i]; }
        if constexpr (ALIGN_EPI) { if (wr == 1) PG8_BAR; }
    }
    PG8_WAIT_V(0);
    if constexpr (!ALIGN_EPI) { if (wr == 0) PG8_BAR; }
    PG8_BAR;
    if constexpr (Epi::AFTER_DRAIN) { E.fused(acc, cur, wr, wc, fr, fq, lds, wid, lane); S.done(cur); }
#undef PG8_SA
#undef PG8_SB
#undef PG8_STAGE
#undef PG8_STAGE_A
#undef PG8_LDA
#undef PG8_LDB
#undef PG8_MMA
#undef PG8_WAIT_V
#undef PG8_WAIT_L
#undef PG8_BAR
#undef PG8_SCHED
}
}

#define GAS __attribute__((address_space(1)))
#define LAS __attribute__((address_space(3)))
typedef unsigned short bf16;
typedef unsigned v4u __attribute__((ext_vector_type(4)));
typedef float f32x4 __attribute__((ext_vector_type(4)));
typedef short bf16x8 __attribute__((ext_vector_type(8)));
typedef GAS unsigned gu32;
typedef GAS unsigned long long gu64;
#define RLX_AGENT __ATOMIC_RELAXED, __HIP_MEMORY_SCOPE_AGENT
#define LDS_WAIT() asm volatile("s_waitcnt lgkmcnt(0)" ::: "memory")
#define VM_WAIT() asm volatile("s_waitcnt vmcnt(0)" ::: "memory")
__device__ __forceinline__ unsigned long long rt() { return __builtin_amdgcn_s_memrealtime(); }
__device__ __forceinline__ unsigned f2bf(float f) { unsigned u = __builtin_bit_cast(unsigned, f); return (u + 0x7fffu + ((u >> 16) & 1u)) >> 16; }
__device__ __forceinline__ unsigned pk2(float lo, float hi) { return f2bf(lo) | (f2bf(hi) << 16); }

#define XB_TMO      128
#define XB_XCNT(j)  (256  + 64 * (j))
#define XB_XSUB(j)  (1280 + 64 * (j))
#define XB_XGEN(j)  (2304 + 64 * (j))
#define XB_TOP      3328
#define XB_TOPGEN   3392
#define XCD_BAR_WORDS 3456
#define XB_SPIN_CAP (1u << 18)

__device__ __forceinline__ unsigned xb_ld(unsigned* p)              { return __hip_atomic_load(p, __ATOMIC_RELAXED, __HIP_MEMORY_SCOPE_AGENT); }
__device__ __forceinline__ unsigned xb_add(unsigned* p, unsigned v) { return __hip_atomic_fetch_add(p, v, __ATOMIC_RELAXED, __HIP_MEMORY_SCOPE_AGENT); }
__device__ __forceinline__ unsigned xb_xcc_id() { return (unsigned)__builtin_amdgcn_s_getreg((3 << 11) | 20) & 0xFu; }
#define XB_SPIN(cond, bar) do { unsigned _sp = 0; while (cond) { __builtin_amdgcn_s_sleep(1); \
    if ((++_sp & 255u) == 0u) { if (xb_ld(&(bar)[XB_TMO])) break; if (_sp > XB_SPIN_CAP) { atomicAdd(&(bar)[XB_TMO], 1u); break; } } } } while (0)

struct XcdBarrier {
    unsigned* bar; unsigned x;
    volatile LAS unsigned* st;
};

__device__ __forceinline__ XcdBarrier xcd_barrier_post(unsigned* bar, volatile LAS unsigned* st) {
    XcdBarrier b; b.bar = bar; b.x = xb_xcc_id(); b.st = st;
    if (threadIdx.x == 0) (void)xb_add(&bar[XB_XCNT(b.x)], 1u);
    return b;
}
__device__ __forceinline__ void xcd_barrier_complete(unsigned* bar, unsigned x, unsigned& nloc, unsigned& nx) {
    const unsigned G = gridDim.x * gridDim.y * gridDim.z;
    unsigned sum, cnt, mine, sp = 0u;
    for (;;) {
        sum = 0u; cnt = 0u; mine = 0u;
#pragma unroll
        for (unsigned j = 0; j < 16; ++j) { const unsigned c = xb_ld(&bar[XB_XCNT(j)]); sum += c; cnt += (c > 0u) ? 1u : 0u; mine = (j == x) ? c : mine; }
        if (sum == G) break;
        __builtin_amdgcn_s_sleep(1);
        if ((++sp & 255u) == 0u) { if (xb_ld(&bar[XB_TMO])) break; if (sp > XB_SPIN_CAP) { atomicAdd(&bar[XB_TMO], 1u); break; } }
    }
    nloc = mine > 0u ? mine : 1u; nx = cnt > 0u ? cnt : 1u;
}

__device__ __forceinline__ void xcd_barrier(const XcdBarrier& b) {
    asm volatile("s_waitcnt vmcnt(0)" ::: "memory");
    __syncthreads();
    if (threadIdx.x == 0) {
        unsigned* bar = b.bar;
        __builtin_amdgcn_s_waitcnt(0);
        unsigned nloc = b.st[0], nx = b.st[1];
        if (nloc == 0u) { xcd_barrier_complete(bar, b.x, nloc, nx); b.st[0] = nloc; b.st[1] = nx; }
        const unsigned old = xb_add(&bar[XB_XSUB(b.x)], 1u);
        const unsigned gen = old / nloc;
        if (old + 1u == (gen + 1u) * nloc) {
            __builtin_amdgcn_fence(__ATOMIC_RELEASE, "agent");
            asm volatile("s_waitcnt vmcnt(0)" ::: "memory");
            const unsigned og = xb_add(&bar[XB_TOP], 1u);
            const unsigned tg = og / nx;
            if (og + 1u == (tg + 1u) * nx) xb_add(&bar[XB_TOPGEN], 1u);
            else XB_SPIN(xb_ld(&bar[XB_TOPGEN]) == tg, bar);
            __builtin_amdgcn_fence(__ATOMIC_ACQUIRE, "agent");
            xb_add(&bar[XB_XGEN(b.x)], 1u);
            asm volatile("s_waitcnt vmcnt(0)" ::: "memory");
        } else {
            XB_SPIN(xb_ld(&bar[XB_XGEN(b.x)]) == gen, bar);
            __builtin_amdgcn_fence(__ATOMIC_ACQUIRE, "agent");
            asm volatile("s_waitcnt vmcnt(0)" ::: "memory");
        }
    }
    __syncthreads();
}

constexpr int NWAVES = 8, NTHR = 512;
constexpr int BATCH = 2, SEQ = 8192, T = BATCH * SEQ, DM = 1024;
constexpr int IN_COLS = 8992, PMW = 5120, NMIX = 4896, NGATE = 4096;
constexpr int C_U = 0, C_QKV = 512, C_A = 2048, C_B = 2052, C_Z = 2056, C_NQ = 2568, C_KC = 3080, C_VC = 3208, C_KS = 3336, C_VS = 3464, C_KW = 3592, C_VW = 3720, C_NG = 3848, C_SGU = 3872;
constexpr int FFD = 2816, FFE = 3584, NEXP = 8;
constexpr int NCMP = 511;
constexpr int PASS_TILES = 64, PASS_CAP1 = 72;
__device__ __forceinline__ constexpr int pass_cap(int pass) { return pass == 0 ? PASS_TILES : PASS_CAP1; }
constexpr float RMS_EPS = 1e-6f;
#ifndef MK_MULTI
#define MK_MULTI 0
#endif
constexpr int NPH = 28;
#ifndef ABL
#define ABL 0
#endif
#ifndef NANFILL
#define NANFILL 0
#endif
#ifndef SELFCHK
#define SELFCHK 0
#endif
#ifndef STAMPMASK
#define STAMPMASK 0
#endif
#ifndef STAMPSEL
#define STAMPSEL 0
#endif
#ifndef NSA_NAIVE
#define NSA_NAIVE 0
#endif
#ifndef ABL_LAYERS
#define ABL_LAYERS 3
#endif
#ifndef MASK_T0
#define MASK_T0 0
#endif
#ifndef MASK_T1
#define MASK_T1 0
#endif

constexpr size_t MiB = 1u << 20;
constexpr size_t WS_CTL = 0, CTL_ZERO_BYTES = 1 * MiB;
constexpr int CW_BAR = 4096;
constexpr int CW_NSAQ = 24576;
constexpr int CW_CNT = 16384;
constexpr size_t WS_ROWTOK = 1 * MiB;
constexpr size_t WS_TOKINFO = WS_ROWTOK + 512 * 1024;
constexpr size_t WS_TOKW = WS_TOKINFO + 128 * 1024;
constexpr size_t WS_GBETA = WS_TOKW + 128 * 1024;
constexpr size_t WS_GLA = WS_GBETA + 256 * 1024;
constexpr size_t WS_GSS = 1 * MiB;
constexpr size_t WS_SSME = 4 * MiB;
constexpr size_t WS_KCC = 3 * MiB;
constexpr size_t WS_W = 8 * MiB;
constexpr size_t W_IN1 = 0, W_IN2 = W_IN1 + (size_t)PMW * DM * 2, W_GLU = W_IN2 + (size_t)NGATE * DM * 2, W_BR = W_GLU + 512 * 512 * 2, W_OUT = W_BR + (size_t)4 * 1024 * 512 * 2, W_LAYER = W_OUT + (size_t)DM * DM * 2;
constexpr size_t WS_WL = WS_W;
constexpr size_t WS_FUP = WS_WL + 2 * W_LAYER;
constexpr size_t WS_FDN = WS_FUP + (size_t)2 * FFD * DM * 2;
constexpr size_t WS_MUP = WS_FDN + (size_t)FFD * DM * 2;
constexpr size_t WS_MDN = WS_MUP + (size_t)NEXP * 2 * FFE * DM * 2;
constexpr size_t WS_WEND = WS_MDN + (size_t)NEXP * FFE * DM * 2;
static_assert(WS_WEND <= 244 * MiB, "weights region");
constexpr size_t GDN_UNITS = (size_t)BATCH * (SEQ / 64) * 4;
constexpr size_t WS_GWF = WS_MDN;
constexpr size_t WS_GQF = WS_GWF + GDN_UNITS * 16384;
constexpr size_t WS_GKF = WS_GQF + GDN_UNITS * 16384;
constexpr size_t WS_GAF = WS_GKF + GDN_UNITS * 16384;
static_assert(WS_GAF + GDN_UNITS * 8192 <= WS_WEND, "scratch E");
constexpr size_t WS_GL = 2560 * 1024;
constexpr size_t WS_A = 244 * MiB;
constexpr int MOE_KSPLIT = 7, MOE_XROWS = (PASS_CAP1 - PASS_TILES) * 256;
constexpr size_t WS_YMX = 476 * MiB;
constexpr size_t WS_ZROW = 768 * 1024;
constexpr size_t WS_YM = 404 * MiB + 36 * MiB;
constexpr size_t WS_B = 404 * MiB;
constexpr size_t WS_NKSF = WS_B;
constexpr size_t WS_NVSF = WS_B + 4 * MiB;
constexpr size_t WS_NKWF = WS_B + 8 * MiB;
constexpr size_t WS_NVWF = WS_B + 12 * MiB;
constexpr size_t WS_CW1F = 5 * MiB, WS_CW2F = 7 * MiB, WS_CBIAS = 7 * MiB + 64 * 1024;
constexpr size_t WS_NKCF = 3 * MiB;
constexpr size_t WS_NVCF = 3 * MiB + 256 * 1024;
constexpr size_t WS_D = 468 * MiB;
constexpr size_t WS_GUF = WS_D + 16 * MiB;
constexpr size_t WS_C = 500 * MiB;
constexpr size_t WS_END = 532 * MiB;

constexpr int RING_BYTES = 131072;
constexpr int LDSCTL_OFF = 146432, MISC_OFF = LDSCTL_OFF + 320;
constexpr int LDS_BYTES = 147456;

typedef short bf16x8_t __attribute__((ext_vector_type(8)));
typedef int i32x4 __attribute__((ext_vector_type(4)));
__device__ __forceinline__ bf16x8_t pack_b(const f32x4& t0, const f32x4& t1) {
    const unsigned a = pk2(t0[0], t0[1]), b = pk2(t0[2], t0[3]), c = pk2(t1[0], t1[1]), d = pk2(t1[2], t1[3]); const v4u w = (v4u){a, b, c, d}; return __builtin_bit_cast(bf16x8_t, w);
}
__device__ __forceinline__ unsigned long long pk_fp8x8(float a0, float a1, float a2, float a3, float a4, float a5, float a6, float a7) {
    int lo = 0, hi = 0; lo = __builtin_amdgcn_cvt_pk_fp8_f32(a0, a1, lo, false); lo = __builtin_amdgcn_cvt_pk_fp8_f32(a2, a3, lo, true); hi = __builtin_amdgcn_cvt_pk_fp8_f32(a4, a5, hi, false); hi = __builtin_amdgcn_cvt_pk_fp8_f32(a6, a7, hi, true);
    return (unsigned long long)(unsigned)lo | ((unsigned long long)(unsigned)hi << 32);
}
__device__ __forceinline__ float bf2f(unsigned short b) { return __uint_as_float(((unsigned)b) << 16); }
__device__ __forceinline__ float bflo(unsigned w) { return __uint_as_float(w << 16); }
__device__ __forceinline__ float bfhi(unsigned w) { return __uint_as_float(w & 0xffff0000u); }
__device__ __forceinline__ float sigm(float x) { return __builtin_amdgcn_rcpf(1.f + __expf(-x)); }
__device__ __forceinline__ float gelu_t(float x) { const float p = fmaf(x * x, -0.102943240f, -2.302208199f); return x * __builtin_amdgcn_rcpf(1.f + __builtin_amdgcn_exp2f(x * p)); }
__device__ __forceinline__ float silu_f(float x) { return x * sigm(x); }
constexpr int DPP_X1 = 0xB1, DPP_X2 = 0x4E, DPP_ROR4 = 0x124, DPP_ROR8 = 0x128;
template <int CTRL> __device__ __forceinline__ float dppf(float v) { return __int_as_float(__builtin_amdgcn_update_dpp(0, __float_as_int(v), CTRL, 0xf, 0xf, true)); }
template <int CTRL> __device__ __forceinline__ int dppi(int v) { return __builtin_amdgcn_update_dpp(0, v, CTRL, 0xf, 0xf, true); }
__device__ __forceinline__ float x16_sum(float v) { const auto r = __builtin_amdgcn_permlane16_swap(__float_as_uint(v), __float_as_uint(v), false, false); return __uint_as_float(r[0]) + __uint_as_float(r[1]); }
__device__ __forceinline__ float x32_sum(float v) { const auto r = __builtin_amdgcn_permlane32_swap(__float_as_uint(v), __float_as_uint(v), false, false); return __uint_as_float(r[0]) + __uint_as_float(r[1]); }
__device__ __forceinline__ float x16_max(float v) { const auto r = __builtin_amdgcn_permlane16_swap(__float_as_uint(v), __float_as_uint(v), false, false); return fmaxf(__uint_as_float(r[0]), __uint_as_float(r[1])); }
__device__ __forceinline__ float x32_max(float v) { const auto r = __builtin_amdgcn_permlane32_swap(__float_as_uint(v), __float_as_uint(v), false, false); return fmaxf(__uint_as_float(r[0]), __uint_as_float(r[1])); }
__device__ __forceinline__ float row_sum(float v) { v += dppf<DPP_ROR8>(v); v += dppf<DPP_ROR4>(v); v += dppf<DPP_X2>(v); v += dppf<DPP_X1>(v); return v; }
__device__ __forceinline__ float row_max(float v) { v = fmaxf(v, dppf<DPP_ROR8>(v)); v = fmaxf(v, dppf<DPP_ROR4>(v)); v = fmaxf(v, dppf<DPP_X2>(v)); v = fmaxf(v, dppf<DPP_X1>(v)); return v; }
__device__ __forceinline__ float wave_sum(float v) { return x32_sum(x16_sum(row_sum(v))); }
__device__ __forceinline__ float wave_max(float v) { return x32_max(x16_max(row_max(v))); }

namespace pg8 {
struct EpiStore {
    static constexpr bool PERM = true, AFTER_DRAIN = false;
    bf16_t* O; int ldc; int pnmod; int act;
    __device__ __forceinline__ void operator()(const f32x4 (&acc)[2][2][4][2], const Unit& u, int wr, int wc, int fr, int fq) const {
        const int row0 = u.pm * BM + wr * 64 + fr, col0 = (u.pn % pnmod) * BM + wc * 32 + 8 * fq;
#pragma unroll
        for (int ai = 0; ai < 2; ++ai)
#pragma unroll
            for (int m = 0; m < 4; ++m) { bf16_t* rowp = O + (size_t)(row0 + ai * HALF + m * 16) * ldc + col0;
#pragma unroll
                for (int bj = 0; bj < 2; ++bj) { f32x4 v0 = acc[ai][bj][m][0], v1 = acc[ai][bj][m][1];
                    if (act == 1) {
#pragma unroll
                        for (int j = 0; j < 4; ++j) { v0[j] = sigm(v0[j]); v1[j] = sigm(v1[j]); } }
                    u32x4 w; w.x = cvt_pk_bf16(v0[0], v0[1]); w.y = cvt_pk_bf16(v0[2], v0[3]); w.z = cvt_pk_bf16(v1[0], v1[1]); w.w = cvt_pk_bf16(v1[2], v1[3]);
                    *(u32x4*)(rowp + bj * HALF) = w; } }
    }
};
struct EpiSwiGLU {
    static constexpr bool PERM = true, AFTER_DRAIN = false;
    bf16_t* O; int ldc; int npn;
    __device__ __forceinline__ void operator()(const f32x4 (&acc)[2][2][4][2], const Unit& u, int wr, int wc, int fr, int fq) const {
        const int row0 = u.pm * BM + wr * 64 + fr, col0 = (u.pn % npn) * HALF + wc * 32 + 8 * fq;
#pragma unroll
        for (int ai = 0; ai < 2; ++ai)
#pragma unroll
            for (int m = 0; m < 4; ++m) { bf16_t* rowp = O + (size_t)(row0 + ai * HALF + m * 16) * ldc + col0;
                f32x4 v0, v1;
#pragma unroll
                for (int j = 0; j < 4; ++j) { v0[j] = silu_f(acc[ai][0][m][0][j]) * acc[ai][1][m][0][j]; v1[j] = silu_f(acc[ai][0][m][1][j]) * acc[ai][1][m][1][j]; }
                u32x4 w; w.x = cvt_pk_bf16(v0[0], v0[1]); w.y = cvt_pk_bf16(v0[2], v0[3]); w.z = cvt_pk_bf16(v1[0], v1[1]); w.w = cvt_pk_bf16(v1[2], v1[3]);
                *(u32x4*)rowp = w; }
    }
};
struct EpiResid {
    static constexpr bool PERM = false, AFTER_DRAIN = false;
    const float* base; float* out; int ldc;
    __device__ __forceinline__ void operator()(const f32x4 (&acc)[2][2][4][2], const Unit& u, int wr, int wc, int fr, int fq) const {
        const int row0 = u.pm * BM + wr * 64 + fr, col0 = u.pn * BM + wc * 32 + 4 * fq;
#pragma unroll
        for (int ai = 0; ai < 2; ++ai) { f32x4 bv[4][2][2];
#pragma unroll
            for (int m = 0; m < 4; ++m)
#pragma unroll
                for (int bj = 0; bj < 2; ++bj)
#pragma unroll
                    for (int n = 0; n < 2; ++n) bv[m][bj][n] = *(const f32x4*)(base + (size_t)(row0 + ai * HALF + m * 16) * ldc + col0 + bj * HALF + n * 16);
            __builtin_amdgcn_sched_barrier(0);
#pragma unroll
            for (int m = 0; m < 4; ++m) { const size_t off = (size_t)(row0 + ai * HALF + m * 16) * ldc + col0;
#pragma unroll
                for (int bj = 0; bj < 2; ++bj)
#pragma unroll
                    for (int n = 0; n < 2; ++n) { const size_t o = off + bj * HALF + n * 16; *(f32x4*)(out + o) = bv[m][bj][n] + acc[ai][bj][m][n]; } }
            __builtin_amdgcn_sched_barrier(0); }
    }
};
struct EpiGLU {
    static constexpr bool PERM = true, AFTER_DRAIN = false;
    const bf16_t* ypre; bf16_t* O;
    __device__ __forceinline__ void operator()(const f32x4 (&acc)[2][2][4][2], const Unit& u, int wr, int wc, int fr, int fq) const {
        const int row0 = u.pm * BM + wr * 64 + fr, col0 = u.pn * BM + wc * 32 + 8 * fq;
        u32x4 yv[2][4][2];
#pragma unroll
        for (int ai = 0; ai < 2; ++ai)
#pragma unroll
            for (int m = 0; m < 4; ++m)
#pragma unroll
                for (int bj = 0; bj < 2; ++bj) yv[ai][m][bj] = *(const u32x4*)(ypre + (size_t)(row0 + ai * HALF + m * 16) * 512 + col0 + bj * HALF);
        __builtin_amdgcn_sched_barrier(0);
#pragma unroll
        for (int ai = 0; ai < 2; ++ai)
#pragma unroll
            for (int m = 0; m < 4; ++m) { const size_t off = (size_t)(row0 + ai * HALF + m * 16) * 512 + col0;
#pragma unroll
                for (int bj = 0; bj < 2; ++bj) { const u32x4 y = yv[ai][m][bj]; const f32x4 a0 = acc[ai][bj][m][0], a1 = acc[ai][bj][m][1];
                    u32x4 w; w.x = cvt_pk_bf16(bflo(y.x) * sigm(a0[0]), bfhi(y.x) * sigm(a0[1])); w.y = cvt_pk_bf16(bflo(y.y) * sigm(a0[2]), bfhi(y.y) * sigm(a0[3]));
                    w.z = cvt_pk_bf16(bflo(y.z) * sigm(a1[0]), bfhi(y.z) * sigm(a1[1])); w.w = cvt_pk_bf16(bflo(y.w) * sigm(a1[2]), bfhi(y.w) * sigm(a1[3]));
                    *(u32x4*)(O + off + bj * HALF) = w; } }
    }
};
struct EpiMerge {
    static constexpr bool PERM = true, AFTER_DRAIN = false;
    const bf16_t* gate; bf16_t* O; int abl;
    __device__ __forceinline__ void operator()(const f32x4 (&acc)[2][2][4][2], const Unit& u, int wr, int wc, int fr, int fq) const {
        const int b = u.pm >> 6, pm = u.pm & 63, pn = u.pn & 3;
        const int row0 = pm * BM + wr * 64 + fr, col0 = pn * BM + wc * 32 + 8 * fq;
        if (b > 0) { __builtin_amdgcn_fence(__ATOMIC_ACQUIRE, "agent"); asm volatile("s_waitcnt vmcnt(0)" ::: "memory"); }
#pragma unroll
        for (int ai = 0; ai < 2; ++ai)
#pragma unroll
            for (int m = 0; m < 4; ++m) { const int row = row0 + ai * HALF + m * 16;
#pragma unroll
                for (int bj = 0; bj < 2; ++bj) { const int c = col0 + bj * HALF;
                    const u32x4 g = *(const u32x4*)(gate + (size_t)row * NGATE + b * 1024 + c); f32x4 a0 = acc[ai][bj][m][0], a1 = acc[ai][bj][m][1];
                    if ((abl >> b) & 1) { a0 = (f32x4){0.f, 0.f, 0.f, 0.f}; a1 = a0; }
                    float v[8] = {bflo(g.x) * a0[0], bfhi(g.x) * a0[1], bflo(g.y) * a0[2], bfhi(g.y) * a0[3], bflo(g.z) * a1[0], bfhi(g.z) * a1[1], bflo(g.w) * a1[2], bfhi(g.w) * a1[3]};
                    bf16_t* op = O + (size_t)row * 1024 + c;
                    if (b > 0) { const u32x4 p = *(const u32x4*)op; v[0] += bflo(p.x); v[1] += bfhi(p.x); v[2] += bflo(p.y); v[3] += bfhi(p.y); v[4] += bflo(p.z); v[5] += bfhi(p.z); v[6] += bflo(p.w); v[7] += bfhi(p.w); }
                    u32x4 w; w.x = cvt_pk_bf16(v[0], v[1]); w.y = cvt_pk_bf16(v[2], v[3]); w.z = cvt_pk_bf16(v[4], v[5]); w.w = cvt_pk_bf16(v[6], v[7]);
                    *(u32x4*)op = w; } }
    }
};
struct EpiGateRatio {
    static constexpr bool PERM = true, AFTER_DRAIN = false;
    bf16_t* O;
    __device__ __forceinline__ void operator()(const f32x4 (&acc)[2][2][4][2], const Unit& u, int wr, int wc, int fr, int fq) const {
        const int row0 = u.pm * BM + wr * 64 + fr, c0 = u.pn * 64 + 16 * wc + 4 * fq;
#pragma unroll
        for (int ai = 0; ai < 2; ++ai)
#pragma unroll
            for (int m = 0; m < 4; ++m) { bf16_t* rowp = O + (size_t)(row0 + ai * HALF + m * 16) * NGATE + c0; float g[4][4];
#pragma unroll
                for (int b = 0; b < 4; ++b)
#pragma unroll
                    for (int j = 0; j < 4; ++j) g[b][j] = fmaxf(sigm(acc[ai][b >> 1][m][b & 1][j]), 1e-20f);
#pragma unroll
                for (int b = 0; b < 4; ++b) { float r[4];
#pragma unroll
                    for (int j = 0; j < 4; ++j) r[j] = (b < 3) ? g[b][j] * __builtin_amdgcn_rcpf(g[b + 1 < 4 ? b + 1 : 3][j]) : g[3][j];
                    *(unsigned long long*)(rowp + b * 1024) = (unsigned long long)cvt_pk_bf16(r[0], r[1]) | ((unsigned long long)cvt_pk_bf16(r[2], r[3]) << 32); } }
    }
};
struct EpiMergeAcc {
    static constexpr bool PERM = true, AFTER_DRAIN = false, KEEP_ACC = true;
    const bf16_t* ratio; bf16_t* O;
    __device__ __forceinline__ void operator()(const f32x4 (&)[2][2][4][2], const Unit&, int, int, int, int) const {}
    __device__ __forceinline__ void keep(f32x4 (&acc)[2][2][4][2], const Unit& u, int wr, int wc, int fr, int fq) const {
        const int b = u.pm >> 6, pm = u.pm & 63, pn = u.pn & 3;
        const int row0 = pm * BM + wr * 64 + fr, col0 = pn * BM + wc * 32 + 8 * fq;
        u32x4 gr[2][4][2];
#pragma unroll
        for (int ai = 0; ai < 2; ++ai)
#pragma unroll
            for (int m = 0; m < 4; ++m)
#pragma unroll
                for (int bj = 0; bj < 2; ++bj) gr[ai][m][bj] = *(const u32x4*)(ratio + (size_t)(row0 + ai * HALF + m * 16) * NGATE + b * 1024 + col0 + bj * HALF);
        __builtin_amdgcn_sched_barrier(0);
#pragma unroll
        for (int ai = 0; ai < 2; ++ai)
#pragma unroll
            for (int m = 0; m < 4; ++m) { const int row = row0 + ai * HALF + m * 16;
#pragma unroll
                for (int bj = 0; bj < 2; ++bj) { const int c = col0 + bj * HALF;
                    const u32x4 g = gr[ai][m][bj];
                    f32x4 a0 = acc[ai][bj][m][0], a1 = acc[ai][bj][m][1];
                    a0[0] *= bflo(g.x); a0[1] *= bfhi(g.x); a0[2] *= bflo(g.y); a0[3] *= bfhi(g.y); a1[0] *= bflo(g.z); a1[1] *= bfhi(g.z); a1[2] *= bflo(g.w); a1[3] *= bfhi(g.w);
                    if (b == 3) { u32x4 w; w.x = cvt_pk_bf16(a0[0], a0[1]); w.y = cvt_pk_bf16(a0[2], a0[3]); w.z = cvt_pk_bf16(a1[0], a1[1]); w.w = cvt_pk_bf16(a1[2], a1[3]);
                        *(u32x4*)(O + (size_t)row * 1024 + c) = w; a0 = (f32x4){0.f, 0.f, 0.f, 0.f}; a1 = a0; }
                    acc[ai][bj][m][0] = a0; acc[ai][bj][m][1] = a1; } }
    }
};
struct MergeOrder {
    StaticOrder so;
    __device__ void init(int G_, int c_) { so.init(T, 1024, G_, c_); }
    __device__ bool next(int i, Unit& u) const { Unit t; if (!so.next(i >> 2, t)) return false; const int b = i & 3; u.pm = b * 64 + t.pm; u.pn = b * 4 + t.pn; return true; }
    __device__ __forceinline__ void a_ready(const Unit&) const {}
    __device__ __forceinline__ void done(const Unit&) const {}
};
struct MoeOrder {
    int ntp, tile0, ncol, G, c; int tb1, tb2, tb3, tb4, tb5, tb6, tb7;
    const int* rowtok = nullptr; int cn0 = 0, cn1 = 0, cn2 = 0, cn3 = 0, cn4 = 0, cn5 = 0, cn6 = 0, cn7 = 0; unsigned hoff = 0, zoff = 0;
    __device__ __forceinline__ unsigned aoff(const Unit& u, int r) const {
        const int ti = tile0 + u.pm; const int e = (ti >= tb1) + (ti >= tb2) + (ti >= tb3) + (ti >= tb4) + (ti >= tb5) + (ti >= tb6) + (ti >= tb7);
        const int tbe = e == 0 ? 0 : e == 1 ? tb1 : e == 2 ? tb2 : e == 3 ? tb3 : e == 4 ? tb4 : e == 5 ? tb5 : e == 6 ? tb6 : tb7;
        const int ce = e == 0 ? cn0 : e == 1 ? cn1 : e == 2 ? cn2 : e == 3 ? cn3 : e == 4 ? cn4 : e == 5 ? cn5 : e == 6 ? cn6 : cn7;
        const int rin = (ti - tbe) * 256 + r; const bool valid = rin < ce; const int tok = rowtok[(size_t)e * T + (valid ? rin : 0)];
        return valid ? hoff + (unsigned)tok * (unsigned)(DM * 2) : zoff; }
    __device__ bool next(int i, Unit& u) const {
        const int L = i * G + c; if (L >= ntp * ncol) return false;
        const int pn = L / ntp, tl = L - pn * ntp, ti = tile0 + tl;
        const int e = (ti >= tb1) + (ti >= tb2) + (ti >= tb3) + (ti >= tb4) + (ti >= tb5) + (ti >= tb6) + (ti >= tb7);
        u.pm = tl; u.pn = e * ncol + pn; return true;
    }
    __device__ __forceinline__ void a_ready(const Unit&) const {}
    __device__ __forceinline__ void done(const Unit&) const {}
};
struct MoeSplitOrder {
    int nex, tile0, G, c; int tb1, tb2, tb3, tb4, tb5, tb6, tb7;
    __device__ bool next(int i, Unit& u) const {
        const int L = i * G + c; if (L >= nex * 4 * MOE_KSPLIT) return false;
        const int kp = L % MOE_KSPLIT, rest = L / MOE_KSPLIT, pn4 = rest & 3, tl = PASS_TILES + (rest >> 2), ti = tile0 + tl;
        const int e = (ti >= tb1) + (ti >= tb2) + (ti >= tb3) + (ti >= tb4) + (ti >= tb5) + (ti >= tb6) + (ti >= tb7);
        u.pm = tl; u.pn = e * 4 + pn4; u.ko = kp * (FFE / MOE_KSPLIT); return true;
    }
    __device__ __forceinline__ void a_ready(const Unit&) const {}
    __device__ __forceinline__ void done(const Unit&) const {}
};
struct EpiPartF32 {
    static constexpr bool PERM = false, AFTER_DRAIN = false;
    float* O;
    __device__ __forceinline__ void operator()(const f32x4 (&acc)[2][2][4][2], const Unit& u, int wr, int wc, int fr, int fq) const {
        const int kp = u.ko / (FFE / MOE_KSPLIT); const int row0 = (u.pm - PASS_TILES) * BM + wr * 64 + fr, col0 = (u.pn & 3) * BM + wc * 32 + 4 * fq;
        float* base = O + (size_t)kp * MOE_XROWS * 1024;
#pragma unroll
        for (int ai = 0; ai < 2; ++ai)
#pragma unroll
            for (int m = 0; m < 4; ++m) { const size_t off = (size_t)(row0 + ai * HALF + m * 16) * 1024 + col0;
#pragma unroll
                for (int bj = 0; bj < 2; ++bj)
#pragma unroll
                    for (int n = 0; n < 2; ++n) *(f32x4*)(base + off + bj * HALF + n * 16) = acc[ai][bj][m][n]; }
    }
};
}

struct Args { const void* in[42]; float* out; unsigned char* ws; int ph_lo, ph_hi; };
__device__ __forceinline__ const void* inptr(const Args& a, int i) { asm volatile("" : "+s"(i)); return a.in[i]; }
__device__ __forceinline__ bool in_rng(int lo, int hi, int k) { asm volatile("" : "+s"(lo), "+s"(hi)); return lo <= k && k < hi; }
struct Frame {
    LAS unsigned char* lds;
    volatile LAS unsigned* MISC;
    gu32* ctl;
    int tid, lane, wave, vcu, G, gw, NGW;
};

__device__ __forceinline__ Frame relaunder_unused(const Frame& F) { Frame R = F; asm volatile("" : "+v"(R.tid), "+v"(R.lane), "+s"(R.wave), "+s"(R.vcu), "+s"(R.gw)); return R; }
__device__ __forceinline__ void tr_item(const float* W, int ldw, int K, bf16* WT, int k0, int n0, int drow0, LAS float* scr, int lane, bool gperm = false, int cl0 = 0) {
#pragma unroll 8
    for (int i = 0; i < 32; ++i) { const int kk = 2 * i + (lane >> 5); scr[kk * 33 + (lane & 31)] = W[(size_t)(k0 + kk) * ldw + n0 + (lane & 31)]; }
    LDS_WAIT(); asm volatile("" ::: "memory");
    const int c = lane & 7;
#pragma unroll
    for (int j = 0; j < 4; ++j) { const int n = (lane >> 3) + 8 * j; const LAS float* s = scr + (8 * c) * 33 + n;
        v4u o; o.x = pk2(s[0 * 33], s[1 * 33]); o.y = pk2(s[2 * 33], s[3 * 33]); o.z = pk2(s[4 * 33], s[5 * 33]); o.w = pk2(s[6 * 33], s[7 * 33]);
        const int cl = cl0 + n; const int dr = gperm ? drow0 + 32 * (cl >> 4) + 8 * ((cl >> 2) & 3) + (cl & 3) : drow0 + n;
        *(GAS v4u*)(WT + (size_t)dr * K + k0 + 8 * c) = o; }
    LDS_WAIT(); asm volatile("" ::: "memory");
}
__device__ __forceinline__ void tr_job(Frame& F, const float* W, int ldw, int K, int ncols, bf16* WT, int mode, int& base, LAS float* scr) {
    const int nblk = ncols / 32, nit = (K / 64) * nblk;
    int first = (F.gw - base) % F.NGW; if (first < 0) first += F.NGW;
    for (int it = first; it < nit; it += F.NGW) { const int kb = it / nblk, nb = it - kb * nblk, n0 = 32 * nb;
        if (mode == 3) { const int b = n0 >> 10, cc = n0 & 1023;
            tr_item(W, ldw, K, WT, 64 * kb, n0, 256 * (cc >> 6) + 128 * (b >> 1) + 4 * (b & 1), scr, F.lane, true, cc & 63); }
        else { const int drow = mode == 0 ? n0 : (256 * (n0 >> 7) + (n0 & 127) + (mode == 2 ? 128 : 0));
        tr_item(W, ldw, K, WT, 64 * kb, n0, drow, scr, F.lane); } }
    base = (base + nit) % F.NGW;
}

__device__ __forceinline__ void p_compress_weights(Frame& F, const Args& a) {
    unsigned char* ws = a.ws;
    for (int lk = 0; lk < 4; ++lk) { const int l = lk >> 1, kv = lk & 1;
        const float* w1 = (const float*)inptr(a, kv ? 23 : 20) + (size_t)l * 2048 * 128; const float* w2 = (const float*)inptr(a, kv ? 24 : 21) + (size_t)l * 128 * 64; const float* pe = (const float*)inptr(a, kv ? 22 : 19) + (size_t)l * 2048;
        v4u* w1f = (v4u*)(ws + WS_CW1F + (size_t)lk * 512 * 1024); v4u* w2f = (v4u*)(ws + WS_CW2F + (size_t)lk * 16384); float* bias = (float*)(ws + WS_CBIAS) + lk * 128;
        for (int i = F.gw * 64 + F.lane; i < 64 * 8 * 64; i += F.NGW * 64) { const int lane = i & 63, nt = (i >> 6) & 7, ks = i >> 9; const int n = 16 * nt + (lane & 15), k0 = 32 * ks + 8 * (lane >> 4);
            v4u o; o.x = pk2(w1[(size_t)(k0 + 0) * 128 + n], w1[(size_t)(k0 + 1) * 128 + n]); o.y = pk2(w1[(size_t)(k0 + 2) * 128 + n], w1[(size_t)(k0 + 3) * 128 + n]);
            o.z = pk2(w1[(size_t)(k0 + 4) * 128 + n], w1[(size_t)(k0 + 5) * 128 + n]); o.w = pk2(w1[(size_t)(k0 + 6) * 128 + n], w1[(size_t)(k0 + 7) * 128 + n]); w1f[i] = o; }
        for (int i = F.gw * 64 + F.lane; i < 4 * 4 * 64; i += F.NGW * 64) { const int lane = i & 63, m = (i >> 6) & 3, ks2 = i >> 8; const int d = 16 * m + (lane & 15), lh = lane >> 4; float v[8];
#pragma unroll
            for (int j = 0; j < 8; ++j) v[j] = w2[(size_t)(32 * ks2 + 16 * (j >> 2) + 4 * lh + (j & 3)) * 64 + d];
            v4u o; o.x = pk2(v[0], v[1]); o.y = pk2(v[2], v[3]); o.z = pk2(v[4], v[5]); o.w = pk2(v[6], v[7]); w2f[i] = o; }
        for (int n = F.gw; n < 128; n += F.NGW) { float sacc = 0.f; for (int k = F.lane; k < 2048; k += 64) sacc += pe[k] * w1[(size_t)k * 128 + n]; sacc = wave_sum(sacc); if (F.lane == 0) bias[n] = sacc; }
    }
}
__device__ __forceinline__ void p_prologue(Frame& F, const Args& a) {
    LAS float* scr = (LAS float*)(F.lds + F.wave * 16384);
    unsigned char* ws = a.ws; int base = 0;
#if NANFILL
    { const v4u qn = (v4u){0x7FC07FC0u, 0x7FC07FC0u, 0x7FC07FC0u, 0x7FC07FC0u};
      const size_t lo_[6] = {WS_A, WS_B, WS_C, WS_D, WS_MDN, WS_ROWTOK}, hi_[6] = {WS_B, WS_D, WS_END, WS_C, WS_WEND, 5 * MiB};
#pragma unroll
      for (int r = 0; r < 6; ++r) if ((NANFILL >> r) & 1) { v4u* p = (v4u*)(ws + lo_[r]); const size_t n = (hi_[r] - lo_[r]) / 16;
          for (size_t i = (size_t)F.gw * 64 + F.lane; i < n; i += (size_t)F.NGW * 64) p[i] = qn; } }
#endif
    for (int l = 0; l < 2; ++l) {
        unsigned char* wl = ws + WS_WL + (size_t)l * W_LAYER;
        const float* w_in = (const float*)inptr(a, 5) + (size_t)l * DM * IN_COLS;
        tr_job(F, w_in, IN_COLS, DM, NMIX, (bf16*)(wl + W_IN1), 0, base, scr);
        tr_job(F, w_in + NMIX, IN_COLS, DM, NGATE, (bf16*)(wl + W_IN2), 3, base, scr);
        tr_job(F, (const float*)inptr(a, 14) + (size_t)l * 512 * 512, 512, 512, 512, (bf16*)(wl + W_GLU), 0, base, scr);
        for (int b = 0; b < 4; ++b) tr_job(F, (const float*)inptr(a, 30 + b) + (size_t)l * 512 * 1024, 1024, 512, 1024, (bf16*)(wl + W_BR) + (size_t)b * 1024 * 512, 0, base, scr);
        tr_job(F, (const float*)inptr(a, 34) + (size_t)l * DM * DM, DM, DM, DM, (bf16*)(wl + W_OUT), 0, base, scr);
        { v4u* z = (v4u*)((bf16*)(wl + W_IN1) + (size_t)NMIX * DM); const int n16 = (PMW - NMIX) * DM * 2 / 16;
          for (int i = F.gw * 64 + F.lane; i < n16; i += F.NGW * 64) z[i] = (v4u){0u, 0u, 0u, 0u}; }
    }
    p_compress_weights(F, a);
    tr_job(F, (const float*)inptr(a, 35), FFD, DM, FFD, (bf16*)(ws + WS_FUP), 1, base, scr);
    tr_job(F, (const float*)inptr(a, 36), FFD, DM, FFD, (bf16*)(ws + WS_FUP), 2, base, scr);
    tr_job(F, (const float*)inptr(a, 37), DM, FFD, DM, (bf16*)(ws + WS_FDN), 0, base, scr);
    for (int e = 0; e < NEXP; ++e) {
        tr_job(F, (const float*)inptr(a, 39) + (size_t)e * DM * FFE, FFE, DM, FFE, (bf16*)(ws + WS_MUP) + (size_t)e * 2 * FFE * DM, 1, base, scr);
        tr_job(F, (const float*)inptr(a, 40) + (size_t)e * DM * FFE, FFE, DM, FFE, (bf16*)(ws + WS_MUP) + (size_t)e * 2 * FFE * DM, 2, base, scr);
    }
}
__device__ __forceinline__ void p_conv_moe_down(Frame& F, const Args& a) {
    LAS float* scr = (LAS float*)(F.lds + F.wave * 16384); int base = 0;
    for (int e = 0; e < NEXP; ++e) tr_job(F, (const float*)inptr(a, 41) + (size_t)e * FFE * DM, DM, FFE, DM, (bf16*)(a.ws + WS_MDN) + (size_t)e * DM * FFE, 0, base, scr);
}

template <bool ROUTER, bool INPLACE_F32>
__device__ __forceinline__ void p_norm(Frame& F, const float* xin, const float* gain, bf16* hout, float* fout, const float* router, const Args& a) {
    const f32x4 g0 = ((const f32x4*)gain)[F.lane], g1 = ((const f32x4*)gain)[F.lane + 64], g2 = ((const f32x4*)gain)[F.lane + 128], g3 = ((const f32x4*)gain)[F.lane + 192];
    LAS unsigned* lcnt = (LAS unsigned*)F.lds; LAS unsigned* gbase = (LAS unsigned*)(F.lds + 64); LAS int* stash = (LAS int*)(F.lds + 1024 + F.wave * 256);
    int nstash = 0;
    if (ROUTER) { if (F.tid < 8) lcnt[F.tid] = 0u; __syncthreads(); }
    const int KT = (T + F.NGW - 1) / F.NGW;
    for (int kk = 0; kk < KT; ++kk) { const int m = F.gw + kk * F.NGW;
      if (m < T) {
        const f32x4* xr = (const f32x4*)(xin + (size_t)m * DM) + F.lane;
        f32x4 v[4]; float s = 0.f;
#pragma unroll
        for (int j = 0; j < 4; ++j) { v[j] = xr[64 * j]; s += (v[j].x * v[j].x + v[j].y * v[j].y) + (v[j].z * v[j].z + v[j].w * v[j].w); }
        const float rstd = 1.0f / sqrtf(wave_sum(s) * (1.f / DM) + RMS_EPS);
        v[0] = v[0] * rstd * g0; v[1] = v[1] * rstd * g1; v[2] = v[2] * rstd * g2; v[3] = v[3] * rstd * g3;
        if (INPLACE_F32) {
            if ((m & (SEQ - 1)) >= MASK_T0 && (m & (SEQ - 1)) < MASK_T1) { v[0] = (f32x4){0.f, 0.f, 0.f, 0.f}; v[1] = v[0]; v[2] = v[0]; v[3] = v[0]; }
            f32x4* o = (f32x4*)(fout + (size_t)m * DM) + F.lane;
#pragma unroll
            for (int j = 0; j < 4; ++j) o[64 * j] = v[j];
        } else {
            unsigned long long* o8 = (unsigned long long*)(hout + (size_t)m * DM) + F.lane;
#pragma unroll
            for (int j = 0; j < 4; ++j) o8[64 * j] = (unsigned long long)pk2(v[j].x, v[j].y) | ((unsigned long long)pk2(v[j].z, v[j].w) << 32);
        }
        if (ROUTER) {
            float lg[8];
#pragma unroll
            for (int e = 0; e < 8; ++e) lg[e] = 0.f;
#pragma unroll
            for (int j = 0; j < 4; ++j)
#pragma unroll
                for (int i = 0; i < 4; ++i) { const int c = 4 * (F.lane + 64 * j) + i; const f32x4 r0 = *(const f32x4*)(router + (size_t)c * 8), r1 = *(const f32x4*)(router + (size_t)c * 8 + 4); const float hv = v[j][i];
                    lg[0] += hv * r0.x; lg[1] += hv * r0.y; lg[2] += hv * r0.z; lg[3] += hv * r0.w; lg[4] += hv * r1.x; lg[5] += hv * r1.y; lg[6] += hv * r1.z; lg[7] += hv * r1.w; }
#pragma unroll
            for (int e = 0; e < 8; ++e) lg[e] = wave_sum(lg[e]);
            if (F.lane == 0) {
                int i1 = 0; float v1 = lg[0];
#pragma unroll
                for (int e = 1; e < 8; ++e) if (lg[e] > v1) { v1 = lg[e]; i1 = e; }
                int i2 = -1; float v2 = -3.0e38f;
#pragma unroll
                for (int e = 0; e < 8; ++e) if (e != i1 && lg[e] > v2) { v2 = lg[e]; i2 = e; }
                const float e2 = __expf(v2 - v1), w1 = 1.f / (1.f + e2), w2 = e2 / (1.f + e2);
                stash[4 * nstash] = i1 | (i2 << 8); stash[4 * nstash + 1] = m; stash[4 * nstash + 2] = __float_as_int(w1); stash[4 * nstash + 3] = __float_as_int(w2);
            }
            ++nstash; } }
        if (ROUTER) {
            if ((kk & 7) == 7 || kk == KT - 1) {
                LDS_WAIT(); asm volatile("" ::: "memory");
                const bool act = F.lane < 2 * nstash; const int st = F.lane >> 1, sk = F.lane & 1; int me = -1, mtok = 0; float mw = 0.f;
                if (act) { const int pk = stash[4 * st]; me = sk ? (pk >> 8) : (pk & 255); mtok = stash[4 * st + 1]; mw = __int_as_float(stash[4 * st + 2 + sk]); }
                int rank = 0; unsigned woff = 0u;
#pragma unroll
                for (int e = 0; e < 8; ++e) { const unsigned long long mask = __ballot(me == e);
                    if (mask != 0ull) { const int leader = __builtin_ctzll(mask); unsigned wo = 0u;
                        if (F.lane == leader) wo = __hip_atomic_fetch_add(lcnt + e, (unsigned)__builtin_popcountll(mask), __ATOMIC_RELAXED, __HIP_MEMORY_SCOPE_WORKGROUP);
                        wo = (unsigned)__builtin_amdgcn_readlane((int)wo, leader);
                        if (me == e) { rank = __builtin_popcountll(mask & ((1ull << F.lane) - 1ull)); woff = wo; } } }
                __syncthreads();
                if (F.tid < 8) { const unsigned n = lcnt[F.tid]; gbase[F.tid] = n ? __hip_atomic_fetch_add((unsigned*)(F.ctl + CW_CNT + 64 * F.tid), n, RLX_AGENT) : 0u; }
                __syncthreads();
                if (act) { int* rowtok = (int*)(a.ws + WS_ROWTOK); int* tokinfo = (int*)(a.ws + WS_TOKINFO); float* tokw = (float*)(a.ws + WS_TOKW);
                    const unsigned slot = gbase[me] + woff + (unsigned)rank;
                    rowtok[(size_t)me * T + slot] = mtok; tokinfo[2 * mtok + sk] = (me << 16) | (int)slot; tokw[2 * mtok + sk] = mw; }
                __syncthreads();
                if (F.tid < 8) lcnt[F.tid] = 0u;
                __syncthreads();
                nstash = 0; }
        }
    }
}

struct MoeTiles { int cnt[8]; int tb[9]; };
__device__ __forceinline__ void moe_tiles(Frame& F, MoeTiles& mt) {
    int run = 0;
#pragma unroll
    for (int e = 0; e < 8; ++e) { const int c = (int)__hip_atomic_load((unsigned*)(F.ctl + CW_CNT + 64 * e), RLX_AGENT); mt.cnt[e] = c; mt.tb[e] = run; run += (c + 255) >> 8; }
    mt.tb[8] = run;
}
__device__ __forceinline__ int moe_expert_of(const MoeTiles& mt, int ti) {
    int e = 0;
#pragma unroll
    for (int k = 1; k < 8; ++k) e += (ti >= mt.tb[k]);
    return e;
}
__device__ __forceinline__ void p_moe_gather(Frame& F, const Args& a, const MoeTiles& mt, int pass) {
    const int tile0 = pass * PASS_TILES; int ntp = mt.tb[8] - tile0; ntp = ntp < 0 ? 0 : (ntp > pass_cap(pass) ? pass_cap(pass) : ntp);
    const bf16* H = (const bf16*)(a.ws + WS_C); bf16* HG = (bf16*)(a.ws + WS_B); const int* rowtok = (const int*)(a.ws + WS_ROWTOK);
    for (int r = F.gw; r < ntp * 256; r += F.NGW) {
        const int ti = tile0 + (r >> 8); const int e = moe_expert_of(mt, ti);
        int tbe = 0, ce = 0;
#pragma unroll
        for (int k = 0; k < 8; ++k) { tbe = (k == e) ? mt.tb[k] : tbe; ce = (k == e) ? mt.cnt[k] : ce; }
        const int rin = (ti - tbe) * 256 + (r & 255);
        v4u x0 = (v4u){0u, 0u, 0u, 0u}, x1 = x0;
        if (rin < ce) { const int tok = rowtok[e * T + rin]; const v4u* src = (const v4u*)(H + (size_t)tok * DM); x0 = src[F.lane]; x1 = src[F.lane + 64]; }
        v4u* dst = (v4u*)(HG + (size_t)r * DM); dst[F.lane] = x0; dst[F.lane + 64] = x1;
    }
}
template <bool FINAL>
__device__ __forceinline__ void p_moe_combine(Frame& F, const Args& a, const MoeTiles& mt, int pass) {
    const int tile0 = pass * PASS_TILES;
    const int* tokinfo = (const int*)(a.ws + WS_TOKINFO); const float* tokw = (const float*)(a.ws + WS_TOKW); const bf16* YM = (const bf16*)(a.ws + WS_YM);
    int infA[2][2]; float wA[2][2];
#pragma unroll
    for (int t = 0; t < 2; ++t) { const int m = F.gw + t * F.NGW; const int mc = m < T ? m : 0; infA[t][0] = tokinfo[2 * mc]; infA[t][1] = tokinfo[2 * mc + 1]; wA[t][0] = tokw[2 * mc]; wA[t][1] = tokw[2 * mc + 1]; }
    for (int m0 = F.gw; m0 < T; m0 += 2 * F.NGW) {
        int inf[2][2]; float wv[2][2];
#pragma unroll
        for (int t = 0; t < 2; ++t) { inf[t][0] = infA[t][0]; inf[t][1] = infA[t][1]; wv[t][0] = wA[t][0]; wv[t][1] = wA[t][1]; }
#pragma unroll
        for (int t = 0; t < 2; ++t) { const int m = m0 + (2 + t) * F.NGW; const int mc = m < T ? m : 0; infA[t][0] = tokinfo[2 * mc]; infA[t][1] = tokinfo[2 * mc + 1]; wA[t][0] = tokw[2 * mc]; wA[t][1] = tokw[2 * mc + 1]; }
        bool inp[2][2], ksp[2][2], any[2]; int row[2][2]; f32x4 v[2][4]; unsigned long long ym[2][2][4];
#pragma unroll
        for (int t = 0; t < 2; ++t) { const int m = m0 + t * F.NGW; const bool tv = m < T; any[t] = FINAL && tv;
#pragma unroll
            for (int k = 0; k < 2; ++k) { const int info = inf[t][k]; const int e = info >> 16, pos = info & 0xffff; int tbe = 0;
#pragma unroll
                for (int q = 0; q < 8; ++q) tbe = (q == e) ? mt.tb[q] : tbe;
                const int ti = tbe + (pos >> 8); bool in = tv && ti >= tile0 && ti < tile0 + pass_cap(pass);
                if ((ABL & 64) && k == 1) in = false;
                if ((ABL & 128) && k == 0) in = false;
                inp[t][k] = in; ksp[t][k] = in && (ti - tile0 >= PASS_TILES); row[t][k] = (ti - tile0) * 256 + (pos & 255); any[t] = any[t] || in; } }
#pragma unroll
        for (int t = 0; t < 2; ++t) { const int m = m0 + t * F.NGW;
            if (any[t]) { const f32x4* xr = (const f32x4*)(a.out + (size_t)m * DM) + F.lane;
#pragma unroll
                for (int j = 0; j < 4; ++j) v[t][j] = xr[64 * j]; }
#pragma unroll
            for (int k = 0; k < 2; ++k) if (inp[t][k] && !ksp[t][k]) { const unsigned long long* y8 = (const unsigned long long*)(YM + (size_t)row[t][k] * DM) + F.lane;
#pragma unroll
                for (int j = 0; j < 4; ++j) ym[t][k][j] = y8[64 * j]; } }
#pragma unroll
        for (int t = 0; t < 2; ++t) { const int m = m0 + t * F.NGW; if (!any[t]) continue;
            f32x4* xr = (f32x4*)(a.out + (size_t)m * DM) + F.lane;
#pragma unroll
            for (int k = 0; k < 2; ++k) { if (!inp[t][k]) continue; const float w = wv[t][k];
                if (ksp[t][k]) {
                    const f32x4* px = (const f32x4*)((const float*)(a.ws + WS_YMX) + (size_t)(row[t][k] - PASS_TILES * 256) * DM) + F.lane;
#pragma unroll
                    for (int j = 0; j < 4; ++j) { f32x4 y = px[64 * j];
#pragma unroll
                        for (int kp = 1; kp < MOE_KSPLIT; ++kp) y = y + px[(size_t)kp * MOE_XROWS * (DM / 4) + 64 * j];
                        v[t][j] = v[t][j] + y * w; }
                } else {
#pragma unroll
                    for (int j = 0; j < 4; ++j) { const unsigned long long y = ym[t][k][j]; const unsigned lo = (unsigned)y, hi = (unsigned)(y >> 32);
                        v[t][j].x += w * bflo(lo); v[t][j].y += w * bfhi(lo); v[t][j].z += w * bflo(hi); v[t][j].w += w * bfhi(hi); } } }
            if (FINAL) { float s = 0.f;
#pragma unroll
                for (int j = 0; j < 4; ++j) s += (v[t][j].x * v[t][j].x + v[t][j].y * v[t][j].y) + (v[t][j].z * v[t][j].z + v[t][j].w * v[t][j].w);
                const float rstd = 1.0f / sqrtf(wave_sum(s) * (1.f / DM) + RMS_EPS); const f32x4* gn = (const f32x4*)inptr(a, 4) + F.lane;
#pragma unroll
                for (int j = 0; j < 4; ++j) { f32x4 o = v[t][j] * rstd * gn[64 * j];
                    if ((m & (SEQ - 1)) >= MASK_T0 && (m & (SEQ - 1)) < MASK_T1) o = (f32x4){0.f, 0.f, 0.f, 0.f};
                    xr[64 * j] = o; } }
            else {
#pragma unroll
                for (int j = 0; j < 4; ++j) xr[64 * j] = v[t][j]; } }
    }
}

struct LayerP {
    const float *a_re, *a_im, *log_dt, *b_re, *b_im, *c_re, *c_im, *ssm_d, *conv_w, *a_log, *dt_bias, *gdn_norm;
    const float *kpe, *kw1, *kw2, *vpe, *vw1, *vw2, *rel_bias, *ln_g, *ln_b, *sgu_w, *sgu_b; const int* pos;
};

__device__ __forceinline__ void mix_sgu(Frame& F, const LayerP& L, const bf16* P, bf16* Y3) {
    LAS float* stat = (LAS float*)(F.lds);
    LAS float* vn = (LAS float*)(F.lds + 1024);
    for (int item = F.vcu; item < 256; item += F.G) {
      const int ck = item >> 1, t0 = ck * 128;
      for (int gi = 0; gi < 2; ++gi) { const int gg = 2 * (item & 1) + gi;
        if (gi == 0) { v4u rawv[16];
#pragma unroll
          for (int i = 0; i < 16; ++i) rawv[i] = *(const v4u*)(P + (size_t)(t0 + F.wave * 16 + i) * PMW + C_SGU + 512 + F.lane * 8);
          __builtin_amdgcn_sched_barrier(0);
#pragma unroll
          for (int i = 0; i < 16; ++i) { const int tk = F.wave * 16 + i;
            const v4u raw = rawv[i];
            float x[8] = {gelu_t(bflo(raw.x)), gelu_t(bfhi(raw.x)), gelu_t(bflo(raw.y)), gelu_t(bfhi(raw.y)), gelu_t(bflo(raw.z)), gelu_t(bfhi(raw.z)), gelu_t(bflo(raw.w)), gelu_t(bfhi(raw.w))};
            float s = 0.f;
#pragma unroll
            for (int j = 0; j < 8; ++j) s += x[j];
            const float mu = wave_sum(s) * (1.f / 512.f); float q = 0.f;
#pragma unroll
            for (int j = 0; j < 8; ++j) { const float d = x[j] - mu; q += d * d; }
            const float rstd = 1.0f / sqrtf(wave_sum(q) * (1.f / 512.f) + RMS_EPS);
            if (F.lane == 0) { stat[2 * tk] = mu; stat[2 * tk + 1] = rstd; } } }
        __syncthreads();
        { const int j = F.tid >> 2, d0 = (F.tid & 3) * 32; const float mu = stat[2 * j], rstd = stat[2 * j + 1]; LAS bf16* vt = (LAS bf16*)vn;
#pragma unroll
          for (int q = 0; q < 4; ++q) { const v4u raw = *(const v4u*)(P + (size_t)(t0 + j) * PMW + C_SGU + 512 + gg * 128 + d0 + q * 8);
              const unsigned wv[4] = {raw.x, raw.y, raw.z, raw.w};
#pragma unroll
              for (int k = 0; k < 4; ++k) { const int d = d0 + q * 8 + 2 * k; const int ch = gg * 128 + d;
                  vt[d * 136 + j] = (bf16)f2bf((gelu_t(bflo(wv[k])) - mu) * rstd * L.ln_g[ch] + L.ln_b[ch]);
                  vt[(d + 1) * 136 + j] = (bf16)f2bf((gelu_t(bfhi(wv[k])) - mu) * rstd * L.ln_g[ch + 1] + L.ln_b[ch + 1]); } } }
        __syncthreads();
        { const int m = F.wave, lr = F.lane & 15, lh = F.lane >> 4; const int i = 16 * m + lr; const LAS bf16* vt = (const LAS bf16*)vn;
          const int nks = (16 * m + 15) / 32 + 1;
          bf16x8_t af[4];
#pragma unroll
          for (int ks = 0; ks < 4; ++ks) { const int j0 = 32 * ks + 8 * lh; const float* wr = L.sgu_w + ((size_t)gg * 128 + i) * 128 + j0; const f32x4 w0 = *(const f32x4*)wr, w1 = *(const f32x4*)(wr + 4);
              const float wv[8] = {w0.x, w0.y, w0.z, w0.w, w1.x, w1.y, w1.z, w1.w}; unsigned pw[4];
#pragma unroll
              for (int k = 0; k < 4; ++k) pw[k] = pk2((j0 + 2 * k <= i) ? wv[2 * k] : 0.f, (j0 + 2 * k + 1 <= i) ? wv[2 * k + 1] : 0.f);
              const v4u w = (v4u){pw[0], pw[1], pw[2], pw[3]}; af[ks] = __builtin_bit_cast(bf16x8_t, w); }
          unsigned long long urv[8];
#pragma unroll
          for (int n = 0; n < 8; ++n) urv[n] = *(const unsigned long long*)(P + (size_t)(t0 + 16 * m + lr) * PMW + C_SGU + gg * 128 + 16 * n + 4 * lh);
          const float bsv = L.sgu_b[gg * 128 + 16 * m + lr];
          __builtin_amdgcn_sched_barrier(0);
#pragma unroll
          for (int n = 0; n < 8; ++n) { f32x4 acc = (f32x4){0.f, 0.f, 0.f, 0.f};
#pragma unroll
              for (int ks = 0; ks < 4; ++ks) if (ks < nks) { const bf16x8_t bfr = *(const LAS bf16x8_t*)(vt + (16 * n + lr) * 136 + 32 * ks + 8 * lh); acc = __builtin_amdgcn_mfma_f32_16x16x32_bf16(bfr, af[ks], acc, 0, 0, 0); }
              { const int ii = 16 * m + lr, d = 16 * n + 4 * lh;
                const unsigned long long ur = urv[n]; const unsigned ulo = (unsigned)ur, uhi = (unsigned)(ur >> 32);
                const float y0 = gelu_t(bflo(ulo)) * (acc[0] + bsv), y1 = gelu_t(bfhi(ulo)) * (acc[1] + bsv), y2 = gelu_t(bflo(uhi)) * (acc[2] + bsv), y3 = gelu_t(bfhi(uhi)) * (acc[3] + bsv);
                *(unsigned long long*)(Y3 + (size_t)(t0 + ii) * 512 + gg * 128 + d) = (unsigned long long)pk2(y0, y1) | ((unsigned long long)pk2(y2, y3) << 32); } } }
        __syncthreads();
      }
    }
}

constexpr int SSM_SPAN = 256, SSM_NSPAN = SEQ / SSM_SPAN;
typedef short s16x4 __attribute__((ext_vector_type(4)));
typedef float f32x2v __attribute__((ext_vector_type(2)));
struct SsmLane { float abr, abi, alr, ali; s16x4 bre[4], bim[4]; };
__device__ __forceinline__ void ssm_lane_params(SsmLane& q, const LayerP& L, int g, int n) {
    const float are = L.a_re[g * 64 + n], aim = L.a_im[g * 64 + n], dt = expf(L.log_dt[g]);
    const float mag = expf(are * dt); q.abr = mag * cosf(aim * dt); q.abi = mag * sinf(aim * dt);
    const float magl = expf(are * dt * (float)SSM_SPAN), angl = aim * dt * (float)SSM_SPAN; q.alr = magl * cosf(angl); q.ali = magl * sinf(angl);
    const float nr = q.abr - 1.0f, ni = q.abi, den = are * are + aim * aim; const float sr = (nr * are + ni * aim) / den, si = (ni * are - nr * aim) / den;
    const int lr = n & 15, lh = n >> 4;
#pragma unroll
    for (int qq = 0; qq < 4; ++qq) { const int ns = 16 * qq + lr; const float srs = __shfl(sr, ns), sis = __shfl(si, ns);
        const f32x4 br = *(const f32x4*)(L.b_re + (g * 64 + ns) * 16 + 4 * lh), bi = *(const f32x4*)(L.b_im + (g * 64 + ns) * 16 + 4 * lh);
        unsigned wr[2], wi[2];
        wr[0] = pk2(srs * br[0] - sis * bi[0], srs * br[1] - sis * bi[1]); wr[1] = pk2(srs * br[2] - sis * bi[2], srs * br[3] - sis * bi[3]);
        wi[0] = pk2(srs * bi[0] + sis * br[0], srs * bi[1] + sis * br[1]); wi[1] = pk2(srs * bi[2] + sis * br[2], srs * bi[3] + sis * br[3]);
        q.bre[qq] = __builtin_bit_cast(s16x4, (unsigned long long)wr[0] | ((unsigned long long)wr[1] << 32)); q.bim[qq] = __builtin_bit_cast(s16x4, (unsigned long long)wi[0] | ((unsigned long long)wi[1] << 32)); }
}
__device__ __forceinline__ void ssm_bu16(const SsmLane& q, const LAS bf16* UT, LAS f32x2v* BU, int sb, int lr, int lh) {
    const s16x4 af = *(const LAS s16x4*)(UT + (16 * sb + lr) * 16 + 4 * lh);
#pragma unroll
    for (int qq = 0; qq < 4; ++qq) { const f32x4 z = (f32x4){0.f, 0.f, 0.f, 0.f};
        const f32x4 dr = __builtin_amdgcn_mfma_f32_16x16x16bf16_1k(af, q.bre[qq], z, 0, 0, 0), di = __builtin_amdgcn_mfma_f32_16x16x16bf16_1k(af, q.bim[qq], z, 0, 0, 0);
#pragma unroll
        for (int r = 0; r < 4; ++r) BU[(4 * lh + r) * 64 + 16 * qq + lr] = (f32x2v){dr[r], di[r]}; }
    LDS_WAIT(); asm volatile("" ::: "memory");
}
__device__ __forceinline__ void ssm_load_u(const bf16* P, size_t tok0, int g, int lane, v4u& r0, v4u& r1) { const bf16* src = P + (tok0 + lane) * PMW + C_U + g * 16; r0 = *(const v4u*)src; r1 = *(const v4u*)(src + 8); }
__device__ __forceinline__ void ssm_put_u(LAS bf16* UT, int lane, const v4u& r0, const v4u& r1) { *(LAS v4u*)(UT + lane * 16) = r0; *(LAS v4u*)(UT + lane * 16 + 8) = r1; LDS_WAIT(); asm volatile("" ::: "memory"); }
__device__ __forceinline__ void ssm_pass1(Frame& F_, const LayerP& L, const bf16* P, const Args& a, LAS unsigned char* wl, int first, int stride) {
    LAS bf16* UT = (LAS bf16*)wl; LAS f32x2v* BU = (LAS f32x2v*)(wl + 8192);
    for (int unit = first; unit < BATCH * 32 * SSM_NSPAN; unit += stride) {
        Frame F = F_; asm volatile("" : "+v"(F.lane));
        const int sp = unit % SSM_NSPAN, g = (unit / SSM_NSPAN) & 31, b = unit / (SSM_NSPAN * 32); const int lr = F.lane & 15, lh = F.lane >> 4;
        SsmLane q; ssm_lane_params(q, L, g, F.lane);
        float s_r = 0.f, s_i = 0.f; const size_t tok0 = (size_t)b * SEQ + (size_t)sp * SSM_SPAN;
        v4u r0, r1; ssm_load_u(P, tok0, g, F.lane, r0, r1);
#pragma unroll 1
        for (int blk = 0; blk < SSM_SPAN / 64; ++blk) { ssm_put_u(UT, F.lane, r0, r1);
            if (blk + 1 < SSM_SPAN / 64) ssm_load_u(P, tok0 + (blk + 1) * 64, g, F.lane, r0, r1);
#pragma unroll 1
            for (int sb = 0; sb < 4; ++sb) { ssm_bu16(q, UT, BU, sb, lr, lh);
#pragma unroll
                for (int tt = 0; tt < 16; ++tt) { const f32x2v bu = BU[tt * 64 + F.lane]; const float nsr = q.abr * s_r - q.abi * s_i + bu.x, nsi = q.abr * s_i + q.abi * s_r + bu.y; s_r = nsr; s_i = nsi; }
                LDS_WAIT(); asm volatile("" ::: "memory"); } }
        float2* E = (float2*)(a.ws + WS_SSME); E[(size_t)unit * 64 + F.lane] = make_float2(s_r, s_i);
    }
}
__device__ __forceinline__ void ssm_pass2(Frame& F_, const LayerP& L, const bf16* P, const Args& a, bf16* Ypre, LAS unsigned char* wl, int first, int stride) {
    constexpr int SP_ = 136;
    LAS bf16* UT = (LAS bf16*)wl; LAS bf16* ST = (LAS bf16*)(wl + 2048); LAS f32x2v* BU = (LAS f32x2v*)(wl + 8192);
    for (int unit = first; unit < BATCH * 32 * SSM_NSPAN; unit += stride) {
        Frame F = F_; asm volatile("" : "+v"(F.lane));
        const int sp = unit % SSM_NSPAN, g = (unit / SSM_NSPAN) & 31, b = unit / (SSM_NSPAN * 32); const int lr = F.lane & 15, lh = F.lane >> 4;
        SsmLane q; ssm_lane_params(q, L, g, F.lane);
        bf16x8_t cb[4];
#pragma unroll
        for (int ks = 0; ks < 4; ++ks) { const int kk = 32 * ks + 8 * lh; const float* cp = (kk < 64) ? L.c_re + (g * 16 + lr) * 64 + kk : L.c_im + (g * 16 + lr) * 64 + (kk - 64); const float sg = (kk < 64) ? 1.0f : -1.0f;
            const f32x4 c0 = *(const f32x4*)cp, c1 = *(const f32x4*)(cp + 4); const v4u w = (v4u){pk2(sg * c0.x, sg * c0.y), pk2(sg * c0.z, sg * c0.w), pk2(sg * c1.x, sg * c1.y), pk2(sg * c1.z, sg * c1.w)}; cb[ks] = __builtin_bit_cast(bf16x8_t, w); }
        const f32x4 dsk4 = *(const f32x4*)(L.ssm_d + g * 16 + 4 * lh);
        const size_t tok0 = (size_t)b * SEQ + (size_t)sp * SSM_SPAN;
        v4u r0, r1; ssm_load_u(P, tok0, g, F.lane, r0, r1);
        float s_r = 0.f, s_i = 0.f;
        { const float2* E = (const float2*)(a.ws + WS_SSME) + (size_t)(unit - sp) * 64 + F.lane;
#pragma unroll 4
          for (int k = 0; k < sp; ++k) { const float2 e = E[(size_t)k * 64]; const float nr = q.alr * s_r - q.ali * s_i + e.x, ni = q.alr * s_i + q.ali * s_r + e.y; s_r = nr; s_i = ni; } }
#pragma unroll 1
        for (int blk = 0; blk < SSM_SPAN / 64; ++blk) { ssm_put_u(UT, F.lane, r0, r1);
            if (blk + 1 < SSM_SPAN / 64) ssm_load_u(P, tok0 + (blk + 1) * 64, g, F.lane, r0, r1);
#pragma unroll 1
            for (int sb = 0; sb < 4; ++sb) { ssm_bu16(q, UT, BU, sb, lr, lh);
#pragma unroll
                for (int tt = 0; tt < 16; ++tt) { const f32x2v bu = BU[tt * 64 + F.lane]; const float nsr = q.abr * s_r - q.abi * s_i + bu.x, nsi = q.abr * s_i + q.abi * s_r + bu.y; s_r = nsr; s_i = nsi;
                    ST[tt * SP_ + F.lane] = (bf16)f2bf(s_r); ST[tt * SP_ + 64 + F.lane] = (bf16)f2bf(s_i); }
                LDS_WAIT(); asm volatile("" ::: "memory");
                f32x4 y = (f32x4){0.f, 0.f, 0.f, 0.f};
#pragma unroll
                for (int ks = 0; ks < 4; ++ks) { const bf16x8_t af = *(const LAS bf16x8_t*)(ST + lr * SP_ + 32 * ks + 8 * lh); y = __builtin_amdgcn_mfma_f32_16x16x32_bf16(cb[ks], af, y, 0, 0, 0); }
                { const int tk = sb * 16 + lr; const unsigned long long ur = *(const LAS unsigned long long*)(UT + tk * 16 + 4 * lh); const unsigned ulo = (unsigned)ur, uhi = (unsigned)(ur >> 32);
                  const float y0 = gelu_t(y[0] + dsk4[0] * bflo(ulo)), y1 = gelu_t(y[1] + dsk4[1] * bfhi(ulo)), y2 = gelu_t(y[2] + dsk4[2] * bflo(uhi)), y3 = gelu_t(y[3] + dsk4[3] * bfhi(uhi));
                  *(unsigned long long*)(Ypre + (tok0 + blk * 64 + tk) * 512 + g * 16 + 4 * lh) = (unsigned long long)pk2(y0, y1) | ((unsigned long long)pk2(y2, y3) << 32); }
                LDS_WAIT(); asm volatile("" ::: "memory"); } }
    }
}

__device__ __forceinline__ void nsa_compress_mfma(Frame& F_, const bf16* P, const Args& a, int layer) {
    unsigned char* ws = a.ws; LAS f32x4* PART = (LAS f32x4*)F_.lds;
    LAS f32x4* HT = (LAS f32x4*)(F_.lds + 65536);
    for (int unit = F_.vcu; unit < 2 * 2 * 2 * 32; unit += F_.G) {
        Frame F = F_; asm volatile("" : "+v"(F.lane));
        const int rt = unit & 31, g = (unit >> 5) & 1, b = (unit >> 6) & 1, kv = unit >> 7; const int lr = F.lane & 15, lh = F.lane >> 4, lk = layer * 2 + kv, bg = b * 2 + g, w = F.wave;
        const int c = 16 * rt + lr, cl = c < NCMP ? c : NCMP - 1;
        const bf16* src = P + ((size_t)b * SEQ + (size_t)16 * cl) * PMW + (kv ? C_VC : C_KC) + g * 64 + 8 * lh;
        const v4u* w1f = (const v4u*)(ws + WS_CW1F + (size_t)lk * 512 * 1024); const v4u* w2f = (const v4u*)(ws + WS_CW2F + (size_t)lk * 16384); const float* bias = (const float*)(ws + WS_CBIAS) + lk * 128;
        f32x4 acc[8];
#pragma unroll
        for (int nt = 0; nt < 8; ++nt) acc[nt] = (f32x4){0.f, 0.f, 0.f, 0.f};
#pragma unroll 2
        for (int k8 = 0; k8 < 8; ++k8) { const int ks = 8 * w + k8; const v4u bw = *(const v4u*)(src + (size_t)(ks >> 1) * PMW + (ks & 1) * 32); const bf16x8_t bfr = __builtin_bit_cast(bf16x8_t, bw);
#pragma unroll
            for (int nt = 0; nt < 8; ++nt) { const v4u aw = w1f[(ks * 8 + nt) * 64 + F.lane]; acc[nt] = __builtin_amdgcn_mfma_f32_16x16x32_bf16(__builtin_bit_cast(bf16x8_t, aw), bfr, acc[nt], 0, 0, 0); } }
#pragma unroll
        for (int nt = 0; nt < 8; ++nt) PART[(w * 8 + nt) * 64 + F.lane] = acc[nt];
        __syncthreads();
        { f32x4 sum = (f32x4){0.f, 0.f, 0.f, 0.f};
#pragma unroll
          for (int ww = 0; ww < 8; ++ww) sum = sum + PART[(ww * 8 + w) * 64 + F.lane];
          const f32x4 bv = *(const f32x4*)(bias + 16 * w + 4 * lh);
#pragma unroll
          for (int r = 0; r < 4; ++r) sum[r] = gelu_t(sum[r] + bv[r]);
          HT[w * 64 + F.lane] = sum; }
        __syncthreads();
        if (w < 4) { const int m = w; f32x4 o2 = (f32x4){0.f, 0.f, 0.f, 0.f};
#pragma unroll
            for (int ks2 = 0; ks2 < 4; ++ks2) { const f32x4 h0 = HT[(2 * ks2) * 64 + F.lane], h1 = HT[(2 * ks2 + 1) * 64 + F.lane]; const bf16x8_t hb = pack_b(h0, h1);
                const v4u aw = w2f[(ks2 * 4 + m) * 64 + F.lane]; o2 = __builtin_amdgcn_mfma_f32_16x16x32_bf16(__builtin_bit_cast(bf16x8_t, aw), hb, o2, 0, 0, 0); }
            const bool pad = (c >= NCMP);
            if (kv == 0) { bf16* kcf = (bf16*)(ws + WS_NKCF); const int ks = m >> 1, lhh = (2 * m + (lh >> 1)) & 3, j0 = 4 * (lh & 1);
                const unsigned long long pk = pad ? 0ull : ((unsigned long long)pk2(o2[0], o2[1]) | ((unsigned long long)pk2(o2[2], o2[3]) << 32));
                *(unsigned long long*)(kcf + ((size_t)((bg * 32 + rt) * 2 + ks) * 64 + lhh * 16 + lr) * 8 + j0) = pk; }
            else { bf16* vcf = (bf16*)(ws + WS_NVCF); const int pr = c >> 5, c5 = c & 31, j = 4 * (c5 >> 4) + (c5 & 3), lhh = (c5 >> 2) & 3;
#pragma unroll
                for (int r = 0; r < 4; ++r) vcf[((size_t)((bg * 16 + pr) * 4 + m) * 64 + lhh * 16 + 4 * lh + r) * 8 + j] = pad ? (bf16)0 : (bf16)f2bf(o2[r]); } }
        __syncthreads();
    }
}

__device__ __forceinline__ void mix_nsa_compress(Frame& F, const LayerP& L, const bf16* P, const Args& a, LAS float* hid, int first, int stride) {
#if NSA_NAIVE
    float* KCC = (float*)(a.ws + WS_KCC);
#endif
    for (int unit = first; unit < 2 * 2 * NCMP * 2; unit += stride) {
        const int g = unit & 1; int r = unit >> 1; const int c = r % NCMP; r /= NCMP; const int b = r & 1, kv = r >> 1;
        const float* pe = kv ? L.vpe : L.kpe; const float* w1 = kv ? L.vw1 : L.kw1; const float* w2 = kv ? L.vw2 : L.kw2;
        const bf16* src = P + (size_t)(b * SEQ + c * 16) * PMW + (kv ? C_VC : C_KC) + g * 64;
        float h0 = 0.f, h1 = 0.f;
        for (int l = 0; l < 32; ++l) {
#pragma unroll 4
            for (int d8 = 0; d8 < 8; ++d8) { const v4u raw = *(const v4u*)(src + (size_t)l * PMW + d8 * 8); const unsigned wv[4] = {raw.x, raw.y, raw.z, raw.w};
#pragma unroll
                for (int k = 0; k < 4; ++k) { const int d = d8 * 8 + 2 * k; const float x0 = bflo(wv[k]) + pe[l * 64 + d], x1 = bfhi(wv[k]) + pe[l * 64 + d + 1];
                    const float* wr0 = w1 + (size_t)(l * 64 + d) * 128; h0 += x0 * wr0[F.lane] + x1 * wr0[128 + F.lane]; h1 += x0 * wr0[64 + F.lane] + x1 * wr0[192 + F.lane]; } } }
        hid[F.lane] = gelu_t(h0); hid[64 + F.lane] = gelu_t(h1);
        LDS_WAIT(); asm volatile("" ::: "memory");
        float o = 0.f;
        for (int j = 0; j < 128; ++j) o += hid[j] * w2[j * 64 + F.lane];
#if NSA_NAIVE
        KCC[((size_t)((kv * 2 + b) * 512 + c) * 2 + g) * 64 + F.lane] = o;
#endif
        { const int bg = b * 2 + g, d = F.lane;
          for (int cc = c; cc <= (c == NCMP - 1 ? NCMP : c); ++cc) { const unsigned short val = (cc == c) ? (unsigned short)f2bf(o) : (unsigned short)0;
              if (kv == 0) { const int n = cc >> 4, lrr = cc & 15, ks = d >> 5, lhh = (d >> 3) & 3, j = d & 7; ((bf16*)(a.ws + WS_NKCF))[((size_t)((bg * 32 + n) * 2 + ks) * 64 + lhh * 16 + lrr) * 8 + j] = val; }
              else { const int pr = cc >> 5, c5 = cc & 31, j = 4 * (c5 >> 4) + (c5 & 3), lhh = (c5 >> 2) & 3, m = d >> 4, lrr = d & 15; ((bf16*)(a.ws + WS_NVCF))[((size_t)((bg * 16 + pr) * 4 + m) * 64 + lhh * 16 + lrr) * 8 + j] = val; } } }
        LDS_WAIT(); asm volatile("" ::: "memory");
    }
}

typedef short bf16x8_t __attribute__((ext_vector_type(8)));
__device__ __forceinline__ int permk(int j, int lh) { return 16 * (j >> 2) + 4 * lh + (j & 3); }
__device__ __forceinline__ void gdn_chunk_prep(Frame& F_, const LayerP& L, const bf16* P, const Args& a) {
    constexpr int KP = 136, AP = 68, TP = 72;
    Frame F = F_;
    LAS bf16* KB = (LAS bf16*)(F.lds);
    LAS bf16* QB = (LAS bf16*)(F.lds + 17408);
    LAS bf16* VB = (LAS bf16*)(F.lds + 34816);
    LAS float* AM = (LAS float*)(F.lds + 52224);
    LAS bf16* AT = (LAS bf16*)(F.lds + 69632);
    LAS float* SC = (LAS float*)(F.lds + 78848);
    LAS float* CW = (LAS float*)(F.lds + 80128);
    LAS bf16* XS = (LAS bf16*)(F.lds + 86272);
    unsigned char* ws = a.ws;
    for (int u = F_.vcu; u < (int)GDN_UNITS; u += F_.G) {
        F.tid = F_.tid; asm volatile("" : "+v"(F.tid)); F.lane = F.tid & 63;
        const int h = u & 3, cidx = (u >> 2) & 127, b = u >> 9; const int t0 = b * SEQ + cidx * 64;
        if (u == F_.vcu || (F_.G & 3)) { for (int i = F.tid; i < 4 * 384; i += NTHR) { const int j = i / 384, cc = i - j * 384; const int part = cc >> 7, ch = cc & 127; CW[i] = L.conv_w[j * 1536 + part * 512 + h * 128 + ch]; } }
        { const int i = F.tid >> 3, sub = F.tid & 7, cb = sub * 16;
          v4u raw[3][4][2];
#pragma unroll
          for (int part = 0; part < 3; ++part)
#pragma unroll
              for (int j = 0; j < 4; ++j) { const int tl = cidx * 64 + i - 3 + j; const bf16* src = P + (size_t)(b * SEQ + (tl < 0 ? 0 : tl)) * PMW + C_QKV + part * 512 + h * 128 + cb; raw[part][j][0] = *(const v4u*)src; raw[part][j][1] = *(const v4u*)(src + 8); }
          const unsigned short avr = P[((size_t)t0 + i) * PMW + C_A + h], bvr = P[((size_t)t0 + i) * PMW + C_B + h];
          __builtin_amdgcn_sched_barrier(0);
          __syncthreads();
#pragma unroll
          for (int part = 0; part < 3; ++part) {
              float acc[16];
#pragma unroll
              for (int q = 0; q < 16; ++q) acc[q] = 0.f;
#pragma unroll
              for (int j = 0; j < 4; ++j) { const int tl = cidx * 64 + i - 3 + j; if (tl >= 0) {
                      const v4u r0 = raw[part][j][0], r1 = raw[part][j][1];
                      const unsigned wv[8] = {r0.x, r0.y, r0.z, r0.w, r1.x, r1.y, r1.z, r1.w}; const LAS float* cw = CW + j * 384 + part * 128 + cb;
#pragma unroll
                      for (int q = 0; q < 8; ++q) { acc[2 * q] += cw[2 * q] * bflo(wv[q]); acc[2 * q + 1] += cw[2 * q + 1] * bfhi(wv[q]); } } }
              float ss = 0.f;
#pragma unroll
              for (int q = 0; q < 16; ++q) { acc[q] = silu_f(acc[q]); ss += acc[q] * acc[q]; }
              float sc = 1.f;
              if (part < 2) { ss += __shfl_xor(ss, 1); ss += __shfl_xor(ss, 2); ss += __shfl_xor(ss, 4); sc = (1.0f / sqrtf(ss + 1e-6f)) * (part == 0 ? 0.08838834764831845f : 1.0f); }
              v4u o0, o1; o0.x = pk2(acc[0] * sc, acc[1] * sc); o0.y = pk2(acc[2] * sc, acc[3] * sc); o0.z = pk2(acc[4] * sc, acc[5] * sc); o0.w = pk2(acc[6] * sc, acc[7] * sc);
              o1.x = pk2(acc[8] * sc, acc[9] * sc); o1.y = pk2(acc[10] * sc, acc[11] * sc); o1.z = pk2(acc[12] * sc, acc[13] * sc); o1.w = pk2(acc[14] * sc, acc[15] * sc);
              LAS bf16* dst = (part == 0 ? QB : (part == 1 ? KB : VB)) + i * KP + cb; *(LAS v4u*)dst = o0; *(LAS v4u*)(dst + 8) = o1; }
          if (sub == 0) { const float av = bf2f(avr), bv = bf2f(bvr);
              const float xx = av + L.dt_bias[h]; const float sp = xx > 20.f ? xx : log1pf(expf(xx)); SC[i] = 1.0f / (1.0f + expf(-bv)); SC[64 + i] = -expf(L.a_log[h]) * sp; } }
        __syncthreads();
        if (F.wave == 0) { float x = SC[64 + F.lane];
#pragma unroll
            for (int o = 1; o < 64; o <<= 1) { const float y = __shfl_up(x, o); if (F.lane >= o) x += y; }
            const float gl = __shfl(x, 63); SC[128 + F.lane] = x; SC[192 + F.lane] = expf(x); SC[256 + F.lane] = expf(gl - x);
            if (F.lane == 63) ((float*)(ws + WS_GL))[u] = expf(x); }
        __syncthreads();
        { const int m = F.wave & 3, isq = F.wave >> 2, lr = F.lane & 15, lh = F.lane >> 4; const LAS bf16* SRC = isq ? QB : KB;
          bf16x8_t af[4];
#pragma unroll
          for (int ks = 0; ks < 4; ++ks) af[ks] = *(const LAS bf16x8_t*)(SRC + (16 * m + lr) * KP + 32 * ks + 8 * lh);
#pragma unroll
          for (int n = 0; n < 4; ++n) { f32x4 acc = (f32x4){0.f, 0.f, 0.f, 0.f};
#pragma unroll
              for (int ks = 0; ks < 4; ++ks) { const bf16x8_t bfr = *(const LAS bf16x8_t*)(KB + (16 * n + lr) * KP + 32 * ks + 8 * lh); acc = __builtin_amdgcn_mfma_f32_16x16x32_bf16(af[ks], bfr, acc, 0, 0, 0); }
              const int j = 16 * n + lr; const float gj = SC[128 + j];
#pragma unroll
              for (int r = 0; r < 4; ++r) { const int i = 16 * m + 4 * lh + r; const float dec = __expf(SC[128 + i] - gj);
                  if (!isq) AM[j * AP + i] = (j < i) ? SC[i] * acc[r] * dec : 0.0f;
                  else AT[i * TP + j] = (bf16)f2bf((j <= i) ? acc[r] * dec : 0.0f); } } }
        __syncthreads();
        LAS bf16* TB = (LAS bf16*)(F.lds + 119040);
        if (F.wave < 4) { const int B = F.wave, lr = F.lane & 15, lh = F.lane >> 4; LAS float* S = (LAS float*)(F.lds + 121088 + F.wave * 1280);
            const f32x4 z4 = (f32x4){0.f, 0.f, 0.f, 0.f};
            float na[4], nb[4];
#pragma unroll
            for (int q = 0; q < 4; ++q) { na[q] = AM[(16 * B + 4 * lh + q) * AP + 16 * B + lr]; nb[q] = AM[(16 * B + lr) * AP + 16 * B + 4 * lh + q]; }
#define PK4(a, b, c, d) __builtin_bit_cast(s16x4, (unsigned long long)pk2((a), (b)) | ((unsigned long long)pk2((c), (d)) << 32))
#define ACC_TO_AOP(acc_, out_) do { _Pragma("unroll") for (int r = 0; r < 4; ++r) S[(4 * lh + r) * 17 + lr] = (acc_)[r]; LDS_WAIT(); asm volatile("" ::: "memory"); \
                _Pragma("unroll") for (int q = 0; q < 4; ++q) (out_)[q] = S[lr * 17 + 4 * lh + q]; LDS_WAIT(); asm volatile("" ::: "memory"); } while (0)
            const s16x4 nA = PK4(na[0], na[1], na[2], na[3]), nAneg = PK4(-na[0], -na[1], -na[2], -na[3]), nB = PK4(nb[0], nb[1], nb[2], nb[3]);
            const f32x4 p2 = __builtin_amdgcn_mfma_f32_16x16x16bf16_1k(nA, nB, z4, 0, 0, 0);
            float p2a[4]; ACC_TO_AOP(p2, p2a); const s16x4 p2A = PK4(p2a[0], p2a[1], p2a[2], p2a[3]), p2B = PK4(p2[0], p2[1], p2[2], p2[3]);
            const f32x4 p4 = __builtin_amdgcn_mfma_f32_16x16x16bf16_1k(p2A, p2B, z4, 0, 0, 0);
            float p4a[4]; ACC_TO_AOP(p4, p4a); const s16x4 p4B = PK4(p4[0], p4[1], p4[2], p4[3]);
            const s16x4 p4A = PK4(p4a[0], p4a[1], p4a[2], p4a[3]);
            const f32x4 p8 = __builtin_amdgcn_mfma_f32_16x16x16bf16_1k(p4A, p4B, z4, 0, 0, 0);
            float ia[4]; f32x4 m1;
#pragma unroll
            for (int q = 0; q < 4; ++q) ia[q] = p4a[q] + ((lr == 4 * lh + q) ? 1.f : 0.f);
#pragma unroll
            for (int r = 0; r < 4; ++r) m1[r] = p4[r] + ((4 * lh + r == lr) ? 1.f : 0.f);
            m1 = __builtin_amdgcn_mfma_f32_16x16x16bf16_1k(PK4(ia[0], ia[1], ia[2], ia[3]), PK4(p8[0], p8[1], p8[2], p8[3]), m1, 0, 0, 0);
            const f32x4 m2 = __builtin_amdgcn_mfma_f32_16x16x16bf16_1k(p2A, PK4(m1[0], m1[1], m1[2], m1[3]), m1, 0, 0, 0);
            const f32x4 tt = __builtin_amdgcn_mfma_f32_16x16x16bf16_1k(nAneg, PK4(m2[0], m2[1], m2[2], m2[3]), m2, 0, 0, 0);
#pragma unroll
            for (int r = 0; r < 4; ++r) TB[B * 256 + (4 * lh + r) * 16 + lr] = (bf16)f2bf(tt[r]);
        } else {
            const int wq = F.wave - 4, lr = F.lane & 15, lh = F.lane >> 4;
            v4u* QF = (v4u*)(ws + WS_GQF + (size_t)u * 16384); v4u* KF = (v4u*)(ws + WS_GKF + (size_t)u * 16384); v4u* AF = (v4u*)(ws + WS_GAF + (size_t)u * 8192);
#pragma unroll
            for (int ks = 0; ks < 4; ++ks) { const int tok = 16 * wq + lr; const float sc = SC[192 + tok]; const LAS bf16* qp = QB + tok * KP + 32 * ks + 4 * lh;
                const unsigned long long q0 = *(const LAS unsigned long long*)qp, q1 = *(const LAS unsigned long long*)(qp + 16);
                v4u o; o.x = pk2(bflo((unsigned)q0) * sc, bfhi((unsigned)q0) * sc); o.y = pk2(bflo((unsigned)(q0 >> 32)) * sc, bfhi((unsigned)(q0 >> 32)) * sc);
                o.z = pk2(bflo((unsigned)q1) * sc, bfhi((unsigned)q1) * sc); o.w = pk2(bflo((unsigned)(q1 >> 32)) * sc, bfhi((unsigned)(q1 >> 32)) * sc);
                QF[(wq * 4 + ks) * 64 + F.lane] = o; }
#pragma unroll
            for (int mm = 0; mm < 2; ++mm)
#pragma unroll
                for (int ks2 = 0; ks2 < 2; ++ks2) { const int md = 2 * wq + mm, d = 16 * md + lr; float v[8];
#pragma unroll
                    for (int j = 0; j < 8; ++j) { const int tok = 32 * ks2 + permk(j, lh); v[j] = bf2f(KB[tok * KP + d]) * SC[256 + tok]; }
                    v4u o; o.x = pk2(v[0], v[1]); o.y = pk2(v[2], v[3]); o.z = pk2(v[4], v[5]); o.w = pk2(v[6], v[7]); KF[(md * 2 + ks2) * 64 + F.lane] = o; }
#pragma unroll
            for (int ks2 = 0; ks2 < 2; ++ks2) { const int i = 16 * wq + lr; const LAS bf16* ap = AT + i * TP + 32 * ks2 + 4 * lh;
                const unsigned long long a0 = *(const LAS unsigned long long*)ap, a1 = *(const LAS unsigned long long*)(ap + 16);
                v4u o; o.x = (unsigned)a0; o.y = (unsigned)(a0 >> 32); o.z = (unsigned)a1; o.w = (unsigned)(a1 >> 32); AF[(wq * 2 + ks2) * 64 + F.lane] = o; }
        }
        __syncthreads();
        { const int w = F.wave, lr = F.lane & 15, lh = F.lane >> 4; const f32x4 z4 = (f32x4){0.f, 0.f, 0.f, 0.f};
          s16x4 Xp[4][2]; unsigned long long* gu = (unsigned long long*)(ws + WS_GUF + (size_t)u * 16384);
#pragma unroll
          for (int B = 0; B < 4; ++B) { f32x4 R[2];
#pragma unroll
              for (int t = 0; t < 2; ++t) { const int c = 32 * w + 16 * t + lr;
#pragma unroll
                  for (int r = 0; r < 4; ++r) { const int i = 16 * B + 4 * lh + r; R[t][r] = (w < 4) ? SC[i] * bf2f(VB[i * KP + c]) : SC[i] * SC[192 + i] * bf2f(KB[i * KP + c - 128]); } }
#pragma unroll
              for (int Bp = 0; Bp < B; ++Bp) { float a[4];
#pragma unroll
                  for (int q = 0; q < 4; ++q) a[q] = -AM[(16 * Bp + 4 * lh + q) * AP + 16 * B + lr];
                  const s16x4 aop = PK4(a[0], a[1], a[2], a[3]);
#pragma unroll
                  for (int t = 0; t < 2; ++t) R[t] = __builtin_amdgcn_mfma_f32_16x16x16bf16_1k(aop, Xp[Bp][t], R[t], 0, 0, 0); }
              const s16x4 top = *(const LAS s16x4*)(TB + B * 256 + lr * 16 + 4 * lh);
#pragma unroll
              for (int t = 0; t < 2; ++t) { const f32x4 x = __builtin_amdgcn_mfma_f32_16x16x16bf16_1k(top, PK4(R[t][0], R[t][1], R[t][2], R[t][3]), z4, 0, 0, 0);
                  Xp[B][t] = PK4(x[0], x[1], x[2], x[3]);
                  if (w < 4) gu[((2 * w + t) * 4 + B) * 64 + F.lane] = __builtin_bit_cast(unsigned long long, Xp[B][t]);
                  else {
#pragma unroll
                      for (int r = 0; r < 4; ++r) XS[(16 * B + 4 * lh + r) * 256 + 32 * w + 16 * t + lr] = (bf16)f2bf(x[r]); } } } }
#undef PK4
#undef ACC_TO_AOP
        __syncthreads();
        { v4u* gwf = (v4u*)(ws + WS_GWF + (size_t)u * 16384);
#pragma unroll
          for (int k = 0; k < 2; ++k) { const int o = F.tid + 512 * k, l = o & 63, ks = (o >> 6) & 3, m = o >> 8; const int i = 16 * m + (l & 15); const LAS bf16* xp = XS + i * 256 + 128 + 32 * ks + 4 * (l >> 4);
              const unsigned long long w0 = *(const LAS unsigned long long*)xp, w1 = *(const LAS unsigned long long*)(xp + 16);
              v4u ov; ov.x = (unsigned)w0 ^ 0x80008000u; ov.y = (unsigned)(w0 >> 32) ^ 0x80008000u; ov.z = (unsigned)w1 ^ 0x80008000u; ov.w = (unsigned)(w1 >> 32) ^ 0x80008000u; gwf[o] = ov; } }
        __syncthreads();
    }
}

__device__ __forceinline__ void gdn_scan(Frame& F, const LayerP& L, const bf16* P, const Args& a, bf16* Y1, int b, int h, int half) {
    constexpr int BUFB = 57344, OTP = 72;
    unsigned char* ws = a.ws; const int w = F.wave, lr = F.lane & 15, lh = F.lane >> 4; const bool comp = w < 4; const int slice = half * 4 + (w & 3);
    LAS unsigned char* buf = F.lds; LAS bf16* OT = (LAS bf16*)(F.lds + 2 * BUFB);
    f32x4 Sacc[8]; bf16x8_t Sb[4];
#pragma unroll
    for (int i = 0; i < 8; ++i) Sacc[i] = (f32x4){0.f, 0.f, 0.f, 0.f};
#pragma unroll
    for (int i = 0; i < 4; ++i) Sb[i] = (bf16x8_t){0, 0, 0, 0, 0, 0, 0, 0};
    v4u stg[7]; unsigned long long uld[4] = {0ull, 0ull, 0ull, 0ull}; float gln = 0.f;
    const int ubase = (b * 128) * 4 + h; float* GSS = (float*)(ws + WS_GSS);
    const int htk = 16 * (w & 3) + (F.lane >> 2), hc0 = 16 * (F.lane & 3), hcol = h * 128 + half * 64 + hc0;
    float ngv[16]; v4u zq[2] = {(v4u){0u, 0u, 0u, 0u}, (v4u){0u, 0u, 0u, 0u}};
#pragma unroll
    for (int q = 0; q < 16; ++q) ngv[q] = comp ? 0.f : L.gdn_norm[half * 64 + hc0 + q];
    if (!comp) { const bf16* zp = P + ((size_t)b * SEQ + htk) * PMW + C_Z + hcol; zq[0] = *(const v4u*)zp; zq[1] = *(const v4u*)(zp + 8); }
    { const size_t u = (size_t)ubase;
#pragma unroll
      for (int k = 0; k < 7; ++k) { const unsigned char* src = (k < 2) ? ws + WS_GWF + u * 16384 + k * 8192 : (k < 4) ? ws + WS_GQF + u * 16384 + (k - 2) * 8192 : (k < 6) ? ws + WS_GKF + u * 16384 + (k - 4) * 8192 : ws + WS_GAF + u * 8192;
          stg[k] = *(const v4u*)(src + F.tid * 16); }
#pragma unroll
      for (int k = 0; k < 7; ++k) *(LAS v4u*)(buf + k * 8192 + F.tid * 16) = stg[k];
      if (comp) {
#pragma unroll
          for (int m = 0; m < 4; ++m) uld[m] = *(const unsigned long long*)(ws + WS_GUF + u * 16384 + (size_t)((slice * 4 + m) * 64 + F.lane) * 8);
          gln = ((const float*)(ws + WS_GL))[u]; } }
    for (int c = 0; c <= 128; ++c) {
        __syncthreads();
        const size_t u = (size_t)ubase + (size_t)c * 4;
        if (c + 1 < 128) { const size_t un = u + 4;
#pragma unroll
            for (int k = 0; k < 7; ++k) { const unsigned char* src = (k < 2) ? ws + WS_GWF + un * 16384 + k * 8192 : (k < 4) ? ws + WS_GQF + un * 16384 + (k - 2) * 8192 : (k < 6) ? ws + WS_GKF + un * 16384 + (k - 4) * 8192 : ws + WS_GAF + un * 8192;
                stg[k] = *(const v4u*)(src + F.tid * 16); } }
        if (comp) { if (c < 128) {
            f32x4 vn[4];
#pragma unroll
            for (int m = 0; m < 4; ++m) { const unsigned lo = (unsigned)uld[m], hi = (unsigned)(uld[m] >> 32); vn[m] = (f32x4){bflo(lo), bfhi(lo), bflo(hi), bfhi(hi)}; }
            const float gl = gln;
            if (c + 1 < 128) { const size_t un = u + 4;
#pragma unroll
                for (int m = 0; m < 4; ++m) uld[m] = *(const unsigned long long*)(ws + WS_GUF + un * 16384 + (size_t)((slice * 4 + m) * 64 + F.lane) * 8);
                gln = ((const float*)(ws + WS_GL))[un]; }
            const LAS unsigned char* cb = buf + (c & 1) * BUFB;
            const LAS bf16x8_t* WFp = (const LAS bf16x8_t*)cb; const LAS bf16x8_t* QFp = (const LAS bf16x8_t*)(cb + 16384); const LAS bf16x8_t* KFp = (const LAS bf16x8_t*)(cb + 32768); const LAS bf16x8_t* AFp = (const LAS bf16x8_t*)(cb + 49152);
            f32x4 o[4];
#pragma unroll
            for (int m = 0; m < 4; ++m) { o[m] = (f32x4){0.f, 0.f, 0.f, 0.f};
#pragma unroll
                for (int ks = 0; ks < 4; ++ks) { vn[m] = __builtin_amdgcn_mfma_f32_16x16x32_bf16(WFp[(m * 4 + ks) * 64 + F.lane], Sb[ks], vn[m], 0, 0, 0);
                    o[m] = __builtin_amdgcn_mfma_f32_16x16x32_bf16(QFp[(m * 4 + ks) * 64 + F.lane], Sb[ks], o[m], 0, 0, 0); } }
            bf16x8_t vb[2]; vb[0] = pack_b(vn[0], vn[1]); vb[1] = pack_b(vn[2], vn[3]);
#pragma unroll
            for (int m = 0; m < 4; ++m)
#pragma unroll
                for (int ks2 = 0; ks2 < 2; ++ks2) o[m] = __builtin_amdgcn_mfma_f32_16x16x32_bf16(AFp[(m * 2 + ks2) * 64 + F.lane], vb[ks2], o[m], 0, 0, 0);
#pragma unroll
            for (int md = 0; md < 8; ++md) { Sacc[md] = Sacc[md] * gl;
#pragma unroll
                for (int ks2 = 0; ks2 < 2; ++ks2) Sacc[md] = __builtin_amdgcn_mfma_f32_16x16x32_bf16(KFp[(md * 2 + ks2) * 64 + F.lane], vb[ks2], Sacc[md], 0, 0, 0); }
#pragma unroll
            for (int ks = 0; ks < 4; ++ks) Sb[ks] = pack_b(Sacc[2 * ks], Sacc[2 * ks + 1]);
            LAS bf16* ot = OT + (c & 1) * (64 * OTP);
#pragma unroll
            for (int m = 0; m < 4; ++m)
#pragma unroll
                for (int r = 0; r < 4; ++r) ot[(16 * m + 4 * lh + r) * OTP + 16 * w + lr] = (bf16)f2bf(o[m][r]);
        } } else {
            const v4u z0 = zq[0], z1 = zq[1];
            if (c < 128) { const bf16* zp = P + ((size_t)b * SEQ + (size_t)c * 64 + htk) * PMW + C_Z + hcol; zq[0] = *(const v4u*)zp; zq[1] = *(const v4u*)(zp + 8); }
            if (c > 0) { const LAS bf16* op = OT + ((c - 1) & 1) * (64 * OTP) + htk * OTP + hc0; const v4u o0 = *(const LAS v4u*)op, o1 = *(const LAS v4u*)(op + 8);
                const unsigned ow[8] = {o0.x, o0.y, o0.z, o0.w, o1.x, o1.y, o1.z, o1.w}, zw[8] = {z0.x, z0.y, z0.z, z0.w, z1.x, z1.y, z1.z, z1.w}; float ssq = 0.f; unsigned yw[8];
#pragma unroll
                for (int q = 0; q < 8; ++q) { const float a0 = bflo(ow[q]), a1 = bfhi(ow[q]); ssq += a0 * a0 + a1 * a1; yw[q] = pk2(a0 * ngv[2 * q] * silu_f(bflo(zw[q])), a1 * ngv[2 * q + 1] * silu_f(bfhi(zw[q]))); }
                ssq += dppf<DPP_X1>(ssq); ssq += dppf<DPP_X2>(ssq);
                const size_t t = (size_t)b * SEQ + (size_t)(c - 1) * 64 + htk; bf16* yp = Y1 + t * 512 + hcol;
                *(v4u*)yp = (v4u){yw[0], yw[1], yw[2], yw[3]}; *(v4u*)(yp + 8) = (v4u){yw[4], yw[5], yw[6], yw[7]};
                if ((F.lane & 3) == 0) GSS[(t * 4 + h) * 2 + half] = ssq; } }
        if (c + 1 < 128) {
#pragma unroll
            for (int k = 0; k < 7; ++k) *(LAS v4u*)(buf + ((c + 1) & 1) * BUFB + k * 8192 + F.tid * 16) = stg[k]; }
    }
    __syncthreads();
}
__device__ __forceinline__ void gdn_norm_pass(Frame& F, const Args& a, bf16* Y1) {
    const float* GSS = (const float*)(a.ws + WS_GSS);
    for (int t = F.gw; t < T; t += F.NGW) { const int hd = F.lane >> 4; const float rs = 1.0f / sqrtf((GSS[((size_t)t * 4 + hd) * 2] + GSS[((size_t)t * 4 + hd) * 2 + 1]) * (1.f / 128.f) + RMS_EPS);
        v4u* p = (v4u*)(Y1 + (size_t)t * 512) + F.lane; const v4u r = *p;
        v4u o; o.x = pk2(bflo(r.x) * rs, bfhi(r.x) * rs); o.y = pk2(bflo(r.y) * rs, bfhi(r.y) * rs); o.z = pk2(bflo(r.z) * rs, bfhi(r.z) * rs); o.w = pk2(bflo(r.w) * rs, bfhi(r.w) * rs); *p = o; }
}

__device__ __forceinline__ void nsa_tiles(Frame& F_, const bf16* P, const Args& a, LAS bf16* tile, int first, int stride) {
    constexpr int TPt = 72;
    for (int unit = first; unit < 2 * 2 * 2 * 128; unit += stride) {
        Frame F = F_; asm volatile("" : "+v"(F.lane));
        const int blk = unit & 127, g = (unit >> 7) & 1, b = (unit >> 8) & 1, which = unit >> 9; const int lr = F.lane & 15, lh = F.lane >> 4;
        const size_t ub = (size_t)((b * 2 + g) * 128 + blk) * 4096;
        v4u rk[8], rv[8];
        { const bf16* s0 = P + ((size_t)b * SEQ + (size_t)blk * 64 + F.lane) * PMW + (which ? C_KW : C_KS) + g * 64; const bf16* s1 = P + ((size_t)b * SEQ + (size_t)blk * 64 + F.lane) * PMW + (which ? C_VW : C_VS) + g * 64;
#pragma unroll
          for (int q = 0; q < 8; ++q) { rk[q] = *(const v4u*)(s0 + q * 8); rv[q] = *(const v4u*)(s1 + q * 8); } }
#pragma unroll
        for (int kv = 0; kv < 2; ++kv) {
#pragma unroll
            for (int q = 0; q < 8; ++q) *(LAS v4u*)(tile + F.lane * TPt + q * 8) = kv ? rv[q] : rk[q];
            LDS_WAIT(); asm volatile("" ::: "memory");
            v4u* out = (v4u*)(a.ws + (which ? (kv ? WS_NVWF : WS_NKWF) : (kv ? WS_NVSF : WS_NKSF)) + ub);
            if (kv == 0) {
#pragma unroll
                for (int m4 = 0; m4 < 4; ++m4) { unsigned long long fr2[2];
#pragma unroll
                    for (int ks = 0; ks < 2; ++ks) { const v4u r = *(const LAS v4u*)(tile + (16 * m4 + lr) * TPt + 32 * ks + 8 * lh);
                        fr2[ks] = pk_fp8x8(bflo(r.x), bfhi(r.x), bflo(r.y), bfhi(r.y), bflo(r.z), bfhi(r.z), bflo(r.w), bfhi(r.w)); }
                    out[m4 * 64 + F.lane] = (v4u){(unsigned)fr2[0], (unsigned)(fr2[0] >> 32), (unsigned)fr2[1], (unsigned)(fr2[1] >> 32)}; }
            } else {
#pragma unroll
                for (int f2 = 0; f2 < 4; ++f2) { const int kk = f2 >> 1, mp = f2 & 1; unsigned long long fr2[2];
#pragma unroll
                    for (int q = 0; q < 2; ++q) { const int m = 2 * mp + q; float v[8];
#pragma unroll
                        for (int k = 0; k < 8; ++k) v[k] = bf2f(tile[(32 * kk + permk(k, lh)) * TPt + 16 * m + lr]);
                        fr2[q] = pk_fp8x8(v[0], v[1], v[2], v[3], v[4], v[5], v[6], v[7]); }
                    out[f2 * 64 + F.lane] = (v4u){(unsigned)fr2[0], (unsigned)(fr2[0] >> 32), (unsigned)fr2[1], (unsigned)(fr2[1] >> 32)}; }
            }
            LDS_WAIT(); asm volatile("" ::: "memory");
        }
    }
}

__device__ __forceinline__ f32x4 nsa_qk(const v4u* kf2, int lane, const bf16x8_t (&qb)[2]) {
    const v4u w0 = kf2[lane], w1 = kf2[64 + lane];
    f32x4 acc = (f32x4){0.f, 0.f, 0.f, 0.f};
    acc = __builtin_amdgcn_mfma_f32_16x16x32_bf16(__builtin_bit_cast(bf16x8_t, w0), qb[0], acc, 0, 0, 0); acc = __builtin_amdgcn_mfma_f32_16x16x32_bf16(__builtin_bit_cast(bf16x8_t, w1), qb[1], acc, 0, 0, 0); return acc;
}
__device__ __forceinline__ f32x4 nsa_qk_lds(const LAS v4u* kf2, int lane, const bf16x8_t (&qb)[2]) {
    const v4u w0 = kf2[lane], w1 = kf2[64 + lane];
    f32x4 acc = (f32x4){0.f, 0.f, 0.f, 0.f};
    acc = __builtin_amdgcn_mfma_f32_16x16x32_bf16(__builtin_bit_cast(bf16x8_t, w0), qb[0], acc, 0, 0, 0); acc = __builtin_amdgcn_mfma_f32_16x16x32_bf16(__builtin_bit_cast(bf16x8_t, w1), qb[1], acc, 0, 0, 0); return acc;
}
__device__ __forceinline__ f32x4 nsa_qk8(const unsigned long long* kf2, int lane, const unsigned long long (&q8)[2]) {
    f32x4 acc = (f32x4){0.f, 0.f, 0.f, 0.f};
    acc = __builtin_amdgcn_mfma_f32_16x16x32_fp8_fp8((long)kf2[lane], (long)q8[0], acc, 0, 0, 0); acc = __builtin_amdgcn_mfma_f32_16x16x32_fp8_fp8((long)kf2[64 + lane], (long)q8[1], acc, 0, 0, 0); return acc;
}
__device__ __forceinline__ void nsa_pv8(f32x4 (&o)[4], const unsigned long long* vf4, int lane, const f32x4& p0, const f32x4& p1) {
    const long pb = (long)pk_fp8x8(p0[0] * 256.f, p0[1] * 256.f, p0[2] * 256.f, p0[3] * 256.f, p1[0] * 256.f, p1[1] * 256.f, p1[2] * 256.f, p1[3] * 256.f);
#pragma unroll
    for (int m = 0; m < 4; ++m) o[m] = __builtin_amdgcn_mfma_f32_16x16x32_fp8_fp8((long)vf4[m * 64 + lane], pb, o[m], 0, 0, 0);
}
__device__ __forceinline__ f32x4 nsa_qk8x(const v4u* kt, int lane, const unsigned long long (&q8)[2], f32x4 acc) {
    const v4u w = kt[lane]; const unsigned long long a0 = (unsigned long long)w.x | ((unsigned long long)w.y << 32), a1 = (unsigned long long)w.z | ((unsigned long long)w.w << 32);
    acc = __builtin_amdgcn_mfma_f32_16x16x32_fp8_fp8((long)a0, (long)q8[0], acc, 0, 0, 0); acc = __builtin_amdgcn_mfma_f32_16x16x32_fp8_fp8((long)a1, (long)q8[1], acc, 0, 0, 0); return acc;
}
__device__ __forceinline__ void nsa_pv8x(f32x4 (&o)[4], const v4u* vs, int lane, unsigned long long pb) {
#pragma unroll
    for (int mp = 0; mp < 2; ++mp) { const v4u w = vs[mp * 64 + lane]; const unsigned long long a0 = (unsigned long long)w.x | ((unsigned long long)w.y << 32), a1 = (unsigned long long)w.z | ((unsigned long long)w.w << 32);
        o[2 * mp] = __builtin_amdgcn_mfma_f32_16x16x32_fp8_fp8((long)a0, (long)pb, o[2 * mp], 0, 0, 0); o[2 * mp + 1] = __builtin_amdgcn_mfma_f32_16x16x32_fp8_fp8((long)a1, (long)pb, o[2 * mp + 1], 0, 0, 0); }
}
__device__ __forceinline__ unsigned long long nsa_pack_p8(const f32x4& p0, const f32x4& p1) { return pk_fp8x8(p0[0] * 256.f, p0[1] * 256.f, p0[2] * 256.f, p0[3] * 256.f, p1[0] * 256.f, p1[1] * 256.f, p1[2] * 256.f, p1[3] * 256.f); }
__device__ __forceinline__ void nsa_pv8p(f32x4 (&o)[4], const unsigned long long* vf4, int lane, unsigned long long pb) {
#pragma unroll
    for (int m = 0; m < 4; ++m) o[m] = __builtin_amdgcn_mfma_f32_16x16x32_fp8_fp8((long)vf4[m * 64 + lane], (long)pb, o[m], 0, 0, 0);
}
__device__ __forceinline__ float lutb(const LAS float* lut, int dist, int gh) { const int dd = dist < 0 ? 0 : (dist > 128 ? 128 : dist); return lut[dd * 8 + gh]; }
__device__ __forceinline__ float red_lh_max(float v) { return x32_max(x16_max(v)); }
__device__ __forceinline__ float red_lh_sum(float v) { return x32_sum(x16_sum(v)); }
__device__ __forceinline__ void nsa_pv(f32x4 (&o)[4], const v4u* vf4, int lane, const f32x4& p0, const f32x4& p1) {
    const bf16x8_t pb = pack_b(p0, p1);
#pragma unroll
    for (int m = 0; m < 4; ++m) { const v4u w = vf4[m * 64 + lane]; o[m] = __builtin_amdgcn_mfma_f32_16x16x32_bf16(__builtin_bit_cast(bf16x8_t, w), pb, o[m], 0, 0, 0); }
}
__device__ __forceinline__ void mix_nsa_mfma(Frame& F_, const LayerP& L, const bf16* P, const Args& a, bf16* Y2, const LAS float* lut, const LAS int* cpos, const LAS int* ptab, const LAS int* bmax, const LAS int* cmax, LAS float* wl, int first, int stride, int nlocal, int bsel, int gsel, int qt0, unsigned* qhead, unsigned* qhead2 = nullptr, int qt0b = 0, const LAS v4u* kclds = nullptr) {
#if STAMPMASK
    unsigned long long tsec[4] = {0ull, 0ull, 0ull, 0ull}, tmark = 0ull;
#define NSA_T0() (tmark = __builtin_amdgcn_s_memrealtime())
#define NSA_T1(k) do { const unsigned long long tn = __builtin_amdgcn_s_memrealtime(); tsec[k] += tn - tmark; tmark = tn; } while (0)
#else
#define NSA_T0() do { } while (0)
#define NSA_T1(k) do { } while (0)
#endif
    LAS float* impT = wl;
    LAS int* sel = (LAS int*)(wl + 512);
    const v4u* KCF = (const v4u*)(a.ws + WS_NKCF); const v4u* VCF = (const v4u*)(a.ws + WS_NVCF);
    const v4u* KSF = (const v4u*)(a.ws + WS_NKSF); const v4u* VSF = (const v4u*)(a.ws + WS_NVSF); const v4u* KWF = (const v4u*)(a.ws + WS_NKWF); const v4u* VWF = (const v4u*)(a.ws + WS_NVWF);
    bool stolen = false;
    for (int lu0 = first;; lu0 += stride) {
        Frame F = F_; asm volatile("" : "+v"(F.lane));
        int lu = lu0;
        if (qhead) { unsigned tk = 0u; if (F.lane == 0) tk = __hip_atomic_fetch_add(qhead, 1u, __ATOMIC_RELAXED, __HIP_MEMORY_SCOPE_AGENT); lu = (int)__builtin_amdgcn_readfirstlane(tk);
            if (lu >= nlocal) { if (!stolen && qhead2) { stolen = true; qhead = qhead2; qt0 = qt0b; continue; } break; }
            lu = nlocal - 1 - lu; }
        else if (lu >= nlocal) break;
        const int g = bsel < 0 ? (lu & 1) : gsel, qt = bsel < 0 ? ((lu >> 1) & (SEQ / 4 - 1)) : (qt0 + lu), b = bsel < 0 ? (lu >> 12) : bsel; const int lr = F.lane & 15, lh = F.lane >> 4, tokc = lr >> 2, head = lr & 3, gh = g * 4 + head, bg = b * 2 + g;
        const int tq0 = qt * 4, tq = tq0 + tokc, tb = tq0 >> 6; const int post = L.pos[tq]; const size_t bt = (size_t)b * SEQ;
        bf16x8_t qb[2]; unsigned long long q8[2];
#pragma unroll
        for (int ks = 0; ks < 2; ++ks) { const v4u r = *(const v4u*)(P + (bt + tq) * PMW + C_NQ + g * 256 + head * 64 + 32 * ks + 8 * lh);
            const v4u w = (v4u){pk2(bflo(r.x) * 0.125f, bfhi(r.x) * 0.125f), pk2(bflo(r.y) * 0.125f, bfhi(r.y) * 0.125f), pk2(bflo(r.z) * 0.125f, bfhi(r.z) * 0.125f), pk2(bflo(r.w) * 0.125f, bfhi(r.w) * 0.125f)}; qb[ks] = __builtin_bit_cast(bf16x8_t, w);
            q8[ks] = pk_fp8x8(bflo(r.x) * 0.125f, bfhi(r.x) * 0.125f, bflo(r.y) * 0.125f, bfhi(r.y) * 0.125f, bflo(r.z) * 0.125f, bfhi(r.z) * 0.125f, bflo(r.w) * 0.125f, bfhi(r.w) * 0.125f); }
        unsigned long long q8t[4][2];
#pragma unroll
        for (int tk = 0; tk < 4; ++tk) { q8t[tk][0] = (tokc == tk) ? q8[0] : 0ull; q8t[tk][1] = (tokc == tk) ? q8[1] : 0ull; }
        f32x4 outv[4];
#pragma unroll
        for (int m = 0; m < 4; ++m) outv[m] = (f32x4){0.f, 0.f, 0.f, 0.f};
        const bf16* ngp = P + (bt + tq) * PMW + C_NG + g * 12 + head * 3; const float gate_c = sigm(bf2f(ngp[0])), gate_s = sigm(bf2f(ngp[1])), gate_w = sigm(bf2f(ngp[2])); const float cbfar = lut[128 * 8 + gh];
        NSA_T0();
        const int ncv = tq >= 31 ? ((tq - 31) >> 4) + 1 : 0; const int nv3 = (tq0 + 3) >= 31 ? ((tq0 + 3 - 31) >> 4) + 1 : 0; const int npair = (nv3 + 31) >> 5;
        const v4u* kcf = KCF + (size_t)bg * 32 * 2 * 64; const v4u* vcf = VCF + (size_t)bg * 16 * 4 * 64;
        float mc = -1e30f, lc = 0.f;
#pragma unroll 2
        for (int n = 0; n < 2 * npair; ++n) { const f32x4 s = kclds ? nsa_qk_lds(kclds + n * 128, F.lane, qb) : nsa_qk(kcf + (size_t)n * 128, F.lane, qb); float sv[4]; float tm = -1e30f;
            if (__all((16 * n + 15 < ncv) && (post - cmax[n] >= 128))) {
#pragma unroll
                for (int r = 0; r < 4; ++r) { sv[r] = s[r] + cbfar; tm = fmaxf(tm, sv[r]); }
            } else { const i32x4 cp = *(const LAS i32x4*)(cpos + 16 * n + 4 * lh); const int cpv[4] = {cp.x, cp.y, cp.z, cp.w};
#pragma unroll
            for (int r = 0; r < 4; ++r) { const int c = 16 * n + 4 * lh + r; const bool valid = c < ncv; sv[r] = valid ? s[r] + lutb(lut, post - cpv[r], gh) : -1e30f; tm = fmaxf(tm, sv[r]); } }
            const float mn = fmaxf(mc, tm); float ad = 0.f;
#pragma unroll
            for (int r = 0; r < 4; ++r) ad += (sv[r] > -1e29f) ? __expf(sv[r] - mn) : 0.f;
            lc = lc * __expf(mc - mn) + ad; mc = mn; }
        { const float mt = red_lh_max(mc); lc = red_lh_sum(lc * __expf(mc - mt)); mc = mt; }
        const float icl = (ncv > 0 && lc > 0.f) ? 1.0f / lc : 0.f;
        { f32x4 oc[4];
#pragma unroll
          for (int m = 0; m < 4; ++m) oc[m] = (f32x4){0.f, 0.f, 0.f, 0.f};
          float carry = 0.f;
#pragma unroll 1
          for (int pr = 0; pr < npair; ++pr) { f32x4 pt[2];
#pragma unroll
              for (int h2 = 0; h2 < 2; ++h2) { const int n = 2 * pr + h2; const f32x4 s = kclds ? nsa_qk_lds(kclds + n * 128, F.lane, qb) : nsa_qk(kcf + (size_t)n * 128, F.lane, qb);
                  if (__all((16 * n + 15 < ncv) && (post - cmax[n] >= 128))) {
#pragma unroll
                      for (int r = 0; r < 4; ++r) pt[h2][r] = __expf(s[r] + cbfar - mc) * icl;
                  } else { const i32x4 cp = *(const LAS i32x4*)(cpos + 16 * n + 4 * lh); const int cpv[4] = {cp.x, cp.y, cp.z, cp.w};
#pragma unroll
                  for (int r = 0; r < 4; ++r) { const int c = 16 * n + 4 * lh + r; const bool valid = c < ncv; pt[h2][r] = valid ? __expf(s[r] + lutb(lut, post - cpv[r], gh) - mc) * icl : 0.f; } }
                  float up;
                  { const unsigned xb = __float_as_uint(pt[h2][3]); const auto r = __builtin_amdgcn_permlane16_swap(xb, xb, false, false);
                    const auto t = __builtin_amdgcn_permlane32_swap(r[1], r[1], false, false);
                    up = (lh == 0) ? carry : (lh == 2) ? __uint_as_float(t[0]) : __uint_as_float(r[0]); carry = __uint_as_float(t[1]); }
                  float e = (pt[h2][0] + pt[h2][1]) + (pt[h2][2] + pt[h2][3]) + up; e += dppf<DPP_X1>(e); e += dppf<DPP_X2>(e);
                  if (head == 0) impT[tokc * 128 + 4 * n + lh] = e; }
              nsa_pv(oc, vcf + (size_t)pr * 256, F.lane, pt[0], pt[1]); }
#pragma unroll
          for (int m = 0; m < 4; ++m) outv[m] = outv[m] + oc[m] * gate_c; }
        LDS_WAIT(); asm volatile("" ::: "memory");
        NSA_T1(0);
        const int nsel = (tb + 1) < 16 ? (tb + 1) : 16;
        { const int tks = lh; float sc[8];
#pragma unroll
          for (int q = 0; q < 8; ++q) { const int j = lr + 16 * q; const bool forced = (j == 0) || (j == tb) || (j == tb - 1); sc[q] = forced ? 1e9f : (j <= tb ? impT[tks * 128 + j] : -1e9f); }
#pragma unroll 1
          for (int it = 0; it < nsel; ++it) { float bv = sc[0]; int bi = lr;
#pragma unroll
              for (int q = 1; q < 8; ++q) if (sc[q] > bv) { bv = sc[q]; bi = lr + 16 * q; }
#pragma unroll
              for (int st = 0; st < 4; ++st) { const float ov = st == 0 ? dppf<DPP_ROR8>(bv) : st == 1 ? dppf<DPP_ROR4>(bv) : st == 2 ? dppf<DPP_X2>(bv) : dppf<DPP_X1>(bv);
                  const int oi = st == 0 ? dppi<DPP_ROR8>(bi) : st == 1 ? dppi<DPP_ROR4>(bi) : st == 2 ? dppi<DPP_X2>(bi) : dppi<DPP_X1>(bi); if (ov > bv || (ov == bv && oi < bi)) { bv = ov; bi = oi; } }
              if (lr == 0) sel[tks * 16 + it] = bi;
#pragma unroll
              for (int q = 0; q < 8; ++q) if (bi == lr + 16 * q) sc[q] = -3.0e38f; } }
        LDS_WAIT(); asm volatile("" ::: "memory");
        NSA_T1(1);
        { f32x4 os[4];
#pragma unroll
          for (int m = 0; m < 4; ++m) os[m] = (f32x4){0.f, 0.f, 0.f, 0.f};
          float ms = -1e30f, ls = 0.f;
#pragma unroll 1
          for (int it = 0; it < nsel; ++it) { int jt[4];
#pragma unroll
              for (int tk = 0; tk < 4; ++tk) jt[tk] = __builtin_amdgcn_readfirstlane(sel[tk * 16 + it]);
              const int jmine = sel[tokc * 16 + it]; f32x4 pt[4];
#pragma unroll
              for (int m4 = 0; m4 < 4; ++m4) pt[m4] = (f32x4){0.f, 0.f, 0.f, 0.f};
              const bool same = (jt[0] == jt[1]) && (jt[1] == jt[2]) && (jt[2] == jt[3]);
              v4u kw[4][4], vw[4][4];
              if (same) { const v4u* kf = KSF + (size_t)(bg * 128 + jt[0]) * 256 + F.lane;
#pragma unroll
                  for (int m4 = 0; m4 < 4; ++m4) kw[0][m4] = kf[m4 * 64];
                  __builtin_amdgcn_sched_barrier(0);
#pragma unroll
                  for (int m4 = 0; m4 < 4; ++m4) { const v4u w = kw[0][m4]; const unsigned long long a0 = (unsigned long long)w.x | ((unsigned long long)w.y << 32), a1 = (unsigned long long)w.z | ((unsigned long long)w.w << 32);
                      pt[m4] = __builtin_amdgcn_mfma_f32_16x16x32_fp8_fp8((long)a0, (long)q8[0], pt[m4], 0, 0, 0); pt[m4] = __builtin_amdgcn_mfma_f32_16x16x32_fp8_fp8((long)a1, (long)q8[1], pt[m4], 0, 0, 0); }
                  __builtin_amdgcn_sched_barrier(0);
                  const v4u* vf = VSF + (size_t)(bg * 128 + jt[0]) * 256 + F.lane;
#pragma unroll
                  for (int i4 = 0; i4 < 4; ++i4) vw[0][i4] = vf[i4 * 64];
                  __builtin_amdgcn_sched_barrier(0);
              } else {
#pragma unroll
              for (int tk = 0; tk < 4; ++tk) { const v4u* kf = KSF + (size_t)(bg * 128 + jt[tk]) * 256 + F.lane;
#pragma unroll
                  for (int m4 = 0; m4 < 4; ++m4) kw[tk][m4] = kf[m4 * 64]; }
              __builtin_amdgcn_sched_barrier(0);
#pragma unroll
              for (int tk = 0; tk < 4; ++tk)
#pragma unroll
                  for (int m4 = 0; m4 < 4; ++m4) { const v4u w = kw[tk][m4]; const unsigned long long a0 = (unsigned long long)w.x | ((unsigned long long)w.y << 32), a1 = (unsigned long long)w.z | ((unsigned long long)w.w << 32);
                      pt[m4] = __builtin_amdgcn_mfma_f32_16x16x32_fp8_fp8((long)a0, (long)q8t[tk][0], pt[m4], 0, 0, 0); pt[m4] = __builtin_amdgcn_mfma_f32_16x16x32_fp8_fp8((long)a1, (long)q8t[tk][1], pt[m4], 0, 0, 0); }
              __builtin_amdgcn_sched_barrier(0);
#pragma unroll
              for (int tk = 0; tk < 4; ++tk) { const v4u* vf = VSF + (size_t)(bg * 128 + jt[tk]) * 256 + F.lane;
#pragma unroll
                  for (int i4 = 0; i4 < 4; ++i4) vw[tk][i4] = vf[i4 * 64]; }
              __builtin_amdgcn_sched_barrier(0);
              }
              float tm = -1e30f; const int key0 = 64 * jmine;
              if (__all((jmine < tb) && (post - bmax[jmine] >= 128))) {
#pragma unroll
                  for (int m4 = 0; m4 < 4; ++m4)
#pragma unroll
                      for (int r = 0; r < 4; ++r) { pt[m4][r] += cbfar; tm = fmaxf(tm, pt[m4][r]); }
              } else {
#pragma unroll
              for (int m4 = 0; m4 < 4; ++m4) { const int kb4 = key0 + 16 * m4 + 4 * lh; const i32x4 kp = *(const LAS i32x4*)(ptab + kb4); const int kpv[4] = {kp.x, kp.y, kp.z, kp.w};
#pragma unroll
                  for (int r = 0; r < 4; ++r) { const bool valid = (kb4 + r <= tq); pt[m4][r] = valid ? pt[m4][r] + lutb(lut, post - kpv[r], gh) : -1e30f; tm = fmaxf(tm, pt[m4][r]); } } }
              tm = red_lh_max(tm); const float mn = fmaxf(ms, tm); const float scl = __expf(ms - mn); float ad = 0.f;
#pragma unroll
              for (int m4 = 0; m4 < 4; ++m4)
#pragma unroll
                  for (int r = 0; r < 4; ++r) { const float pv = (pt[m4][r] > -1e29f) ? __expf(pt[m4][r] - mn) : 0.f; pt[m4][r] = pv; ad += pv; }
              ls = ls * scl + red_lh_sum(ad); ms = mn;
#pragma unroll
              for (int m = 0; m < 4; ++m) os[m] = os[m] * scl;
              const unsigned long long pba = nsa_pack_p8(pt[0], pt[1]), pbb = nsa_pack_p8(pt[2], pt[3]);
              __builtin_amdgcn_sched_barrier(0);
              if (same) {
#pragma unroll
                  for (int i4 = 0; i4 < 4; ++i4) { const v4u w = vw[0][i4]; const unsigned long long a0 = (unsigned long long)w.x | ((unsigned long long)w.y << 32), a1 = (unsigned long long)w.z | ((unsigned long long)w.w << 32);
                      const unsigned long long pb = (i4 >> 1) ? pbb : pba; const int mp = i4 & 1;
                      os[2 * mp] = __builtin_amdgcn_mfma_f32_16x16x32_fp8_fp8((long)a0, (long)pb, os[2 * mp], 0, 0, 0); os[2 * mp + 1] = __builtin_amdgcn_mfma_f32_16x16x32_fp8_fp8((long)a1, (long)pb, os[2 * mp + 1], 0, 0, 0); }
              } else {
#pragma unroll
              for (int tk = 0; tk < 4; ++tk) { const bool mine = (tokc == tk);
#pragma unroll
                  for (int i4 = 0; i4 < 4; ++i4) { const v4u w = vw[tk][i4]; const unsigned long long a0 = (unsigned long long)w.x | ((unsigned long long)w.y << 32), a1 = (unsigned long long)w.z | ((unsigned long long)w.w << 32);
                      const unsigned long long pb = mine ? ((i4 >> 1) ? pbb : pba) : 0ull; const int mp = i4 & 1;
                      os[2 * mp] = __builtin_amdgcn_mfma_f32_16x16x32_fp8_fp8((long)a0, (long)pb, os[2 * mp], 0, 0, 0); os[2 * mp + 1] = __builtin_amdgcn_mfma_f32_16x16x32_fp8_fp8((long)a1, (long)pb, os[2 * mp + 1], 0, 0, 0); } } } }
          const float isl = ls > 0.f ? gate_s / (ls * 256.f) : 0.f;
#pragma unroll
          for (int m = 0; m < 4; ++m) outv[m] = outv[m] + os[m] * isl; }
        NSA_T1(2);
        { f32x4 ow[4];
#pragma unroll
          for (int m = 0; m < 4; ++m) ow[m] = (f32x4){0.f, 0.f, 0.f, 0.f};
          float mw = -1e30f, lw = 0.f; const int k32a = (tq0 - 511) > 0 ? ((tq0 - 511) >> 5) : 0, k32b = (tq0 + 3) >> 5;
#pragma unroll 2
          for (int k32 = k32a; k32 <= k32b; ++k32) { const int key0 = 32 * k32, half = k32 & 1; const size_t ub = (size_t)(bg * 128 + (k32 >> 1)) * 256; f32x4 pt[2]; float tm = -1e30f;
              const bool wfar = __all((key0 + 31 <= tq) && (key0 >= tq - 511) && (post - bmax[key0 >> 6] >= 128));
#pragma unroll
              for (int h2 = 0; h2 < 2; ++h2) { const f32x4 s = nsa_qk8x(KWF + ub + (2 * half + h2) * 64, F.lane, q8, (f32x4){0.f, 0.f, 0.f, 0.f});
                  if (wfar) {
#pragma unroll
                      for (int r = 0; r < 4; ++r) { pt[h2][r] = s[r] + cbfar; tm = fmaxf(tm, pt[h2][r]); }
                  } else { const int kb4 = key0 + 16 * h2 + 4 * lh; const i32x4 kp = *(const LAS i32x4*)(ptab + kb4); const int kpv[4] = {kp.x, kp.y, kp.z, kp.w};
#pragma unroll
                  for (int r = 0; r < 4; ++r) { const int key = kb4 + r; const bool valid = (key <= tq) && (key >= tq - 511); pt[h2][r] = valid ? s[r] + lutb(lut, post - kpv[r], gh) : -1e30f; tm = fmaxf(tm, pt[h2][r]); } } }
              tm = red_lh_max(tm); const float mn = fmaxf(mw, tm); const float scl = __expf(mw - mn); float ad = 0.f;
#pragma unroll
              for (int h2 = 0; h2 < 2; ++h2)
#pragma unroll
                  for (int r = 0; r < 4; ++r) { const float pv = (pt[h2][r] > -1e29f) ? __expf(pt[h2][r] - mn) : 0.f; pt[h2][r] = pv; ad += pv; }
              lw = lw * scl + red_lh_sum(ad); mw = mn;
#pragma unroll
              for (int m = 0; m < 4; ++m) ow[m] = ow[m] * scl;
              nsa_pv8x(ow, VWF + ub + half * 128, F.lane, nsa_pack_p8(pt[0], pt[1])); }
          const float iwl = lw > 0.f ? gate_w / (lw * 256.f) : 0.f;
#pragma unroll
          for (int m = 0; m < 4; ++m) outv[m] = outv[m] + ow[m] * iwl; }
        NSA_T1(3);
#pragma unroll
        for (int m = 0; m < 4; ++m) { const unsigned long long pk = (unsigned long long)pk2(outv[m][0], outv[m][1]) | ((unsigned long long)pk2(outv[m][2], outv[m][3]) << 32);
            *(unsigned long long*)(Y2 + (bt + tq) * 512 + g * 256 + head * 64 + 16 * m + 4 * lh) = pk; }
        LDS_WAIT(); asm volatile("" ::: "memory");
    }
#if STAMPMASK
    if (blockIdx.x == gridDim.x - 1 && threadIdx.x == 0) { unsigned long long* ts = (unsigned long long*)(a.ws + WS_CTL + 512 * 1024); for (int k = 0; k < 4; ++k) ts[44 + k] = tsec[k]; }
#endif
#undef NSA_T0
#undef NSA_T1
}

__device__ __forceinline__ void dot64x4(const bf16* krow, const LAS float* qs, float (&lg)[4]) {
    float s0 = 0.f, s1 = 0.f, s2 = 0.f, s3 = 0.f;
#pragma nounroll
    for (int i = 0; i < 8; ++i) { const v4u kr = ((const v4u*)krow)[i];
        const float kf[8] = {bflo(kr.x), bfhi(kr.x), bflo(kr.y), bfhi(kr.y), bflo(kr.z), bfhi(kr.z), bflo(kr.w), bfhi(kr.w)};
        const LAS float* qp = qs + i * 8;
        { const f32x4 qa = *(const LAS f32x4*)(qp), qb = *(const LAS f32x4*)(qp + 4);
          s0 += kf[0] * qa.x + kf[1] * qa.y + kf[2] * qa.z + kf[3] * qa.w + kf[4] * qb.x + kf[5] * qb.y + kf[6] * qb.z + kf[7] * qb.w; }
        { const f32x4 qa = *(const LAS f32x4*)(qp + 64), qb = *(const LAS f32x4*)(qp + 68);
          s1 += kf[0] * qa.x + kf[1] * qa.y + kf[2] * qa.z + kf[3] * qa.w + kf[4] * qb.x + kf[5] * qb.y + kf[6] * qb.z + kf[7] * qb.w; }
        { const f32x4 qa = *(const LAS f32x4*)(qp + 128), qb = *(const LAS f32x4*)(qp + 132);
          s2 += kf[0] * qa.x + kf[1] * qa.y + kf[2] * qa.z + kf[3] * qa.w + kf[4] * qb.x + kf[5] * qb.y + kf[6] * qb.z + kf[7] * qb.w; }
        { const f32x4 qa = *(const LAS f32x4*)(qp + 192), qb = *(const LAS f32x4*)(qp + 196);
          s3 += kf[0] * qa.x + kf[1] * qa.y + kf[2] * qa.z + kf[3] * qa.w + kf[4] * qb.x + kf[5] * qb.y + kf[6] * qb.z + kf[7] * qb.w; } }
    lg[0] = s0; lg[1] = s1; lg[2] = s2; lg[3] = s3;
}
__device__ __forceinline__ void nsa_chunk(Frame& F, const bf16* krow, const bf16* vbase, size_t vstride_tok0, bool kvalid, int dist, const LAS float* qs, const LAS float* lut, int g,
                                          LAS float* pb, float (&mrun)[4], float (&lrun)[4], float (&oacc)[4], const bf16* vrow0, int nkeys) {
    (void)vbase; (void)vstride_tok0;
    float lg[4];
    if (kvalid) { dot64x4(krow, qs, lg);
        const int dd = dist < 0 ? 0 : (dist > 128 ? 128 : dist); const f32x4 bs = *(const LAS f32x4*)(lut + dd * 8 + g * 4);
        lg[0] += bs.x; lg[1] += bs.y; lg[2] += bs.z; lg[3] += bs.w;
    } else { lg[0] = lg[1] = lg[2] = lg[3] = -1e30f; }
    float p[4];
#pragma unroll
    for (int h = 0; h < 4; ++h) { const float bm = wave_max(lg[h]); const float mn = fmaxf(mrun[h], bm); p[h] = kvalid ? __expf(lg[h] - mn) : 0.f;
        const float sc = __expf(mrun[h] - mn); lrun[h] = lrun[h] * sc + wave_sum(p[h]); oacc[h] *= sc; mrun[h] = mn; }
    *(LAS f32x4*)(pb + F.lane * 4) = (f32x4){p[0], p[1], p[2], p[3]};
    LDS_WAIT(); asm volatile("" ::: "memory");
#pragma unroll 2
    for (int kk = 0; kk < nkeys; ++kk) { const f32x4 pp = *(const LAS f32x4*)(pb + kk * 4); const float vv = bf2f(vrow0[(size_t)kk * PMW + F.lane]);
        oacc[0] += pp.x * vv; oacc[1] += pp.y * vv; oacc[2] += pp.z * vv; oacc[3] += pp.w * vv; }
    LDS_WAIT(); asm volatile("" ::: "memory");
}
__device__ __forceinline__ void mix_nsa_naive(Frame& F_, const LayerP& L, const bf16* P, const Args& a, bf16* Y2, const LAS float* lut, int first, int stride) {
    LAS float* wl = (LAS float*)(F_.lds + 8192 + F_.wave * 12288);
    LAS float* qs = wl;
    LAS float* pc = wl + 256;
    LAS float* pb = wl + 256 + 2048;
    LAS int* sel = (LAS int*)(wl + 256 + 2048 + 256);
    const float* KCC = (const float*)(a.ws + WS_KCC);
    for (int unit = first; unit < T * 2; unit += stride) {
        Frame F = F_; asm volatile("" : "+v"(F.lane));
        const int g = unit & 1, t = unit >> 1, b = t >> 13, tq = t & (SEQ - 1);
        const int post = L.pos[tq];
        { const bf16* qp = P + (size_t)t * PMW + C_NQ + g * 256; const unsigned long long r = *(const unsigned long long*)(qp + F.lane * 4); const unsigned lo = (unsigned)r, hi = (unsigned)(r >> 32);
          *(LAS f32x4*)(qs + F.lane * 4) = (f32x4){bflo(lo) * 0.125f, bfhi(lo) * 0.125f, bflo(hi) * 0.125f, bfhi(hi) * 0.125f}; }
        LDS_WAIT(); asm volatile("" ::: "memory");
        const int ncv = tq >= 31 ? ((tq - 31) >> 4) + 1 : 0;
        float oc[4] = {0.f, 0.f, 0.f, 0.f};
        float icn[4] = {0.f, 0.f, 0.f, 0.f};
        {
            float mloc[4] = {-1e30f, -1e30f, -1e30f, -1e30f};
#pragma nounroll
            for (int cc = 0; cc < 8; ++cc) { const int c = cc * 64 + F.lane; const bool valid = c < ncv; f32x4 lgv = (f32x4){-1e30f, -1e30f, -1e30f, -1e30f};
                if (valid) { const float* kr = KCC + ((size_t)((0 * 2 + b) * 512 + c) * 2 + g) * 64; const int dist = post - L.pos[16 * c + 31];
                    const int dd = dist < 0 ? 0 : (dist > 128 ? 128 : dist); const f32x4 bs = *(const LAS f32x4*)(lut + dd * 8 + g * 4);
                    float s0 = 0.f, s1 = 0.f, s2 = 0.f, s3 = 0.f;
#pragma unroll 2
                    for (int d4 = 0; d4 < 16; ++d4) { const f32x4 kv = *(const f32x4*)(kr + d4 * 4);
                        const f32x4 q0 = *(const LAS f32x4*)(qs + d4 * 4), q1 = *(const LAS f32x4*)(qs + 64 + d4 * 4), q2 = *(const LAS f32x4*)(qs + 128 + d4 * 4), q3 = *(const LAS f32x4*)(qs + 192 + d4 * 4);
                        s0 += kv.x * q0.x + kv.y * q0.y + kv.z * q0.z + kv.w * q0.w; s1 += kv.x * q1.x + kv.y * q1.y + kv.z * q1.z + kv.w * q1.w;
                        s2 += kv.x * q2.x + kv.y * q2.y + kv.z * q2.z + kv.w * q2.w; s3 += kv.x * q3.x + kv.y * q3.y + kv.z * q3.z + kv.w * q3.w; }
                    lgv = (f32x4){s0 + bs.x, s1 + bs.y, s2 + bs.z, s3 + bs.w}; }
                mloc[0] = fmaxf(mloc[0], lgv.x); mloc[1] = fmaxf(mloc[1], lgv.y); mloc[2] = fmaxf(mloc[2], lgv.z); mloc[3] = fmaxf(mloc[3], lgv.w);
                *(LAS f32x4*)(pc + c * 4) = lgv; }
            LDS_WAIT(); asm volatile("" ::: "memory");
            float mx[4], sl[4] = {0.f, 0.f, 0.f, 0.f};
#pragma unroll
            for (int h = 0; h < 4; ++h) mx[h] = wave_max(mloc[h]);
#pragma nounroll
            for (int cc = 0; cc < 8; ++cc) { const int c = cc * 64 + F.lane; const bool valid = c < ncv; const f32x4 lgv = *(const LAS f32x4*)(pc + c * 4);
                f32x4 pv; pv.x = valid ? __expf(lgv.x - mx[0]) : 0.f; pv.y = valid ? __expf(lgv.y - mx[1]) : 0.f; pv.z = valid ? __expf(lgv.z - mx[2]) : 0.f; pv.w = valid ? __expf(lgv.w - mx[3]) : 0.f;
                sl[0] += pv.x; sl[1] += pv.y; sl[2] += pv.z; sl[3] += pv.w; *(LAS f32x4*)(pc + c * 4) = pv; }
            LDS_WAIT(); asm volatile("" ::: "memory");
#pragma unroll
            for (int h = 0; h < 4; ++h) { const float sm = wave_sum(sl[h]); icn[h] = ncv > 0 ? 1.f / sm : 0.f; }
            const float* vcb = KCC + ((size_t)((1 * 2 + b) * 512) * 2 + g) * 64;
#pragma nounroll
            for (int c = 0; c < ncv; ++c) { const f32x4 pp = *(const LAS f32x4*)(pc + c * 4); const float vv = vcb[(size_t)c * 128 + F.lane];
                oc[0] += pp.x * vv; oc[1] += pp.y * vv; oc[2] += pp.z * vv; oc[3] += pp.w * vv; }
#pragma unroll
            for (int h = 0; h < 4; ++h) oc[h] *= icn[h];
        }
        const int tb = tq >> 6;
        float sc0, sc1;
        { float im[2];
#pragma unroll
          for (int q = 0; q < 2; ++q) { const int j = F.lane + 64 * q; float s = 0.f;
#pragma unroll
              for (int dc = -1; dc <= 3; ++dc) { const int c = 4 * j + dc; if (c >= 0 && c < NCMP) { const f32x4 pp = *(const LAS f32x4*)(pc + c * 4); s += (pp.x * icn[0] + pp.y * icn[1]) + (pp.z * icn[2] + pp.w * icn[3]); } }
              const bool forced = (j == 0) || (j == tb) || (j == tb - 1); const bool elig = j <= tb;
              im[q] = forced ? 1e9f : (elig ? s : -1e9f); }
          sc0 = im[0]; sc1 = im[1]; }
        int nsel = 0;
        for (int it = 0; it < 16; ++it) {
            float bv = sc0; int bi = F.lane; if (sc1 > sc0) { bv = sc1; bi = F.lane + 64; }
#pragma unroll
            for (int o = 1; o < 64; o <<= 1) { const float ov = __shfl_xor(bv, o); const int oi = __shfl_xor(bi, o); if (ov > bv || (ov == bv && oi < bi)) { bv = ov; bi = oi; } }
            if (bv <= -1e9f) break;
            if (F.lane == 0) sel[it] = bi;
            if (bi == F.lane) sc0 = -3.0e38f; if (bi == F.lane + 64) sc1 = -3.0e38f;
            nsel = it + 1;
        }
        LDS_WAIT(); asm volatile("" ::: "memory");
        float ms[4] = {-1e30f, -1e30f, -1e30f, -1e30f}, ls[4] = {0.f, 0.f, 0.f, 0.f}, os[4] = {0.f, 0.f, 0.f, 0.f};
#pragma nounroll
        for (int it = 0; it < nsel; ++it) { const int j = sel[it]; const int tok = j * 64 + F.lane; const bool valid = tok <= tq;
            const size_t gt = (size_t)b * SEQ + tok; const int nk = (tq - j * 64 + 1) < 64 ? (tq - j * 64 + 1) : 64;
            nsa_chunk(F, P + gt * PMW + C_KS + g * 64, nullptr, 0, valid, post - L.pos[tok], qs, lut, g, pb, ms, ls, os, P + ((size_t)b * SEQ + j * 64) * PMW + C_VS + g * 64, nk); }
        float mw[4] = {-1e30f, -1e30f, -1e30f, -1e30f}, lw[4] = {0.f, 0.f, 0.f, 0.f}, ow[4] = {0.f, 0.f, 0.f, 0.f};
#pragma nounroll
        for (int cc = 0; cc < 8; ++cc) { const int tok0 = tq - 511 + cc * 64; if (tok0 + 63 < 0) continue;
            const int tok = tok0 + F.lane; const bool valid = tok >= 0; const int tokc = valid ? tok : 0; const size_t gt = (size_t)b * SEQ + tokc;
            const int skip = tok0 < 0 ? -tok0 : 0;
            const int ltok = (tok0 < 0 ? 0 : tok0) + F.lane; const bool lvalid = (F.lane < 64 - skip);
            const size_t lgt = (size_t)b * SEQ + (lvalid ? ltok : 0);
            (void)gt; (void)tokc; (void)valid;
            nsa_chunk(F, P + lgt * PMW + C_KW + g * 64, nullptr, 0, lvalid, post - L.pos[lvalid ? ltok : 0], qs, lut, g, pb, mw, lw, ow, P + ((size_t)b * SEQ + (tok0 < 0 ? 0 : tok0)) * PMW + C_VW + g * 64, 64 - skip); }
        { const bf16* ngp = P + (size_t)t * PMW + C_NG + g * 12;
#pragma unroll
          for (int h = 0; h < 4; ++h) { const float gc = sigm(bf2f(ngp[h * 3])), gs = sigm(bf2f(ngp[h * 3 + 1])), gw_ = sigm(bf2f(ngp[h * 3 + 2]));
              const float y = gc * oc[h] + gs * (os[h] / ls[h]) + gw_ * (ow[h] / lw[h]);
              Y2[(size_t)t * 512 + g * 256 + h * 64 + F.lane] = (bf16)f2bf(y); } }
        LDS_WAIT(); asm volatile("" ::: "memory");
    }
}

__device__ __forceinline__ void make_layer(LayerP& L, const Args& args, int layer) { asm volatile("" : "+s"(layer));
        L.a_re = (const float*)inptr(args, 6) + layer * 2048; L.a_im = (const float*)inptr(args, 7) + layer * 2048; L.log_dt = (const float*)inptr(args, 8) + layer * 32;
        L.b_re = (const float*)inptr(args, 9) + layer * 32768; L.b_im = (const float*)inptr(args, 10) + layer * 32768; L.c_re = (const float*)inptr(args, 11) + layer * 32768; L.c_im = (const float*)inptr(args, 12) + layer * 32768;
        L.ssm_d = (const float*)inptr(args, 13) + layer * 512; L.conv_w = (const float*)inptr(args, 15) + layer * 4 * 1536; L.a_log = (const float*)inptr(args, 16) + layer * 4; L.dt_bias = (const float*)inptr(args, 17) + layer * 4;
        L.gdn_norm = (const float*)inptr(args, 18) + layer * 128;
        L.kpe = (const float*)inptr(args, 19) + layer * 2048; L.kw1 = (const float*)inptr(args, 20) + (size_t)layer * 2048 * 128; L.kw2 = (const float*)inptr(args, 21) + layer * 8192;
        L.vpe = (const float*)inptr(args, 22) + layer * 2048; L.vw1 = (const float*)inptr(args, 23) + (size_t)layer * 2048 * 128; L.vw2 = (const float*)inptr(args, 24) + layer * 8192;
        L.rel_bias = (const float*)inptr(args, 25); L.ln_g = (const float*)inptr(args, 26) + layer * 512; L.ln_b = (const float*)inptr(args, 27) + layer * 512;
        L.sgu_w = (const float*)inptr(args, 28) + (size_t)layer * 4 * 128 * 128; L.sgu_b = (const float*)inptr(args, 29) + layer * 512; L.pos = (const int*)inptr(args, 1);

}
__device__ __forceinline__ Frame make_frame(unsigned char* lds_generic, unsigned char* ws) {
    Frame F;
    F.lds = (LAS unsigned char*)lds_generic;
    F.MISC = (volatile LAS unsigned*)(F.lds + MISC_OFF);
    int t = threadIdx.x; asm volatile("" : "+v"(t));
    F.tid = t; F.lane = F.tid & 63; F.wave = __builtin_amdgcn_readfirstlane(F.tid >> 6);
    F.G = gridDim.x; { const int bx = blockIdx.x; F.vcu = (F.G % 8 == 0) ? (bx % 8) * (F.G / 8) + bx / 8 : bx; }
    F.gw = F.vcu * NWAVES + F.wave; F.NGW = F.G * NWAVES;
    F.ctl = (gu32*)(ws + WS_CTL);
    return F;
}
#define ws (args.ws)
#define F0 make_frame(lds, ws)
#define relaunder(x) (x)
#define IN(k) in_rng(lo, hi, (k))
#if STAMPMASK
#define STAMP_AT(k) do { if (blockIdx.x == 0 && threadIdx.x == 0) ((unsigned long long*)(ws + WS_CTL + 512 * 1024))[(k) + 1] = __builtin_amdgcn_s_memrealtime(); } while (0)
#else
#define STAMP_AT(k) do { } while (0)
#endif
#define GRID_BAR(k) do { if (IN(k) && IN((k) + 1)) { Frame Fb = F0; XcdBarrier bar; bar.bar = (unsigned*)(Fb.ctl + CW_BAR); bar.x = xb_xcc_id(); bar.st = Fb.MISC + 8; xcd_barrier(bar); } STAMP_AT(k); } while (0)

#define IS_SCAN_BLOCK(Fr) (((Fr).G == 256) ? (((Fr).vcu & 15) == 0) : ((Fr).vcu < 16))
#define PA ((bf16*)(ws + WS_A))
#define YB ((bf16*)(ws + WS_B))
#define MGB ((bf16*)(ws + WS_D))
#define YPRE ((bf16*)(ws + WS_D))
#define HB ((bf16*)(ws + WS_C))
#define XW (args.out)

template <int layer>
__device__ __forceinline__ void layer_body(const Args& args, const int lo, const int hi, unsigned char* lds) {
        const int pb = 1 + layer * 10;
#define wl (ws + WS_WL + (size_t)layer * W_LAYER)
        if (IN(pb + 0)) { Frame F = relaunder(F0); p_norm<false, false>(F, layer == 0 ? (const float*)inptr(args, 0) : XW, (const float*)inptr(args, 2) + layer * DM, HB, nullptr, nullptr, args); }
        GRID_BAR(pb + 0);
        if (IN(pb + 1)) { Frame F = relaunder(F0); pg8::Gemm g{HB, (const bf16*)(wl + W_IN1), T, PMW, DM}; pg8::StaticOrder S; S.init(T, PMW, F.G, (int)blockIdx.x);
            pg8::EpiStore E{PA, PMW, 1 << 20, 0}; pg8::gemm_phase<pg8::EpiStore, pg8::StaticOrder, true, true>(F.lds, g, S, E); }
        GRID_BAR(pb + 1);
        if (IN(pb + 2)) {
            { Frame F = relaunder(F0); LayerP L; make_layer(L, args, layer); mix_sgu(F, L, PA, YB + (size_t)3 * T * 512); }
#if STAMPMASK
            __syncthreads(); if (layer == 0 && blockIdx.x == gridDim.x - 1 && threadIdx.x == 0) ((unsigned long long*)(ws + WS_CTL + 512 * 1024))[48] = __builtin_amdgcn_s_memrealtime();
#endif
            { Frame F = relaunder(F0); LayerP L; make_layer(L, args, layer); gdn_chunk_prep(F, L, PA, args); }
#if !NSA_NAIVE
            { Frame F = relaunder(F0); nsa_compress_mfma(F, PA, args, layer); }
#endif
#if STAMPMASK
            __syncthreads(); if (layer == 0 && blockIdx.x == gridDim.x - 1 && threadIdx.x == 0) ((unsigned long long*)(ws + WS_CTL + 512 * 1024))[49] = __builtin_amdgcn_s_memrealtime();
#endif
            { Frame F = relaunder(F0);
              __syncthreads();
              { LayerP L; make_layer(L, args, layer); ssm_pass1(F, L, PA, args, F.lds + F.wave * 16384, F.gw, F.NGW); }
              __syncthreads();
#if STAMPMASK
              __syncthreads(); if (layer == 0 && blockIdx.x == gridDim.x - 1 && threadIdx.x == 0) ((unsigned long long*)(ws + WS_CTL + 512 * 1024))[50] = __builtin_amdgcn_s_memrealtime();
#endif
#if NSA_NAIVE
              { LayerP L; make_layer(L, args, layer); mix_nsa_compress(F, L, PA, args, (LAS float*)(F.lds + 73728 + F.wave * 4096), F.gw, F.NGW); }
#endif
#if STAMPMASK
              __syncthreads(); if (layer == 0 && blockIdx.x == gridDim.x - 1 && threadIdx.x == 0) ((unsigned long long*)(ws + WS_CTL + 512 * 1024))[51] = __builtin_amdgcn_s_memrealtime();
#endif
              nsa_tiles(F, PA, args, (LAS bf16*)(F.lds + F.wave * 9216), F.gw, F.NGW); }
        }
        GRID_BAR(pb + 2);
        if (IN(pb + 3)) {
            if (IS_SCAN_BLOCK(F0)) { Frame F = relaunder(F0); LayerP L; make_layer(L, args, layer); const int si = (F.G == 256) ? (F.vcu >> 4) : F.vcu; gdn_scan(F, L, PA, args, YB + (size_t)1 * T * 512, si >> 3, (si >> 1) & 3, si & 1); }
            __syncthreads();
#if STAMPMASK
            if (layer == 0 && blockIdx.x == 0 && threadIdx.x == 0) ((unsigned long long*)(ws + WS_CTL + 512 * 1024))[40] = __builtin_amdgcn_s_memrealtime();
#endif
            if (F0.G != 256) { Frame F = relaunder(F0); LayerP L; make_layer(L, args, layer); ssm_pass2(F, L, PA, args, YPRE, F.lds + F.wave * 16384, F.gw, F.NGW); }
            else if (!IS_SCAN_BLOCK(F0)) { Frame F = relaunder(F0); LayerP L; make_layer(L, args, layer);
              ssm_pass2(F, L, PA, args, YPRE, F.lds + F.wave * 16384, F.gw, 1 << 28);
              if ((F.vcu & 15) == 1) ssm_pass2(F, L, PA, args, YPRE, F.lds + F.wave * 16384, F.gw - NWAVES, 1 << 28); }
            __syncthreads();
#if STAMPMASK
            if (layer == 0 && blockIdx.x == gridDim.x - 1 && threadIdx.x == 0) ((unsigned long long*)(ws + WS_CTL + 512 * 1024))[41] = __builtin_amdgcn_s_memrealtime();
#endif
            if (!IS_SCAN_BLOCK(F0) || F0.G == 256) { Frame F = relaunder(F0); LayerP L; make_layer(L, args, layer);
                LAS float* lut = (LAS float*)(F.lds);
                for (int i = F.tid; i < 129 * 8; i += NTHR) { const int d = i >> 3, hh = i & 7; int bk;
                    if (d < 16) bk = d; else { const float nf = (float)d; int lg2 = 16 + (int)(logf(nf / 16.0f) / 2.0794415416798357f * 16.0f); bk = lg2 > 31 ? 31 : lg2; }
                    if (d >= 128) bk = 31;
                    lut[i] = L.rel_bias[bk * 8 + hh]; }
                LAS int* cpos = (LAS int*)(F.lds + 4352);
                for (int i = F.tid; i < 512; i += NTHR) cpos[i] = L.pos[16 * (i < NCMP ? i : NCMP - 1) + 31];
                LAS int* ptab = (LAS int*)(F.lds + 40960);
                for (int i = F.tid; i < SEQ; i += NTHR) ptab[i] = L.pos[i];
                LAS int* bmax = (LAS int*)(F.lds + 6400);
                __syncthreads();
                if (F.tid < 128) { int mx = ptab[64 * F.tid]; for (int k = 1; k < 64; ++k) mx = max(mx, ptab[64 * F.tid + k]); bmax[F.tid] = mx; }
                LAS int* cmax = (LAS int*)(F.lds + 6912);
                if (F.tid >= 128 && F.tid < 160) { const int n = F.tid - 128; int mx = cpos[16 * n]; for (int k = 1; k < 16; ++k) mx = max(mx, cpos[16 * n + k]); cmax[n] = mx; }
                __syncthreads();
#if NSA_NAIVE
                mix_nsa_naive(F, L, PA, args, YB + (size_t)2 * T * 512, lut, (F.vcu - 16) * 8 + F.wave, (F.G - 16) * 8);
#else
                if (F.G == 256) {
                    const int x = F.vcu >> 5;
                    LAS v4u* kcl = (LAS v4u*)(F.lds + 73728);
                    { const v4u* src = (const v4u*)(ws + WS_NKCF) + (size_t)(x & 3) * 4096; for (int i = F.tid; i < 4096; i += NTHR) kcl[i] = src[i]; }
                    __syncthreads();
                    mix_nsa_mfma(F, L, PA, args, YB + (size_t)2 * T * 512, lut, cpos, ptab, bmax, cmax, (LAS float*)(F.lds + 8192 + F.wave * 4096), 0, 0, SEQ / 8, (x & 3) >> 1, x & 1, (x >> 2) * (SEQ / 8), (unsigned*)(F.ctl + CW_NSAQ + 64 * (layer * 8 + x)), (unsigned*)(F.ctl + CW_NSAQ + 64 * (layer * 8 + (x ^ 4))), ((x ^ 4) >> 2) * (SEQ / 8), kcl);
                } else mix_nsa_mfma(F, L, PA, args, YB + (size_t)2 * T * 512, lut, cpos, ptab, bmax, cmax, (LAS float*)(F.lds + 8192 + F.wave * 4096), (F.vcu - 16) * 8 + F.wave, (F.G - 16) * 8, BATCH * 2 * (SEQ / 4), -1, 0, 0, nullptr);
#endif
            }
        }
#if STAMPMASK
        if (IN(pb + 3)) { __syncthreads(); if (layer == 0 && blockIdx.x == gridDim.x - 1 && threadIdx.x == 0) ((unsigned long long*)(ws + WS_CTL + 512 * 1024))[42] = __builtin_amdgcn_s_memrealtime(); }
#endif
        GRID_BAR(pb + 3);
        if (IN(pb + 4)) {
            { Frame F = relaunder(F0); gdn_norm_pass(F, args, YB + (size_t)1 * T * 512); }
            { Frame F = relaunder(F0); pg8::Gemm g{YPRE, (const bf16*)(wl + W_GLU), T, 512, 512}; pg8::StaticOrder S; S.init(T, 512, F.G, (int)blockIdx.x);
              pg8::EpiGLU E{YPRE, YB}; pg8::gemm_phase<pg8::EpiGLU, pg8::StaticOrder, true, true>(F.lds, g, S, E); }
            __syncthreads();
        }
        if (IN(pb + 4)) { Frame F = relaunder(F0); pg8::Gemm g{HB, (const bf16*)(wl + W_IN2), T, NGATE, DM}; pg8::StaticOrder S; S.init(T, NGATE, F.G, (int)blockIdx.x);
            pg8::EpiGateRatio E{PA}; pg8::gemm_phase<pg8::EpiGateRatio, pg8::StaticOrder, true, true>(F.lds, g, S, E); }
        GRID_BAR(pb + 4);
        if (IN(pb + 5)) { Frame F = relaunder(F0); pg8::Gemm g{YB, (const bf16*)(wl + W_BR), 4 * T, 4096, 512}; pg8::MergeOrder S; S.init(F.G, (int)blockIdx.x);
            pg8::EpiMergeAcc E{PA, MGB}; pg8::gemm_phase<pg8::EpiMergeAcc, pg8::MergeOrder, true, true>(F.lds, g, S, E); }
        GRID_BAR(pb + 5);
        if (IN(pb + 6)) { Frame F = relaunder(F0); pg8::Gemm g{MGB, (const bf16*)(wl + W_OUT), T, DM, DM}; pg8::StaticOrder S; S.init(T, DM, F.G, (int)blockIdx.x);
            pg8::EpiResid E{layer == 0 ? (const float*)inptr(args, 0) : XW, XW, DM}; pg8::gemm_phase<pg8::EpiResid, pg8::StaticOrder, true, true>(F.lds, g, S, E); }
        GRID_BAR(pb + 6);
        if (IN(pb + 7)) { Frame F = relaunder(F0);
            if (layer == 0) p_norm<false, false>(F, XW, (const float*)inptr(args, 3), HB, nullptr, nullptr, args);
            else { p_norm<true, false>(F, XW, (const float*)inptr(args, 3) + DM, HB, nullptr, (const float*)inptr(args, 38), args); p_conv_moe_down(F, args); }
        }
        GRID_BAR(pb + 7);
        if constexpr (layer == 0) {
            if (IN(9) && !(ABL & 16)) { Frame F = relaunder(F0); pg8::Gemm g{HB, (const bf16*)(ws + WS_FUP), T, 2 * FFD, DM}; pg8::StaticOrder S; S.init(T, 2 * FFD, F.G, (int)blockIdx.x);
                pg8::EpiSwiGLU E{PA, FFD, 1 << 20}; pg8::gemm_phase<pg8::EpiSwiGLU, pg8::StaticOrder, true, true>(F.lds, g, S, E); }
            GRID_BAR(9);
            if (IN(10) && !(ABL & 16)) { Frame F = relaunder(F0); pg8::Gemm g{PA, (const bf16*)(ws + WS_FDN), T, DM, FFD}; pg8::StaticOrder S; S.init(T, DM, F.G, (int)blockIdx.x);
                pg8::EpiResid E{XW, XW, DM}; pg8::gemm_phase<pg8::EpiResid, pg8::StaticOrder, true, true>(F.lds, g, S, E); }
            GRID_BAR(10);
        } else {
            {
                constexpr int pass = 0; constexpr int q0 = 19;
                MoeTiles mt;
                if (IN(q0) || IN(q0 + 1) || IN(q0 + 2) || IN(q0 + 3)) { Frame Fm = F0; moe_tiles(Fm, mt); }
                const int tile0 = pass * PASS_TILES; int ntp = mt.tb[8] - tile0; ntp = ntp < 0 ? 0 : (ntp > pass_cap(pass) ? pass_cap(pass) : ntp);
                if (IN(q0 + 1)) { Frame F = relaunder(F0); pg8::Gemm g{(const bf16*)ws, (const bf16*)(ws + WS_MUP), PASS_CAP1 * 256, NEXP * 2 * FFE, DM};
                    pg8::MoeOrder S{ntp, tile0, 28, F.G, (int)blockIdx.x, mt.tb[1], mt.tb[2], mt.tb[3], mt.tb[4], mt.tb[5], mt.tb[6], mt.tb[7],
                                    (const int*)(ws + WS_ROWTOK), mt.cnt[0], mt.cnt[1], mt.cnt[2], mt.cnt[3], mt.cnt[4], mt.cnt[5], mt.cnt[6], mt.cnt[7], (unsigned)WS_C, (unsigned)WS_ZROW};
                    pg8::EpiSwiGLU E{PA, FFE, 28}; pg8::gemm_phase<pg8::EpiSwiGLU, pg8::MoeOrder, true, true, true>(F.lds, g, S, E); }
                GRID_BAR(q0 + 1);
                if (IN(q0 + 2)) { Frame F = relaunder(F0); pg8::Gemm g{PA, (const bf16*)(ws + WS_MDN), PASS_CAP1 * 256, NEXP * DM, FFE};
                    pg8::MoeOrder S{ntp, tile0, 4, F.G, (int)blockIdx.x, mt.tb[1], mt.tb[2], mt.tb[3], mt.tb[4], mt.tb[5], mt.tb[6], mt.tb[7]};
                    pg8::EpiStore E{(bf16*)(ws + WS_YM), DM, 4, 0}; pg8::gemm_phase<pg8::EpiStore, pg8::MoeOrder, true, true>(F.lds, g, S, E); }
                GRID_BAR(q0 + 2);
                if (IN(q0 + 3) && !(ABL & 32)) { Frame F = relaunder(F0); p_moe_combine<false>(F, args, mt, pass); }
            }
            {
                constexpr int pass = 1; constexpr int q0 = 23;
                MoeTiles mt;
                if (IN(q0) || IN(q0 + 1) || IN(q0 + 2) || IN(q0 + 3)) { Frame Fm = F0; moe_tiles(Fm, mt); }
                const int tile0 = pass * PASS_TILES; int ntp = mt.tb[8] - tile0; ntp = ntp < 0 ? 0 : (ntp > pass_cap(pass) ? pass_cap(pass) : ntp);
                if (IN(q0 + 1)) { Frame F = relaunder(F0); pg8::Gemm g{(const bf16*)ws, (const bf16*)(ws + WS_MUP), PASS_CAP1 * 256, NEXP * 2 * FFE, DM};
                    pg8::MoeOrder S{ntp, tile0, 28, F.G, (int)blockIdx.x, mt.tb[1], mt.tb[2], mt.tb[3], mt.tb[4], mt.tb[5], mt.tb[6], mt.tb[7],
                                    (const int*)(ws + WS_ROWTOK), mt.cnt[0], mt.cnt[1], mt.cnt[2], mt.cnt[3], mt.cnt[4], mt.cnt[5], mt.cnt[6], mt.cnt[7], (unsigned)WS_C, (unsigned)WS_ZROW};
                    pg8::EpiSwiGLU E{PA, FFE, 28}; pg8::gemm_phase<pg8::EpiSwiGLU, pg8::MoeOrder, true, true, true>(F.lds, g, S, E); }
                GRID_BAR(q0 + 1);
                if (IN(q0 + 2)) { Frame F = relaunder(F0); pg8::Gemm g{PA, (const bf16*)(ws + WS_MDN), PASS_CAP1 * 256, NEXP * DM, FFE};
                    const int ntA = ntp < PASS_TILES ? ntp : PASS_TILES;
                    pg8::MoeOrder S{ntA, tile0, 4, F.G, (int)blockIdx.x, mt.tb[1], mt.tb[2], mt.tb[3], mt.tb[4], mt.tb[5], mt.tb[6], mt.tb[7]};
                    pg8::EpiStore E{(bf16*)(ws + WS_YM), DM, 4, 0}; pg8::gemm_phase<pg8::EpiStore, pg8::MoeOrder, true, true>(F.lds, g, S, E); }
                if (IN(q0 + 2)) { __syncthreads(); Frame F = relaunder(F0); pg8::Gemm g{PA, (const bf16*)(ws + WS_MDN), PASS_CAP1 * 256, NEXP * DM, FFE / MOE_KSPLIT, FFE};
                    pg8::MoeSplitOrder S{ntp > PASS_TILES ? ntp - PASS_TILES : 0, tile0, F.G, (int)blockIdx.x, mt.tb[1], mt.tb[2], mt.tb[3], mt.tb[4], mt.tb[5], mt.tb[6], mt.tb[7]};
                    pg8::EpiPartF32 E{(float*)(ws + WS_YMX)}; pg8::gemm_phase<pg8::EpiPartF32, pg8::MoeSplitOrder, true, true>(F.lds, g, S, E); }
                GRID_BAR(q0 + 2);
                if (IN(q0 + 3) && !(ABL & 32)) { Frame F = relaunder(F0); p_moe_combine<true>(F, args, mt, pass); }
            }
        }
    }
__global__ void __launch_bounds__(NTHR, 2) fwd(Args args) {
    extern __shared__ __attribute__((aligned(16))) unsigned char lds[];
    { Frame Fz = F0;
      for (int u = Fz.tid; u < (LDS_BYTES - LDSCTL_OFF) / 4; u += NTHR) ((LAS unsigned*)(Fz.lds + LDSCTL_OFF))[u] = 0u; }
    __syncthreads();
    const int lo = args.ph_lo, hi = args.ph_hi;
    STAMP_AT(-1);
    if (hi - lo > 1) { Frame Fz = F0; (void)xcd_barrier_post((unsigned*)(Fz.ctl + CW_BAR), Fz.MISC + 8); }
    if (IN(0)) { Frame F = relaunder(F0); p_prologue(F, args); }
    GRID_BAR(0);

    layer_body<0>(args, lo, hi, lds);
    layer_body<1>(args, lo, hi, lds);
#if STAMPMASK
    __syncthreads();
    if (blockIdx.x == 0) { STAMP_AT(27); __syncthreads();
        const unsigned long long* ts = (const unsigned long long*)(ws + WS_CTL + 512 * 1024); unsigned long long tot = 0;
        for (int k = 0; k < 28; ++k) if ((STAMPMASK >> k) & 1) tot += ts[k + 1] - ts[k];
        if (STAMPSEL >= 9) tot = ts[39 + STAMPSEL] - ts[3]; else if (STAMPSEL >= 5) tot = ts[39 + STAMPSEL]; else if (STAMPSEL) tot = ts[39 + STAMPSEL] - ts[4];
        const float vraw = (float)tot * 1e-3f;
        const float v = exp2f(rintf(log2f(vraw > 1e-3f ? vraw : 1e-3f) * 2.0f) * 0.5f);
        for (size_t i = threadIdx.x; i < (size_t)T * DM; i += NTHR) XW[i] = v; }
#endif
#undef IN
#undef GRID_BAR
#undef ws
#undef F0
#undef relaunder
#undef PA
#undef YB
#undef MGB
#undef YPRE
#undef HB
#undef XW
#undef wl
}


#if SELFCHK
constexpr int CW_CHK = 32768;
__device__ __forceinline__ unsigned hsh(unsigned x) { x ^= x >> 16; x *= 0x7feb352du; x ^= x >> 15; x *= 0x846ca68bu; x ^= x >> 16; return x; }
__device__ __forceinline__ float rbf(float f) { return __uint_as_float(f2bf(f) << 16); }
__device__ __forceinline__ bool bad(float got, float ref, float rel, float ab) { const float d = fabsf(got - ref); return !(d <= rel * fabsf(ref) + ab); }
__global__ void __launch_bounds__(256) chk(Args a, int which, int layer) {
    const unsigned sid = blockIdx.x * 256 + threadIdx.x; unsigned char* ws = a.ws;
    const unsigned h1 = hsh(sid * 2654435761u + 12345u * (unsigned)which), h2 = hsh(h1 + 0x9e3779b9u);
    const int r = (int)(h1 % (unsigned)T);
    const bf16* H = (const bf16*)(ws + WS_C); const bf16* PAp = (const bf16*)(ws + WS_A); const bf16* Y = (const bf16*)(ws + WS_B); const bf16* MG = (const bf16*)(ws + WS_D);
    const float* w_in = (const float*)a.in[5] + (size_t)layer * DM * IN_COLS;
    unsigned* cnt = (unsigned*)(ws + WS_CTL) + CW_CHK + 64 * which;
    bool fail = false;
    if (which == 1) { const int c = (int)(h2 % (unsigned)NMIX); float s = 0.f; for (int k = 0; k < DM; ++k) s += bf2f(H[(size_t)r * DM + k]) * rbf(w_in[(size_t)k * IN_COLS + c]);
        fail = bad(bf2f(PAp[(size_t)r * PMW + c]), s, 0.02f, 0.02f); }
    else if (which == 2) { const int c = (int)(h2 % (unsigned)NGATE); float s = 0.f; for (int k = 0; k < DM; ++k) s += bf2f(H[(size_t)r * DM + k]) * rbf(w_in[(size_t)k * IN_COLS + NMIX + c]);
        fail = bad(bf2f(PAp[(size_t)r * NGATE + c]), 1.f / (1.f + expf(-s)), 0.02f, 0.01f); }
    else if (which == 3) { const int c = (int)(h2 % 512u); const bf16* yp = (const bf16*)(ws + WS_D); const float* glu = (const float*)a.in[14] + (size_t)layer * 512 * 512; float s = 0.f;
        for (int k = 0; k < 512; ++k) s += bf2f(yp[(size_t)r * 512 + k]) * rbf(glu[(size_t)k * 512 + c]);
        fail = bad(bf2f(Y[(size_t)r * 512 + c]), bf2f(yp[(size_t)r * 512 + c]) / (1.f + expf(-s)), 0.02f, 0.01f); }
    else if (which == 4) { const int c = (int)(h2 % 1024u); float tot = 0.f;
        for (int b = 0; b < 4; ++b) { const float* wb = (const float*)a.in[30 + b] + (size_t)layer * 512 * 1024; float s = 0.f;
            for (int k = 0; k < 512; ++k) s += bf2f(Y[((size_t)b * T + r) * 512 + k]) * rbf(wb[(size_t)k * 1024 + c]);
            tot += bf2f(PAp[(size_t)r * NGATE + b * 1024 + c]) * s; }
        fail = bad(bf2f(MG[(size_t)r * 1024 + c]), tot, 0.03f, 0.03f); }
    else if (which == 5 || which == 7) { const int c = (int)(h2 % 1024u); const float* wo = (const float*)a.in[34] + (size_t)layer * DM * DM; float s = ((const float*)a.in[0])[(size_t)r * DM + c];
        for (int k = 0; k < DM; ++k) s += bf2f(MG[(size_t)r * 1024 + k]) * rbf(wo[(size_t)k * DM + c]);
        if (which == 7) { const float* wd = (const float*)a.in[37]; for (int j = 0; j < FFD; ++j) s += bf2f(PAp[(size_t)r * FFD + j]) * rbf(wd[(size_t)j * DM + c]); }
        fail = bad(a.out[(size_t)r * DM + c], s, 0.01f, 0.03f); }
    else if (which == 6) { const int c = (int)(h2 % (unsigned)FFD); const float* wg = (const float*)a.in[35]; const float* wu = (const float*)a.in[36]; float g = 0.f, u = 0.f;
        for (int k = 0; k < DM; ++k) { const float hv = bf2f(H[(size_t)r * DM + k]); g += hv * rbf(wg[(size_t)k * FFD + c]); u += hv * rbf(wu[(size_t)k * FFD + c]); }
        fail = bad(bf2f(PAp[(size_t)r * FFD + c]), g / (1.f + expf(-g)) * u, 0.02f, 0.02f); }
    else if (which == 8 || which == 9) {
        int cn[8], tb[9], run = 0; for (int e = 0; e < 8; ++e) { cn[e] = (int)((unsigned*)(ws + WS_CTL))[CW_CNT + 64 * e]; tb[e] = run; run += (cn[e] + 255) >> 8; } tb[8] = run;
        const int ntp = run < PASS_TILES ? run : PASS_TILES; const int rl = (int)(h1 % (unsigned)(ntp * 256)); const int ti = rl >> 8; int e = 0; for (int k = 1; k < 8; ++k) e += (ti >= tb[k]);
        const int rin = (ti - tb[e]) * 256 + (rl & 255);
        if (rin < cn[e]) { const int tok = ((const int*)(ws + WS_ROWTOK))[e * T + rin];
            if (which == 8) { const int c = (int)(h2 % (unsigned)FFE); const float* wg = (const float*)a.in[39] + (size_t)e * DM * FFE; const float* wu = (const float*)a.in[40] + (size_t)e * DM * FFE; float g = 0.f, u = 0.f;
                for (int k = 0; k < DM; ++k) { const float hv = bf2f(H[(size_t)tok * DM + k]); g += hv * rbf(wg[(size_t)k * FFE + c]); u += hv * rbf(wu[(size_t)k * FFE + c]); }
                fail = bad(bf2f(PAp[(size_t)rl * FFE + c]), g / (1.f + expf(-g)) * u, 0.02f, 0.02f); }
            else { const int c = (int)(h2 % 1024u); const float* wd = (const float*)a.in[41] + (size_t)e * FFE * DM; float s = 0.f;
                for (int j = 0; j < FFE; ++j) s += bf2f(PAp[(size_t)rl * FFE + j]) * rbf(wd[(size_t)j * DM + c]);
                fail = bad(bf2f(((const bf16*)(ws + WS_YM))[(size_t)rl * DM + c]), s, 0.02f, 0.02f); } } }
    else if (which == 10) {
        const int c = (int)(h2 % 1024u); const float* x = (const float*)a.in[0] + (size_t)r * DM; float ss = 0.f; for (int k = 0; k < DM; ++k) ss += x[k] * x[k];
        const float ref = x[c] / sqrtf(ss / DM + RMS_EPS) * ((const float*)a.in[2])[c]; fail = bad(bf2f(H[(size_t)r * DM + c]), ref, 0.01f, 0.005f); }
    if (fail) { atomicAdd(cnt, 1u);
        if (which == 2) { const int c = (int)(h2 % (unsigned)NGATE); atomicAdd(cnt + 1 + (c >> 10), 1u);
            const int pm = r >> 8, pn = c >> 8; atomicOr(cnt + 8 + (pm >> 5), 1u << (pm & 31)); atomicOr(cnt + 10, 1u << pn);
            atomicOr(cnt + 11, 1u << ((r >> 4) & 15)); atomicOr(cnt + 12, 1u << (c & 31)); } }
}
__global__ void __launch_bounds__(256) chk_final(Args a) {
    const unsigned* c = (const unsigned*)(a.ws + WS_CTL) + CW_CHK; int first = 0;
    for (int k = 1; k <= 10; ++k) if (first == 0 && c[64 * k] != 0u) first = k;
#if SELFCHK == 2
    first = 0; { unsigned n = c[64 * 2] + 1u; while (n > 1u) { n >>= 1; ++first; } } if (c[64 * 2] == 0u) first = 0; else first += 0;
#elif SELFCHK == 4
    first = __builtin_popcount(c[64 * 2 + 8]) + __builtin_popcount(c[64 * 2 + 9]);
#elif SELFCHK == 5
    first = __builtin_popcount(c[64 * 2 + 10]);
#elif SELFCHK == 6
    first = __builtin_popcount(c[64 * 2 + 11]);
#elif SELFCHK == 7
    first = __builtin_popcount(c[64 * 2 + 12]);
#elif SELFCHK == 3
    first = (c[64 * 2 + 1] ? 1 : 0) | (c[64 * 2 + 2] ? 2 : 0) | (c[64 * 2 + 3] ? 4 : 0) | (c[64 * 2 + 4] ? 8 : 0);
#endif
    if (first) { const float v = 1.0f + (float)first; for (size_t i = (size_t)blockIdx.x * 256 + threadIdx.x; i < (size_t)T * DM; i += (size_t)gridDim.x * 256) a.out[i] = v; }
}
#endif
extern "C" void kernel_launch(void* const* d_in, const int* in_sizes, int n_in, void* d_out, int out_size, void* d_ws, size_t ws_size, hipStream_t stream) {
    static int grid = 0;
    if (grid == 0) {
        if (n_in != 42 || out_size != T * DM || ws_size < WS_END) { fprintf(stderr, "kernel_launch: unexpected shapes: n_in %d out %d ws %zu (need %zu)\n", n_in, out_size, ws_size, (size_t)WS_END); grid = -1; return; }
        int dev = 0, cus = 0, per_cu = 0;
        if (hipGetDevice(&dev) != hipSuccess || hipDeviceGetAttribute(&cus, hipDeviceAttributeMultiprocessorCount, dev) != hipSuccess) { grid = -1; return; }
        if (hipFuncSetAttribute((const void*)fwd, hipFuncAttributeMaxDynamicSharedMemorySize, LDS_BYTES) != hipSuccess) { fprintf(stderr, "kernel_launch: hipFuncSetAttribute failed\n"); grid = -1; return; }
        if (hipOccupancyMaxActiveBlocksPerMultiprocessor(&per_cu, (const void*)fwd, NTHR, LDS_BYTES) != hipSuccess || per_cu < 1) fprintf(stderr, "kernel_launch: occupancy query says %d\n", per_cu);
        (void)hipGetLastError();
        grid = cus;
    }
    if (grid < 0) return;
    (void)in_sizes;
    if (hipMemsetAsync((char*)d_ws + WS_CTL, 0, CTL_ZERO_BYTES, stream) != hipSuccess) return;
#if NANFILL & 64
    if (hipMemsetAsync((char*)d_ws + WS_W, 0xFF, WS_MDN - WS_W, stream) != hipSuccess) return;
#endif
    Args a{};
    for (int i = 0; i < 42; ++i) a.in[i] = d_in[i];
    a.out = (float*)d_out; a.ws = (unsigned char*)d_ws;
#if MK_MULTI
    for (int p = 0; p < NPH; ++p) { a.ph_lo = p; a.ph_hi = p + 1; hipLaunchKernelGGL(fwd, dim3(grid), dim3(NTHR), LDS_BYTES, stream, a);
#if SELFCHK
        const int after[11] = {0, 2, 5, 4, 6, 7, 9, 10, 20, 21, 1};
        for (int k = 1; k <= 10; ++k) if (after[k] == p) hipLaunchKernelGGL(chk, dim3(256), dim3(256), 0, stream, a, k, 0);
#endif
    }
#if SELFCHK
    hipLaunchKernelGGL(chk_final, dim3(1024), dim3(256), 0, stream, a);
#endif
#else
    a.ph_lo = 0; a.ph_hi = NPH; hipLaunchKernelGGL(fwd, dim3(grid), dim3(NTHR), LDS_BYTES, stream, a);
#endif
}
```
